# Optimizing an MI355X kernel written in HIP

```python
import jax, jax.numpy as jnp
from jax import lax
import numpy as np

D_MODEL = 1024
BATCH = 32
SEQ = 2048
DEPTH = 1

GLA_HEADS = 4
GLA_V_W = D_MODEL // 2
GLA_DV = GLA_V_W // GLA_HEADS
GLA_DK = GLA_DV // 2
GLA_QK_W = GLA_HEADS * GLA_DK
GLA_GATE_RANK = 16
GLA_LOGIT_NORM = 16.0
GLA_CHUNK = 64
RWKV_HEAD = 64
RWKV_W = D_MODEL // 2
RWKV_HEADS = RWKV_W // RWKV_HEAD
RWKV_DECAY_LORA = 64
RWKV_AAA_LORA = 64
RWKV_GATE_LORA = 128
RWKV_GN_EPS = RWKV_HEAD * 1e-5
GLA_SPLITS = (GLA_QK_W, GLA_QK_W, GLA_V_W, GLA_V_W, GLA_GATE_RANK, GLA_GATE_RANK)
RWKV_SPLITS = (RWKV_W, RWKV_W, RWKV_W, RWKV_DECAY_LORA, RWKV_AAA_LORA, RWKV_GATE_LORA)
GLA_PROJ_W = sum(GLA_SPLITS)
RWKV_PROJ_W = sum(RWKV_SPLITS)
GATE_PROJ_W = 2 * D_MODEL
N_PROJ = GLA_PROJ_W + RWKV_PROJ_W + GATE_PROJ_W
D_FF = ((8 * D_MODEL // 3) + 63) // 64 * 64
CONV_W = 3
NORM_EPS = 1e-6
HEAD_NORM_EPS = 1e-5

kernel_name = "bidir_gla_rwkv7_gated_hybrid"


def _rmsnorm(x, g):
    xf = x.astype(jnp.float32)
    y = xf * lax.rsqrt(jnp.mean(xf * xf, axis=-1, keepdims=True) + NORM_EPS)
    return (y * g.astype(jnp.float32)).astype(x.dtype)


def _shift_prev(u):
    return jnp.pad(u[:, :-1], ((0, 0), (1, 0), (0, 0)))


def _shift_next(u):
    return jnp.pad(u[:, 1:], ((0, 0), (0, 1), (0, 0)))


def _split(t, sizes):
    return jnp.split(t, np.cumsum(sizes)[:-1].tolist(), axis=-1)


def _gla_chunked(q, k, v, log_a):
    f32 = jnp.float32
    B_, T, H, K = q.shape
    V = v.shape[-1]
    C = GLA_CHUNK
    n = T // C
    q = q.astype(f32).reshape(B_, n, C, H, K)
    k = k.astype(f32).reshape(B_, n, C, H, K)
    v = v.astype(f32).reshape(B_, n, C, H, V)
    b = jnp.cumsum(log_a.astype(f32).reshape(B_, n, C, H, K), axis=2)
    b_ref = b[:, :, C // 2:C // 2 + 1]
    qi = q * jnp.exp(b - b_ref)
    ki = k * jnp.exp(b_ref - b)
    A = jnp.einsum('bnchk,bnshk->bnhcs', qi, ki)
    A = jnp.where(jnp.tril(jnp.ones((C, C), dtype=bool)), A, 0.0)
    o_intra = jnp.einsum('bnhcs,bnshv->bnchv', A, v)
    b_last = b[:, :, -1:]
    kv = jnp.einsum('bnchk,bnchv->bnhkv', k * jnp.exp(b_last - b), v)
    decay = jnp.exp(b_last[:, :, 0])

    def step(S, inp):
        d, u = inp
        return S * d[..., None] + u, S

    _, S_prev = lax.scan(step, jnp.zeros((B_, H, K, V), f32),
                         (jnp.moveaxis(decay, 1, 0), jnp.moveaxis(kv, 1, 0)))
    S_prev = jnp.moveaxis(S_prev, 0, 1)
    o_inter = jnp.einsum('bnchk,bnhkv->bnchv', q * jnp.exp(b), S_prev)
    return (o_intra + o_inter).reshape(B_, T, H, V)


def _gla_branch(p, wa2_f, ba_f, wa2_b, ba_b, norm_g, proj):
    f32 = jnp.float32
    B_, T, _ = p.shape
    q, k, v, og, af, ab = _split(p, GLA_SPLITS)
    q = q.reshape(B_, T, GLA_HEADS, GLA_DK) * (GLA_DK ** -0.5)
    k = k.reshape(B_, T, GLA_HEADS, GLA_DK)
    v = v.reshape(B_, T, GLA_HEADS, GLA_DV)
    la_f = (jax.nn.log_sigmoid((af @ wa2_f + ba_f).astype(f32)) / GLA_LOGIT_NORM).reshape(B_, T, GLA_HEADS, GLA_DK)
    la_b = (jax.nn.log_sigmoid((ab @ wa2_b + ba_b).astype(f32)) / GLA_LOGIT_NORM).reshape(B_, T, GLA_HEADS, GLA_DK)
    flip = lambda t: jnp.flip(t, axis=1)
    o = _gla_chunked(q, k, v, la_f) + flip(_gla_chunked(flip(q), flip(k), flip(v), flip(la_b)))
    o = o * lax.rsqrt(jnp.mean(o * o, axis=-1, keepdims=True) + HEAD_NORM_EPS)
    o = (o.reshape(B_, T, GLA_V_W) * norm_g.astype(f32)).astype(p.dtype)
    o = o * jax.nn.silu(og)
    return o @ proj


def _rwkv7_step(S, inp):
    r, w, k, v, a, b = inp
    sa = jnp.einsum('bhvk,bhk->bhv', S, a)
    S = S * w[:, :, None, :] + sa[..., None] * b[:, :, None, :] + v[..., None] * k[:, :, None, :]
    y = jnp.einsum('bhvk,bhk->bhv', S, r)
    return S, y


def _rwkv_branch(p, mu_prev, mu_next, w0_f, w2_f, w0_b, w2_b, a0, a2, g2, k_k, k_a, r_k, ln_w, ln_b, proj):
    f32 = jnp.float32
    B_, T, _ = p.shape
    s = p + mu_prev * (_shift_prev(p) - p) + mu_next * (_shift_next(p) - p)
    r, k, v, wl, al, gl = _split(s, RWKV_SPLITS)
    tw = jnp.tanh(wl)

    def decay(w0, w2):
        w = -jax.nn.softplus(-(w0 + tw @ w2).astype(f32)) - 0.5
        return jnp.exp(-jnp.exp(w))

    a = jax.nn.sigmoid(a0 + al @ a2)
    g = jax.nn.sigmoid(gl) @ g2
    heads = lambda t: t.reshape(B_, T, RWKV_HEADS, RWKV_HEAD).astype(f32)
    kk = heads(k * k_k)
    kk = kk / jnp.maximum(jnp.sqrt(jnp.sum(kk * kk, axis=-1, keepdims=True)), 1e-12)
    k = k * (1.0 + (a - 1.0) * k_a)
    rh, kh, vh, ah = heads(r), heads(k), heads(v), heads(a)
    tm = lambda t: jnp.moveaxis(t, 1, 0)
    r_s, k_s, v_s, a_s, b_s = tm(rh), tm(kh), tm(vh), tm(-kk), tm(kk * ah)
    S0 = jnp.zeros((B_, RWKV_HEADS, RWKV_HEAD, RWKV_HEAD), f32)
    _, y_f = lax.scan(_rwkv7_step, S0, (r_s, tm(heads(decay(w0_f, w2_f))), k_s, v_s, a_s, b_s))
    _, y_b = lax.scan(_rwkv7_step, S0, (r_s, tm(heads(decay(w0_b, w2_b))), k_s, v_s, a_s, b_s), reverse=True)
    y = jnp.moveaxis(y_f + y_b, 0, 1)
    mu = jnp.mean(y, axis=-1, keepdims=True)
    var = jnp.mean(jnp.square(y - mu), axis=-1, keepdims=True)
    y = ((y - mu) * lax.rsqrt(var + RWKV_GN_EPS)).reshape(B_, T, RWKV_W) * ln_w.astype(f32) + ln_b.astype(f32)
    bonus = (jnp.sum(rh * kh * r_k.astype(f32), axis=-1, keepdims=True) * vh).reshape(B_, T, RWKV_W)
    o = (y + bonus).astype(p.dtype) * g
    return o @ proj


def setup_inputs(seed: int = 0) -> dict:
    key = jax.random.key(seed)
    ks = jax.random.split(key, 32)
    L, D = DEPTH, D_MODEL
    f32 = jnp.float32
    nrm = lambda k, shape, scale: jax.random.normal(k, shape, f32) * scale
    uni = lambda k, shape: jax.random.uniform(k, shape, f32, 0.0, 0.5)
    centre = jnp.array([0.0, 1.0, 0.0], f32)[None, :, None]
    return {
        "x": nrm(ks[0], (BATCH, SEQ, D), 1.0),
        "norm1_g": 1.0 + nrm(ks[1], (L, D), 0.02),
        "w_in": nrm(ks[2], (L, D, N_PROJ), D ** -0.5),
        "gla_wa2_f": nrm(ks[3], (L, GLA_GATE_RANK, GLA_QK_W), GLA_GATE_RANK ** -0.5),
        "gla_ba_f": 1.0 + nrm(ks[4], (L, GLA_QK_W), 0.5),
        "gla_wa2_b": nrm(ks[5], (L, GLA_GATE_RANK, GLA_QK_W), GLA_GATE_RANK ** -0.5),
        "gla_ba_b": 1.0 + nrm(ks[6], (L, GLA_QK_W), 0.5),
        "gla_norm_g": 1.0 + nrm(ks[7], (L, GLA_V_W), 0.02),
        "gla_proj": nrm(ks[8], (L, GLA_V_W, D), GLA_V_W ** -0.5),
        "rwkv_mu_prev": uni(ks[9], (L, RWKV_PROJ_W)),
        "rwkv_mu_next": uni(ks[10], (L, RWKV_PROJ_W)),
        "rwkv_w0_f": -1.0 + nrm(ks[11], (L, RWKV_W), 0.5),
        "rwkv_w2_f": nrm(ks[12], (L, RWKV_DECAY_LORA, RWKV_W), RWKV_DECAY_LORA ** -0.5),
        "rwkv_w0_b": -1.0 + nrm(ks[13], (L, RWKV_W), 0.5),
        "rwkv_w2_b": nrm(ks[14], (L, RWKV_DECAY_LORA, RWKV_W), RWKV_DECAY_LORA ** -0.5),
        "rwkv_a0": nrm(ks[15], (L, RWKV_W), 0.1),
        "rwkv_a2": nrm(ks[16], (L, RWKV_AAA_LORA, RWKV_W), RWKV_AAA_LORA ** -0.5),
        "rwkv_g2": nrm(ks[17], (L, RWKV_GATE_LORA, RWKV_W), RWKV_GATE_LORA ** -0.5),
        "rwkv_k_k": 0.85 + nrm(ks[18], (L, RWKV_W), 0.05),
        "rwkv_k_a": 1.0 + nrm(ks[19], (L, RWKV_W), 0.05),
        "rwkv_r_k": nrm(ks[20], (L, RWKV_HEADS, RWKV_HEAD), 0.1),
        "rwkv_ln_w": 1.0 + nrm(ks[21], (L, RWKV_W), 0.02),
        "rwkv_ln_b": nrm(ks[22], (L, RWKV_W), 0.02),
        "rwkv_proj": nrm(ks[23], (L, RWKV_W, D), RWKV_W ** -0.5),
        "w_out": nrm(ks[24], (L, D, D), D ** -0.5),
        "norm2_g": 1.0 + nrm(ks[25], (L, D), 0.02),
        "ffn_up": nrm(ks[26], (L, D, 2 * D_FF), D ** -0.5),
        "ffn_conv_w": centre + nrm(ks[27], (L, CONV_W, 2 * D_FF), 0.2),
        "ffn_conv_b": nrm(ks[28], (L, 2 * D_FF), 0.02),
        "ffn_down": nrm(ks[29], (L, D_FF, D), D_FF ** -0.5),
        "norm_f_g": 1.0 + nrm(ks[30], (D,), 0.02),
    }


def reference(x, norm1_g, w_in, gla_wa2_f, gla_ba_f, gla_wa2_b, gla_ba_b, gla_norm_g, gla_proj,
              rwkv_mu_prev, rwkv_mu_next, rwkv_w0_f, rwkv_w2_f, rwkv_w0_b, rwkv_w2_b, rwkv_a0, rwkv_a2,
              rwkv_g2, rwkv_k_k, rwkv_k_a, rwkv_r_k, rwkv_ln_w, rwkv_ln_b, rwkv_proj, w_out,
              norm2_g, ffn_up, ffn_conv_w, ffn_conv_b, ffn_down, norm_f_g):
    for l in range(DEPTH):
        h = _rmsnorm(x, norm1_g[l])
        p = h @ w_in[l]
        p_gla, p_rwkv, p_gate = jnp.split(p, [GLA_PROJ_W, GLA_PROJ_W + RWKV_PROJ_W], axis=-1)
        y_a = _gla_branch(p_gla, gla_wa2_f[l], gla_ba_f[l], gla_wa2_b[l], gla_ba_b[l],
                          gla_norm_g[l], gla_proj[l])
        y_b = _rwkv_branch(p_rwkv, rwkv_mu_prev[l], rwkv_mu_next[l], rwkv_w0_f[l], rwkv_w2_f[l],
                           rwkv_w0_b[l], rwkv_w2_b[l], rwkv_a0[l], rwkv_a2[l], rwkv_g2[l],
                           rwkv_k_k[l], rwkv_k_a[l], rwkv_r_k[l], rwkv_ln_w[l], rwkv_ln_b[l], rwkv_proj[l])
        gate_a, gate_b = jnp.split(p_gate, 2, axis=-1)
        merged = jax.nn.sigmoid(gate_a) * y_a + jax.nn.sigmoid(gate_b) * y_b
        x = x + merged @ w_out[l]
        h2 = _rmsnorm(x, norm2_g[l])
        u = h2 @ ffn_up[l]
        cw = ffn_conv_w[l]
        u = cw[0] * _shift_prev(u) + cw[1] * u + cw[2] * _shift_next(u) + ffn_conv_b[l]
        u_gate, u_val = jnp.split(u, 2, axis=-1)
        x = x + (jax.nn.silu(u_gate) * u_val) @ ffn_down[l]
    return _rmsnorm(x, norm_f_g)
```

```cpp
#include <hip/hip_runtime.h>
#include <hip/hip_cooperative_groups.h>
#include <cstdio>
#include <cstdint>
namespace cg = cooperative_groups;
#define N_PHASE_LAUNCH 0
#define FUSE_NORM2 0
namespace pg8 {
#define PG8_LAS __attribute__((address_space(3)))
typedef unsigned short bf16_t;
typedef short bf16x8 __attribute__((ext_vector_type(8)));
typedef float f32x4 __attribute__((ext_vector_type(4)));
typedef unsigned u32x4 __attribute__((ext_vector_type(4)));
constexpr int BM = 256, BK = 64, HALF = 128, HTB = HALF * BK * 2  , STAGE_BYTES = 8 * HTB, NXCD = 8, WGM = 8;

__host__ __device__ __forceinline__ int lds_byte(int r, int c) { const int st = (r >> 4) * 2 + (c >> 5), rr = r & 15, cc = c & 31, ob = rr * 64 + cc * 2; return st * 1024 + (ob ^ (((ob >> 9) & 1) << 5)); }
__host__ __device__ __forceinline__ void stage_rc(int b, int& R, int& C) { const int st = b / 1024, sb = b % 1024, swz = sb ^ (((sb >> 9) & 1) << 5); R = (st >> 1) * 16 + swz / 64; C = (st & 1) * 32 + (swz % 64) / 2; }
__host__ __device__ __forceinline__ int perm32(int rho) { const int n = rho >> 4, i = rho & 15; return 8 * (i >> 2) + 4 * n + (i & 3); }

struct Unit { int pm, pn; };
struct Gemm { const bf16_t* A; const bf16_t* Bt; int M, N, K; };

struct StaticOrder {
    int nM, nN, nwg, G, c;
    __host__ __device__ void init(int M, int N, int G_, int c_) { nM = M / BM; nN = N / BM; nwg = nM * nN; G = G_; c = c_; }
    __host__ __device__ bool next(int i, Unit& u) const {
        const long L = (long)i * G + c; if (L >= nwg) return false;
        int wgid = (int)L; { const int q = nwg / NXCD, r = nwg % NXCD, xcd = wgid % NXCD, off = wgid / NXCD; wgid = (xcd < r ? xcd * (q + 1) : r * (q + 1) + (xcd - r) * q) + off; }
        const int nig = WGM * nN, gid = wgid / nig, fm = gid * WGM, gsz = (nM - fm) < WGM ? (nM - fm) : WGM;
        u.pm = fm + ((wgid % nig) % gsz); u.pn = (wgid % nig) / gsz; return true;
    }
    __device__ __forceinline__ void a_ready(const Unit&) const {}
    __device__ __forceinline__ void done(const Unit&) const {}
};

__device__ __forceinline__ unsigned cvt_pk_bf16(float lo, float hi) { unsigned r; asm volatile("v_cvt_pk_bf16_f32 %0, %1, %2" : "=v"(r) : "v"(lo), "v"(hi)); return r; }

template <class Epi, class Sched, bool ALIGN_EPI = false, bool SP2 = false>
__device__ __forceinline__ void gemm_phase(PG8_LAS unsigned char* lds, const Gemm g, const Sched& S, const Epi& E) {
    const int tid = threadIdx.x, wid = __builtin_amdgcn_readfirstlane(tid >> 6), lane = tid & 63, wr = wid >> 2, wc = wid & 3, fr = lane & 15, fq = lane >> 4;
    const int K = g.K, nt = K / BK;
    unsigned voffA[2], voffB[2];
#pragma unroll
    for (int i = 0; i < 2; ++i) { int R, C; stage_rc(tid * 16 + i * 8192, R, C); const int Rb = Epi::PERM ? ((R & ~31) + perm32(R & 31)) : R;
        voffA[i] = (unsigned)(R * K + C) * 2u; voffB[i] = (unsigned)(Rb * K + C) * 2u; }
    const size_t kstep = (size_t)(BK * 2);
    const size_t hstep = (size_t)HALF * K * 2;
    const size_t tstep = 2 * hstep;
    const unsigned ldsw = (unsigned)wid * 1024u;
    const int aoff = lds_byte(wr * 64 + fr, fq * 8), boff = lds_byte(wc * 32 + fr, fq * 8);
#define PG8_SA(b, h) (((b) * 2 + (h)) * HTB)
#define PG8_SB(b, h) ((4 + (b) * 2 + (h)) * HTB)
#define PG8_STAGE(bufoff, gbase, voff) do { _Pragma("unroll") for (int _i = 0; _i < 2; ++_i) \
        __builtin_amdgcn_global_load_lds((const unsigned*)((const char*)(gbase) + (voff)[_i]), (PG8_LAS unsigned*)(lds + (bufoff) + ldsw + _i * 8192), 16, 0, 0); } while (0)
#define PG8_LDA(dst, b, h) do { _Pragma("unroll") for (int m = 0; m < 4; ++m) _Pragma("unroll") for (int k = 0; k < 2; ++k) dst[m][k] = *(const PG8_LAS bf16x8*)(lds + PG8_SA(b, h) + aoff + m * 2048 + k * 1024); } while (0)
#define PG8_LDB(dst, b, h) do { _Pragma("unroll") for (int n = 0; n < 2; ++n) _Pragma("unroll") for (int k = 0; k < 2; ++k) dst[n][k] = *(const PG8_LAS bf16x8*)(lds + PG8_SB(b, h) + boff + n * 2048 + k * 1024); } while (0)
#define PG8_MMA(ai, bj, At, Bt) do { __builtin_amdgcn_s_setprio(1); _Pragma("unroll") for (int m = 0; m < 4; ++m) _Pragma("unroll") for (int n = 0; n < 2; ++n) _Pragma("unroll") for (int k = 0; k < 2; ++k) \
        acc[ai][bj][m][n] = __builtin_amdgcn_mfma_f32_16x16x32_bf16(Bt[n][k], At[m][k], acc[ai][bj][m][n], 0, 0, 0); __builtin_amdgcn_s_setprio(0); } while (0)
#define PG8_WAIT_V(n) asm volatile("s_waitcnt vmcnt(" #n ")" ::: "memory")
#define PG8_WAIT_L(n) asm volatile("s_waitcnt lgkmcnt(" #n ")" ::: "memory")
#define PG8_BAR __builtin_amdgcn_s_barrier()
#define PG8_SCHED __builtin_amdgcn_sched_barrier(0)
    Unit cur, nxt; int ui = 0;
    if (!S.next(0, cur)) return;
    f32x4 acc[2][2][4][2];
#pragma unroll
    for (int a = 0; a < 2; ++a)
#pragma unroll
        for (int b = 0; b < 2; ++b)
#pragma unroll
            for (int m = 0; m < 4; ++m)
#pragma unroll
                for (int n = 0; n < 2; ++n) acc[a][b][m][n] = (f32x4){0.f, 0.f, 0.f, 0.f};
    bf16x8 At[4][2], B0[2][2], B1[2][2];
    const char* cA = (const char*)g.A + (size_t)cur.pm * tstep; const char* cB = (const char*)g.Bt + (size_t)cur.pn * tstep;
    S.a_ready(cur);
    if constexpr (SP2) {
        PG8_STAGE(PG8_SB(0, 0), cB, voffB); PG8_STAGE(PG8_SB(0, 1), cB + hstep, voffB); PG8_STAGE(PG8_SA(0, 0), cA, voffA); PG8_STAGE(PG8_SA(0, 1), cA + hstep, voffA);
        if (wr == 1) PG8_BAR;
        PG8_WAIT_V(2); PG8_BAR;
        PG8_STAGE(PG8_SB(1, 0), cB + kstep, voffB); PG8_STAGE(PG8_SA(1, 0), cA + kstep, voffA); PG8_STAGE(PG8_SB(1, 1), cB + hstep + kstep, voffB);
        PG8_WAIT_V(6); PG8_BAR;
    } else {
        PG8_STAGE(PG8_SB(0, 0), cB, voffB); PG8_STAGE(PG8_SA(0, 0), cA, voffA); PG8_STAGE(PG8_SB(0, 1), cB + hstep, voffB); PG8_STAGE(PG8_SA(0, 1), cA + hstep, voffA);
        if (wr == 1) PG8_BAR;
        PG8_WAIT_V(4); PG8_BAR;
        PG8_STAGE(PG8_SB(1, 0), cB + kstep, voffB); PG8_STAGE(PG8_SA(1, 0), cA + kstep, voffA); PG8_STAGE(PG8_SB(1, 1), cB + hstep + kstep, voffB);
        PG8_WAIT_V(6); PG8_BAR;
    }
    for (;;) {
        const bool has_next = S.next(ui + 1, nxt);
        const char* nA = has_next ? (const char*)g.A + (size_t)nxt.pm * tstep : cA; const char* nB = has_next ? (const char*)g.Bt + (size_t)nxt.pn * tstep : cB;
        for (int t = 0; t < nt; t += 2) {
            if constexpr (Epi::MID) { if (t == (nt >> 1)) {
                __builtin_amdgcn_sched_barrier(0); asm volatile("s_nop 7\n\ts_nop 7" ::: "memory"); __builtin_amdgcn_sched_barrier(0);
                E.mid(acc, cur, wr, wc, fr, fq);
                __builtin_amdgcn_sched_barrier(0); asm volatile("s_nop 7" ::: "memory"); __builtin_amdgcn_sched_barrier(0); } }
            const bool last = (t == nt - 2);
            const char* a1 = cA + (size_t)(t + 1) * kstep;
            const char* a2 = last ? nA : cA + (size_t)(t + 2) * kstep; const char* b2 = last ? nB : cB + (size_t)(t + 2) * kstep;
            const char* a3 = a2 + kstep; const char* b3 = b2 + kstep;
            if (last && has_next) S.a_ready(nxt);
            if constexpr (SP2) {
            PG8_LDB(B0, 0, 0); PG8_LDB(B1, 0, 1); PG8_SCHED; PG8_LDA(At, 0, 0); PG8_STAGE(PG8_SA(1, 1), a1 + hstep, voffA);
            PG8_WAIT_V(8); PG8_WAIT_L(0); PG8_BAR; PG8_MMA(0, 0, At, B0); PG8_MMA(0, 1, At, B1); PG8_BAR; PG8_SCHED;
            PG8_LDA(At, 0, 1); PG8_STAGE(PG8_SB(0, 0), b2, voffB); PG8_STAGE(PG8_SB(0, 1), b2 + hstep, voffB); PG8_STAGE(PG8_SA(0, 0), a2, voffA);
            PG8_WAIT_V(8); PG8_WAIT_L(0); PG8_BAR; PG8_MMA(1, 0, At, B0); PG8_MMA(1, 1, At, B1); PG8_BAR; PG8_SCHED;
            PG8_LDB(B0, 1, 0); PG8_LDB(B1, 1, 1); PG8_SCHED; PG8_LDA(At, 1, 0); PG8_STAGE(PG8_SA(0, 1), a2 + hstep, voffA);
            PG8_WAIT_V(8); PG8_WAIT_L(0); PG8_BAR; PG8_MMA(0, 0, At, B0); PG8_MMA(0, 1, At, B1); PG8_BAR; PG8_SCHED;
            PG8_LDA(At, 1, 1); PG8_STAGE(PG8_SB(1, 0), b3, voffB); PG8_STAGE(PG8_SB(1, 1), b3 + hstep, voffB); PG8_STAGE(PG8_SA(1, 0), a3, voffA);
            PG8_WAIT_V(8); PG8_WAIT_L(0); PG8_BAR; PG8_MMA(1, 0, At, B0); PG8_MMA(1, 1, At, B1); PG8_BAR; PG8_SCHED;
            } else {
            PG8_LDB(B0, 0, 0); PG8_SCHED; PG8_LDA(At, 0, 0); PG8_STAGE(PG8_SA(1, 1), a1 + hstep, voffA);
            PG8_WAIT_L(8); PG8_BAR; PG8_WAIT_L(0); PG8_MMA(0, 0, At, B0); PG8_BAR; PG8_SCHED;
            PG8_LDB(B1, 0, 1); PG8_STAGE(PG8_SB(0, 0), b2, voffB);
            PG8_BAR; PG8_WAIT_L(0); PG8_MMA(0, 1, At, B1); PG8_BAR;
            PG8_LDA(At, 0, 1); PG8_STAGE(PG8_SA(0, 0), a2, voffA);
            PG8_BAR; PG8_WAIT_L(0); PG8_MMA(1, 0, At, B0); PG8_BAR; PG8_SCHED;
            PG8_STAGE(PG8_SB(0, 1), b2 + hstep, voffB);
            PG8_WAIT_V(6); PG8_BAR; PG8_MMA(1, 1, At, B1); PG8_BAR;
            PG8_LDB(B0, 1, 0); PG8_SCHED; PG8_LDA(At, 1, 0); PG8_STAGE(PG8_SA(0, 1), a2 + hstep, voffA);
            PG8_WAIT_L(8); PG8_BAR; PG8_WAIT_L(0); PG8_MMA(0, 0, At, B0); PG8_BAR; PG8_SCHED;
            PG8_LDB(B1, 1, 1); PG8_STAGE(PG8_SB(1, 0), b3, voffB);
            PG8_BAR; PG8_WAIT_L(0); PG8_MMA(0, 1, At, B1); PG8_BAR;
            PG8_LDA(At, 1, 1); PG8_STAGE(PG8_SA(1, 0), a3, voffA);
            PG8_BAR; PG8_WAIT_L(0); PG8_MMA(1, 0, At, B0); PG8_BAR; PG8_SCHED;
            PG8_STAGE(PG8_SB(1, 1), b3 + hstep, voffB);
            PG8_WAIT_V(6); PG8_BAR; PG8_MMA(1, 1, At, B1); PG8_BAR;
            }
        }
        if constexpr (ALIGN_EPI) { if (wr == 0) PG8_BAR; }
        __builtin_amdgcn_sched_barrier(0); asm volatile("s_nop 7\n\ts_nop 7" ::: "memory"); __builtin_amdgcn_sched_barrier(0);
        if constexpr (!Epi::AFTER_DRAIN) { E(acc, cur, wr, wc, fr, fq); S.done(cur); }
        if (!has_next) break;
#pragma unroll
        for (int a = 0; a < 2; ++a)
#pragma unroll
            for (int b = 0; b < 2; ++b)
#pragma unroll
                for (int m = 0; m < 4; ++m)
#pragma unroll
                    for (int n = 0; n < 2; ++n) acc[a][b][m][n] = (f32x4){0.f, 0.f, 0.f, 0.f};
        cur = nxt; cA = nA; cB = nB; ++ui;
        if constexpr (ALIGN_EPI) { if (wr == 1) PG8_BAR; }
    }
    PG8_WAIT_V(0);
    if constexpr (!ALIGN_EPI) { if (wr == 0) PG8_BAR; }
    PG8_BAR;
    if constexpr (Epi::AFTER_DRAIN) { E.fused(acc, cur, wr, wc, fr, fq, lds, wid, lane); S.done(cur); }
#undef PG8_SA
#undef PG8_SB
#undef PG8_STAGE
#undef PG8_LDA
#undef PG8_LDB
#undef PG8_MMA
#undef PG8_WAIT_V
#undef PG8_WAIT_L
#undef PG8_BAR
#undef PG8_SCHED
}
}

#ifndef PG8_SP2
#define PG8_SP2 true
#endif
#ifndef PG8_ALIGN
#define PG8_ALIGN true
#endif
namespace pg8 {
typedef unsigned u32x2 __attribute__((ext_vector_type(2)));
__device__ __forceinline__ float bfl(unsigned w) { return __uint_as_float(w << 16); }
__device__ __forceinline__ float bfh(unsigned w) { return __uint_as_float(w & 0xffff0000u); }
__device__ __forceinline__ float sigm(float x) { return __builtin_amdgcn_rcpf(1.0f + __expf(-x)); }
struct EpiStore {
    static constexpr bool PERM = true, AFTER_DRAIN = false, MID = false;
    bf16_t* O; int ldc; int nvalid; int split_cols; bf16_t* O2;
    __device__ __forceinline__ void operator()(const f32x4 (&acc)[2][2][4][2], const Unit& u, int wr, int wc, int fr, int fq) const {
        const int row0 = u.pm * BM + wr * 64 + fr; int colt = u.pn * BM; bf16_t* base = O;
        if (split_cols && colt >= split_cols) { base = O2; colt -= split_cols; }
        const int col0 = colt + wc * 32 + 8 * fq;
#pragma unroll
        for (int ai = 0; ai < 2; ++ai)
#pragma unroll
            for (int m = 0; m < 4; ++m) { bf16_t* rowp = base + (size_t)(row0 + ai * HALF + m * 16) * ldc + col0;
#pragma unroll
                for (int bj = 0; bj < 2; ++bj) { const f32x4 v0 = acc[ai][bj][m][0], v1 = acc[ai][bj][m][1];
                    u32x4 w; w.x = cvt_pk_bf16(v0[0], v0[1]); w.y = cvt_pk_bf16(v0[2], v0[3]); w.z = cvt_pk_bf16(v1[0], v1[1]); w.w = cvt_pk_bf16(v1[2], v1[3]);
                    if (col0 + bj * HALF + 8 <= nvalid) *(u32x4*)(rowp + bj * HALF) = w; } }
    }
};
template <int MODE> struct EpiGate {
    static constexpr bool PERM = true, AFTER_DRAIN = false, MID = false;
    const bf16_t* G; bf16_t* O; int ldc;
    __device__ __forceinline__ void operator()(const f32x4 (&acc)[2][2][4][2], const Unit& u, int wr, int wc, int fr, int fq) const {
        const int row0 = u.pm * BM + wr * 64 + fr; const int col0 = u.pn * BM + wc * 32 + 8 * fq;
#pragma unroll
        for (int ai = 0; ai < 2; ++ai)
#pragma unroll
            for (int m = 0; m < 4; ++m) { const size_t off = (size_t)(row0 + ai * HALF + m * 16) * ldc + col0;
#pragma unroll
                for (int bj = 0; bj < 2; ++bj) { const f32x4 v0 = acc[ai][bj][m][0], v1 = acc[ai][bj][m][1];
                    const u32x4 g = *(const u32x4*)(G + off + bj * HALF);
                    float r0 = sigm(bfl(g.x)) * v0[0], r1 = sigm(bfh(g.x)) * v0[1], r2 = sigm(bfl(g.y)) * v0[2], r3 = sigm(bfh(g.y)) * v0[3];
                    float r4 = sigm(bfl(g.z)) * v1[0], r5 = sigm(bfh(g.z)) * v1[1], r6 = sigm(bfl(g.w)) * v1[2], r7 = sigm(bfh(g.w)) * v1[3];
                    if (MODE == 1) { const u32x4 p = *(const u32x4*)(O + off + bj * HALF);
                        r0 += bfl(p.x); r1 += bfh(p.x); r2 += bfl(p.y); r3 += bfh(p.y); r4 += bfl(p.z); r5 += bfh(p.z); r6 += bfl(p.w); r7 += bfh(p.w); }
                    u32x4 w; w.x = cvt_pk_bf16(r0, r1); w.y = cvt_pk_bf16(r2, r3); w.z = cvt_pk_bf16(r4, r5); w.w = cvt_pk_bf16(r6, r7);
                    *(u32x4*)(O + off + bj * HALF) = w; } }
    }
};
struct EpiMerge {
    static constexpr bool PERM = true, AFTER_DRAIN = false, MID = true;
    const bf16_t* GA; const bf16_t* GB; bf16_t* O; int ldc;
    template <bool DIV> __device__ __forceinline__ void scale_pass(f32x4 (&acc)[2][2][4][2], const bf16_t* G, const Unit& u, int wr, int wc, int fr, int fq) const {
        const int row0 = u.pm * BM + wr * 64 + fr; const int col0 = u.pn * BM + wc * 32 + 8 * fq;
#pragma unroll
        for (int ai = 0; ai < 2; ++ai)
#pragma unroll
            for (int m = 0; m < 4; ++m) { const size_t off = (size_t)(row0 + ai * HALF + m * 16) * ldc + col0;
#pragma unroll
                for (int bj = 0; bj < 2; ++bj) { const u32x4 g = *(const u32x4*)(G + off + bj * HALF);
                    f32x4 r0, r1;
                    r0[0] = 1.f + __expf(-bfl(g.x)); r0[1] = 1.f + __expf(-bfh(g.x)); r0[2] = 1.f + __expf(-bfl(g.y)); r0[3] = 1.f + __expf(-bfh(g.y));
                    r1[0] = 1.f + __expf(-bfl(g.z)); r1[1] = 1.f + __expf(-bfh(g.z)); r1[2] = 1.f + __expf(-bfl(g.w)); r1[3] = 1.f + __expf(-bfh(g.w));
                    if (DIV) {
#pragma unroll
                        for (int i = 0; i < 4; ++i) { r0[i] = __builtin_amdgcn_rcpf(r0[i]); r1[i] = __builtin_amdgcn_rcpf(r1[i]); } }
                    acc[ai][bj][m][0] = acc[ai][bj][m][0] * r0; acc[ai][bj][m][1] = acc[ai][bj][m][1] * r1;
                    asm volatile("" ::: "memory"); } }
    }
    __device__ __forceinline__ void mid(f32x4 (&acc)[2][2][4][2], const Unit& u, int wr, int wc, int fr, int fq) const {
        scale_pass<false>(acc, GB, u, wr, wc, fr, fq); scale_pass<true>(acc, GA, u, wr, wc, fr, fq);
    }
    __device__ __forceinline__ void operator()(const f32x4 (&acc)[2][2][4][2], const Unit& u, int wr, int wc, int fr, int fq) const {
        const int row0 = u.pm * BM + wr * 64 + fr; const int col0 = u.pn * BM + wc * 32 + 8 * fq;
#pragma unroll
        for (int ai = 0; ai < 2; ++ai)
#pragma unroll
            for (int m = 0; m < 4; ++m) { const size_t off = (size_t)(row0 + ai * HALF + m * 16) * ldc + col0;
#pragma unroll
                for (int bj = 0; bj < 2; ++bj) { const f32x4 v0 = acc[ai][bj][m][0], v1 = acc[ai][bj][m][1];
                    const u32x4 g = *(const u32x4*)(GB + off + bj * HALF);
                    u32x4 w; w.x = cvt_pk_bf16(sigm(bfl(g.x)) * v0[0], sigm(bfh(g.x)) * v0[1]); w.y = cvt_pk_bf16(sigm(bfl(g.y)) * v0[2], sigm(bfh(g.y)) * v0[3]);
                    w.z = cvt_pk_bf16(sigm(bfl(g.z)) * v1[0], sigm(bfh(g.z)) * v1[1]); w.w = cvt_pk_bf16(sigm(bfl(g.w)) * v1[2], sigm(bfh(g.w)) * v1[3]);
                    *(u32x4*)(O + off + bj * HALF) = w; } }
    }
};
struct EpiRes {
    static constexpr bool PERM = false, AFTER_DRAIN = false, MID = false;
    const float* base; float* out; int ldc;
    __device__ __forceinline__ void operator()(const f32x4 (&acc)[2][2][4][2], const Unit& u, int wr, int wc, int fr, int fq) const {
        const int row0 = u.pm * BM + wr * 64 + fr; const int col0 = u.pn * BM + wc * 32 + 4 * fq;
#pragma unroll
        for (int ai = 0; ai < 2; ++ai)
#pragma unroll
            for (int m = 0; m < 4; ++m) { const size_t off = (size_t)(row0 + ai * HALF + m * 16) * ldc + col0;
#pragma unroll
                for (int bj = 0; bj < 2; ++bj)
#pragma unroll
                    for (int n = 0; n < 2; ++n) { const f32x4 b = *(const f32x4*)(base + off + bj * HALF + n * 16); *(f32x4*)(out + off + bj * HALF + n * 16) = b + acc[ai][bj][m][n]; } }
    }
};

struct EpiResBf16 {
    static constexpr bool PERM = false, AFTER_DRAIN = false, MID = false;
    const float* base; bf16_t* out; int ldc;
    __device__ __forceinline__ void operator()(const f32x4 (&acc)[2][2][4][2], const Unit& u, int wr, int wc, int fr, int fq) const {
        const int row0 = u.pm * BM + wr * 64 + fr; const int col0 = u.pn * BM + wc * 32 + 4 * fq;
#pragma unroll
        for (int ai = 0; ai < 2; ++ai)
#pragma unroll
            for (int m = 0; m < 4; ++m) { const size_t off = (size_t)(row0 + ai * HALF + m * 16) * ldc + col0;
#pragma unroll
                for (int bj = 0; bj < 2; ++bj)
#pragma unroll
                    for (int n = 0; n < 2; ++n) { const f32x4 x = *(const f32x4*)(base + off + bj * HALF + n * 16) + acc[ai][bj][m][n];
                        u32x2 w; w.x = cvt_pk_bf16(x[0], x[1]); w.y = cvt_pk_bf16(x[2], x[3]); *(u32x2*)(out + off + bj * HALF + n * 16) = w; } }
    }
};
struct EpiResNorm {
    static constexpr bool PERM = false, AFTER_DRAIN = false, MID = false;
    const float* base; float* out; bf16_t* H; const float* g; float* SS; int ldc;
    __device__ __forceinline__ void operator()(const f32x4 (&acc)[2][2][4][2], const Unit& u, int wr, int wc, int fr, int fq) const {
        const int row0 = u.pm * BM + wr * 64 + fr; const int col0 = u.pn * BM + wc * 32 + 4 * fq;
#pragma unroll
        for (int ai = 0; ai < 2; ++ai)
#pragma unroll
            for (int m = 0; m < 4; ++m) { const int row = row0 + ai * HALF + m * 16; const size_t off = (size_t)row * ldc + col0; float ss = 0.f;
#pragma unroll
                for (int bj = 0; bj < 2; ++bj)
#pragma unroll
                    for (int n = 0; n < 2; ++n) { const f32x4 x1 = *(const f32x4*)(base + off + bj * HALF + n * 16) + acc[ai][bj][m][n]; *(f32x4*)(out + off + bj * HALF + n * 16) = x1;
                        ss += (x1[0] * x1[0] + x1[1] * x1[1]) + (x1[2] * x1[2] + x1[3] * x1[3]);
                        const f32x4 hh = x1 * *(const f32x4*)(g + col0 + bj * HALF + n * 16);
                        u32x2 w; w.x = cvt_pk_bf16(hh[0], hh[1]); w.y = cvt_pk_bf16(hh[2], hh[3]); *(u32x2*)(H + off + bj * HALF + n * 16) = w; }
                ss += __shfl_xor(ss, 16); ss += __shfl_xor(ss, 32);
                if (fq == 0) (void)__hip_atomic_fetch_add(SS + row, ss, __ATOMIC_RELAXED, __HIP_MEMORY_SCOPE_AGENT); }
    }
};
__device__ __forceinline__ f32x4 dpp_shr1(f32x4 v) { f32x4 r;
#pragma unroll
    for (int i = 0; i < 4; ++i) { const float t = v[i]; r[i] = __int_as_float(__builtin_amdgcn_update_dpp(0, __float_as_int(t), 0x111, 0xF, 0xF, true)); }
    return r; }
__device__ __forceinline__ f32x4 dpp_shl1(f32x4 v) { f32x4 r;
#pragma unroll
    for (int i = 0; i < 4; ++i) { const float t = v[i]; r[i] = __int_as_float(__builtin_amdgcn_update_dpp(0, __float_as_int(t), 0x101, 0xF, 0xF, true)); }
    return r; }
__device__ __forceinline__ f32x4 dpp_mirror(f32x4 v) { f32x4 r;
#pragma unroll
    for (int i = 0; i < 4; ++i) { const float t = v[i]; r[i] = __int_as_float(__builtin_amdgcn_update_dpp(0, __float_as_int(t), 0x140, 0xF, 0xF, true)); }
    return r; }
struct EpiConv {
    static constexpr bool PERM = true, AFTER_DRAIN = false, MID = false;
    bf16_t* ACT; float* SB; const float* cw; const float* cb; PG8_LAS float* xe; bf16_t* Udbg; const float* SS;
    __device__ __forceinline__ void operator()(const f32x4 (&acc)[2][2][4][2], const Unit& u, int wr, int wc, int fr, int fq) const {
        constexpr int FF = 2752, FFP = 2816, NSRC = 5504, NU = 5632;
        if (SS) {
            f32x4 (&sa)[2][2][4][2] = const_cast<f32x4 (&)[2][2][4][2]>(acc);
#pragma unroll
            for (int ai = 0; ai < 2; ++ai)
#pragma unroll
                for (int m = 0; m < 4; ++m) { const float q = __hip_atomic_load(SS + u.pm * BM + ai * HALF + wr * 64 + m * 16 + fr, __ATOMIC_RELAXED, __HIP_MEMORY_SCOPE_AGENT);
                    const float rs = 1.0f / sqrtf(q * (1.0f / 1024.0f) + 1e-6f);
#pragma unroll
                    for (int bj = 0; bj < 2; ++bj)
#pragma unroll
                        for (int n = 0; n < 2; ++n) sa[ai][bj][m][n] = sa[ai][bj][m][n] * rs; } }
#pragma unroll
        for (int ai = 0; ai < 2; ++ai) { const int slab = 2 * ai + wr;
#pragma unroll
            for (int bj = 0; bj < 2; ++bj)
#pragma unroll
                for (int n = 0; n < 2; ++n) {
                    if (fr == 0) *(PG8_LAS f32x4*)(xe + ((slab * 2 + 0) * 4 + wc) * 64 + bj * 32 + fq * 8 + n * 4) = acc[ai][bj][0][n];
                    if (fr == 15) *(PG8_LAS f32x4*)(xe + ((slab * 2 + 1) * 4 + wc) * 64 + bj * 32 + fq * 8 + n * 4) = acc[ai][bj][3][n]; } }
        if (Udbg && u.pm < 128) { const int row0 = u.pm * BM + wr * 64 + fr, col0 = u.pn * BM + wc * 32 + 8 * fq;
#pragma unroll
            for (int ai = 0; ai < 2; ++ai)
#pragma unroll
                for (int m = 0; m < 4; ++m)
#pragma unroll
                    for (int bj = 0; bj < 2; ++bj) { const f32x4 v0 = acc[ai][bj][m][0], v1 = acc[ai][bj][m][1]; u32x4 w; w.x = cvt_pk_bf16(v0[0], v0[1]); w.y = cvt_pk_bf16(v0[2], v0[3]); w.z = cvt_pk_bf16(v1[0], v1[1]); w.w = cvt_pk_bf16(v1[2], v1[3]);
                        *(u32x4*)(Udbg + (size_t)(row0 + ai * HALF + m * 16) * NU + col0 + bj * HALF) = w; } }
        { const int colb = u.pn * BM + wc * 32 + 8 * fq;
          if (wr == 0 && fr < 2) {
#pragma unroll
              for (int bj = 0; bj < 2; ++bj)
#pragma unroll
                  for (int n = 0; n < 2; ++n) *(f32x4*)(SB + (size_t)(u.pm * 4 + fr) * NU + colb + bj * HALF + 4 * n) = acc[0][bj][0][n]; }
          if (wr == 1 && fr >= 14) {
#pragma unroll
              for (int bj = 0; bj < 2; ++bj)
#pragma unroll
                  for (int n = 0; n < 2; ++n) *(f32x4*)(SB + (size_t)(u.pm * 4 + 2 + (fr - 14)) * NU + colb + bj * HALF + 4 * n) = acc[1][bj][3][n]; } }
        asm volatile("s_waitcnt lgkmcnt(0)" ::: "memory"); __builtin_amdgcn_s_barrier(); asm volatile("" ::: "memory");
        const int j0 = u.pn * 128 + wc * 32 + fq * 8;
        const f32x4 z4 = (f32x4){0.f, 0.f, 0.f, 0.f};
#pragma unroll
        for (int n = 0; n < 2; ++n) { const int jn = j0 + 4 * n; const bool valid = jn < FF;
            f32x4 wg0 = z4, wg1 = z4, wg2 = z4, wv0 = z4, wv1 = z4, wv2 = z4, bg = z4, bv = z4;
            if (valid) { wg0 = *(const f32x4*)(cw + jn); wg1 = *(const f32x4*)(cw + NSRC + jn); wg2 = *(const f32x4*)(cw + 2 * NSRC + jn);
                         wv0 = *(const f32x4*)(cw + FF + jn); wv1 = *(const f32x4*)(cw + NSRC + FF + jn); wv2 = *(const f32x4*)(cw + 2 * NSRC + FF + jn);
                         bg = *(const f32x4*)(cb + jn); bv = *(const f32x4*)(cb + FF + jn); }
#pragma unroll
            for (int ai = 0; ai < 2; ++ai) { const int slab = 2 * ai + wr;
                f32x4 topg = z4, topv = z4, botg = z4, botv = z4;
                if (slab > 0) { topg = *(const PG8_LAS f32x4*)(xe + (((slab - 1) * 2 + 1) * 4 + wc) * 64 + fq * 8 + n * 4); topv = *(const PG8_LAS f32x4*)(xe + (((slab - 1) * 2 + 1) * 4 + wc) * 64 + 32 + fq * 8 + n * 4); }
                if (slab < 3) { botg = *(const PG8_LAS f32x4*)(xe + (((slab + 1) * 2 + 0) * 4 + wc) * 64 + fq * 8 + n * 4); botv = *(const PG8_LAS f32x4*)(xe + (((slab + 1) * 2 + 0) * 4 + wc) * 64 + 32 + fq * 8 + n * 4); }
#pragma unroll
                for (int m = 0; m < 4; ++m) { const f32x4 eg = acc[ai][0][m][n], ev = acc[ai][1][m][n];
                    f32x4 upg = dpp_shr1(eg), upv = dpp_shr1(ev), dng = dpp_shl1(eg), dnv = dpp_shl1(ev);
                    const f32x4 ag = (m > 0) ? dpp_mirror(acc[ai][0][m > 0 ? m - 1 : 0][n]) : topg, av = (m > 0) ? dpp_mirror(acc[ai][1][m > 0 ? m - 1 : 0][n]) : topv;
                    const f32x4 cg2 = (m < 3) ? dpp_mirror(acc[ai][0][m < 3 ? m + 1 : 3][n]) : botg, cv2 = (m < 3) ? dpp_mirror(acc[ai][1][m < 3 ? m + 1 : 3][n]) : botv;
                    if (fr == 0) { upg = ag; upv = av; }
                    if (fr == 15) { dng = cg2; dnv = cv2; }
                    const f32x4 g = wg0 * upg + wg1 * eg + wg2 * dng + bg, v = wv0 * upv + wv1 * ev + wv2 * dnv + bv;
                    f32x4 o;
#pragma unroll
                    for (int i = 0; i < 4; ++i) o[i] = valid ? g[i] * sigm(g[i]) * v[i] : 0.f;
                    const int rt = ai * HALF + wr * 64 + m * 16 + fr;
                    if (rt != 0 && rt != 255) { u32x2 w; w.x = cvt_pk_bf16(o[0], o[1]); w.y = cvt_pk_bf16(o[2], o[3]); *(u32x2*)(ACT + (size_t)(u.pm * BM + rt) * FFP + jn) = w; } } }
        }
    }
};
}

constexpr int NB = 32, T = 2048, D = 1024, M = NB * T, MH = M / 2;
constexpr int NMIX = 3360, NMIXP = 3584, NGATE = 2048;
constexpr int DFF = 2752, DFFP = 2816, NUP = 5632, NUPSRC = 5504, NPROJ = 5408;
constexpr int C_GQ = 0, C_GK = 256, C_GV = 512, C_GOG = 1024, C_GAF = 1536, C_GAB = 1552, C_R0 = 1568;
constexpr size_t MiB = 1u << 20;
constexpr size_t WS_WMIX = 1 * MiB, WS_WGATE = 8 * MiB, WS_WGP = 12 * MiB, WS_WRP = 13 * MiB, WS_WOUT = 14 * MiB, WS_WUP = 16 * MiB, WS_WDN = 27 * MiB;
constexpr size_t WS_LW2F = 33 * MiB, WS_LW2B = WS_LW2F + 65536, WS_LA2 = WS_LW2B + 65536, WS_LG2 = WS_LA2 + 65536;
constexpr size_t WS_HB = 36 * MiB, WS_PM = 164 * MiB, WS_GO = 584 * MiB, WS_O = 712 * MiB, WS_E = 840 * MiB, WS_BON = 968 * MiB, WS_END = 970 * MiB;
constexpr size_t WS_H2 = 256 * MiB;
constexpr size_t WS_U = WS_PM, WS_SB = WS_PM, WS_ACT = 516 * MiB, WS_X2 = 36 * MiB;
static_assert(WS_WDN + (size_t)D * DFFP * 2 <= WS_LW2F && WS_LG2 + 131072 <= WS_HB, "weights map");
static_assert(WS_PM + (size_t)M * NMIX * 2 <= WS_GO && WS_U + (size_t)MH * NUP * 2 <= WS_ACT && WS_ACT + (size_t)M * DFFP * 2 <= 1024 * MiB, "ws map");
constexpr int LDS_BYTES = 147456;

#define LAS __attribute__((address_space(3)))
#define DI __device__ __forceinline__
typedef unsigned short bf16;
typedef float f32x4 __attribute__((ext_vector_type(4)));
typedef float f32x2 __attribute__((ext_vector_type(2)));
typedef short bf16x8 __attribute__((ext_vector_type(8)));
typedef unsigned u32x4 __attribute__((ext_vector_type(4)));
typedef unsigned u32x2 __attribute__((ext_vector_type(2)));
typedef _Float16 h16x2 __attribute__((ext_vector_type(2)));
#define LDS_WAIT() asm volatile("s_waitcnt lgkmcnt(0)" ::: "memory")
#define LDS_BARRIER() do { asm volatile("s_waitcnt lgkmcnt(0)" ::: "memory"); __builtin_amdgcn_s_barrier(); asm volatile("" ::: "memory"); } while (0)
#define MFMA16(a, b, c) __builtin_amdgcn_mfma_f32_16x16x32_bf16((a), (b), (c), 0, 0, 0)
#define MFMA_GUARD(v) asm volatile("s_nop 7\n\ts_nop 7" : "+v"(v))

struct Params {
    const float* in[31]; float* out; unsigned char* ws;
};
enum { I_X = 0, I_N1G, I_WIN, I_GWA2F, I_GBAF, I_GWA2B, I_GBAB, I_GNG, I_GPROJ, I_MUP, I_MUN, I_W0F, I_W2F, I_W0B, I_W2B, I_A0, I_A2, I_G2, I_KK, I_KA, I_RK, I_LNW, I_LNB, I_RPROJ,
       I_WOUT, I_N2G, I_FUP, I_FCW, I_FCB, I_FDN, I_NFG };

DI float bfl(unsigned w) { return __uint_as_float(w << 16); }
DI float bfh(unsigned w) { return __uint_as_float(w & 0xffff0000u); }
DI unsigned f2bf(float f) { unsigned u = __float_as_uint(f); return (u + 0x7fffu + ((u >> 16) & 1u)) >> 16; }
typedef __bf16 bf16x2_t __attribute__((ext_vector_type(2)));
DI unsigned pk2(float lo, float hi) { const f32x2 v = {lo, hi}; const bf16x2_t b = __builtin_convertvector(v, bf16x2_t); return __builtin_bit_cast(unsigned, b); }
DI float sigm(float x) { return __builtin_amdgcn_rcpf(1.0f + __expf(-x)); }
DI unsigned pkh2(float lo, float hi) { h16x2 v; v.x = (_Float16)lo; v.y = (_Float16)hi; return __builtin_bit_cast(unsigned, v); }
DI float hlo(unsigned w) { h16x2 v = __builtin_bit_cast(h16x2, w); return (float)v.x; }
DI float hhi(unsigned w) { h16x2 v = __builtin_bit_cast(h16x2, w); return (float)v.y; }
DI float wave_sum(float v) {
#pragma unroll
    for (int o = 1; o < 64; o <<= 1) v += __shfl_xor(v, o);
    return v;
}
DI float quad_sum(float x) {
    x += __builtin_bit_cast(float, __builtin_amdgcn_update_dpp(0, __builtin_bit_cast(int, x), 0xB1, 0xF, 0xF, true));
    x += __builtin_bit_cast(float, __builtin_amdgcn_update_dpp(0, __builtin_bit_cast(int, x), 0x4E, 0xF, 0xF, true));
    return x;
}
DI float oct_sum(float x) {
    x = quad_sum(x);
    x += __builtin_bit_cast(float, __builtin_amdgcn_update_dpp(0, __builtin_bit_cast(int, x), 0x141, 0xF, 0xF, true));
    return x;
}
struct F8 { f32x4 a, b; };
DI F8 unpack8(u32x4 w) { F8 r; r.a = (f32x4){bfl(w.x), bfh(w.x), bfl(w.y), bfh(w.y)}; r.b = (f32x4){bfl(w.z), bfh(w.z), bfl(w.w), bfh(w.w)}; return r; }
DI u32x4 pack8(f32x4 a, f32x4 b) { u32x4 w; w.x = pk2(a[0], a[1]); w.y = pk2(a[2], a[3]); w.z = pk2(b[0], b[1]); w.w = pk2(b[2], b[3]); return w; }
DI f32x4 unpack4(u32x2 w) { return (f32x4){bfl(w.x), bfh(w.x), bfl(w.y), bfh(w.y)}; }
DI u32x2 pack4(f32x4 a) { u32x2 w; w.x = pk2(a[0], a[1]); w.y = pk2(a[2], a[3]); return w; }

DI void tr_item(const float* W, int ldw, int k0, int c0, bf16* WT, int ldt, int n0, LAS float* scr, int lane) {
    const int c = lane & 7;
    if (c0 < 0) {
#pragma unroll
        for (int j = 0; j < 4; ++j) { const int n = (lane >> 3) + 8 * j; *(u32x4*)(WT + (size_t)(n0 + n) * ldt + k0 + 8 * c) = (u32x4){0u, 0u, 0u, 0u}; }
        return;
    }
#pragma unroll 8
    for (int i = 0; i < 32; ++i) { const int kk = 2 * i + (lane >> 5); scr[kk * 33 + (lane & 31)] = W[(size_t)(k0 + kk) * ldw + c0 + (lane & 31)]; }
    LDS_WAIT();
#pragma unroll
    for (int j = 0; j < 4; ++j) { const int n = (lane >> 3) + 8 * j; const LAS float* s = scr + (8 * c) * 33 + n;
        u32x4 o; o.x = pk2(s[0 * 33], s[1 * 33]); o.y = pk2(s[2 * 33], s[3 * 33]); o.z = pk2(s[4 * 33], s[5 * 33]); o.w = pk2(s[6 * 33], s[7 * 33]);
        *(u32x4*)(WT + (size_t)(n0 + n) * ldt + k0 + 8 * c) = o; }
    LDS_WAIT();
}
DI void rms_row_bf16(const float* xrow, const float* g, bf16* orow, int lane) {
    const f32x4* xr = (const f32x4*)xrow + lane;
    f32x4 v[4]; float s = 0.f;
#pragma unroll
    for (int j = 0; j < 4; ++j) { v[j] = xr[64 * j]; s += (v[j].x * v[j].x + v[j].y * v[j].y) + (v[j].z * v[j].z + v[j].w * v[j].w); }
    const float rstd = 1.0f / sqrtf(wave_sum(s) * (1.f / D) + 1e-6f);
    u32x2* o8 = (u32x2*)orow + lane;
#pragma unroll
    for (int j = 0; j < 4; ++j) { const f32x4 gg = ((const f32x4*)g)[lane + 64 * j]; o8[64 * j] = pack4(v[j] * rstd * gg); }
}
DI void rms_rows2_f32(const unsigned char* src, float* dst, int m0, int m1, const float* g, int lane) {
    const f32x4* xa = (const f32x4*)(src + (size_t)m0 * D * 4) + lane; const f32x4* xb = (const f32x4*)(src + (size_t)m1 * D * 4) + lane;
    f32x4 va[4], vb[4]; float sa = 0.f, sb = 0.f;
#pragma unroll
    for (int j = 0; j < 4; ++j) { va[j] = xa[64 * j]; vb[j] = xb[64 * j]; }
#pragma unroll
    for (int j = 0; j < 4; ++j) { sa += (va[j].x * va[j].x + va[j].y * va[j].y) + (va[j].z * va[j].z + va[j].w * va[j].w); sb += (vb[j].x * vb[j].x + vb[j].y * vb[j].y) + (vb[j].z * vb[j].z + vb[j].w * vb[j].w); }
#pragma unroll
    for (int o = 1; o < 64; o <<= 1) { sa += __shfl_xor(sa, o); sb += __shfl_xor(sb, o); }
    const float ra = 1.0f / sqrtf(sa * (1.f / D) + 1e-6f), rb = 1.0f / sqrtf(sb * (1.f / D) + 1e-6f);
    f32x4* oa = (f32x4*)(dst + (size_t)m0 * D) + lane; f32x4* ob = (f32x4*)(dst + (size_t)m1 * D) + lane;
#pragma unroll
    for (int j = 0; j < 4; ++j) { const f32x4 gg = ((const f32x4*)g)[lane + 64 * j]; oa[64 * j] = va[j] * ra * gg; ob[64 * j] = vb[j] * rb * gg; }
}
DI void rms_rows2_bf16(const float* src, const float* g, bf16* dst, int m0, int m1, int lane) {
    const f32x4* xa = (const f32x4*)(src + (size_t)m0 * D) + lane; const f32x4* xb = (const f32x4*)(src + (size_t)m1 * D) + lane;
    f32x4 va[4], vb[4]; float sa = 0.f, sb = 0.f;
#pragma unroll
    for (int j = 0; j < 4; ++j) { va[j] = xa[64 * j]; vb[j] = xb[64 * j]; }
#pragma unroll
    for (int j = 0; j < 4; ++j) { sa += (va[j].x * va[j].x + va[j].y * va[j].y) + (va[j].z * va[j].z + va[j].w * va[j].w); sb += (vb[j].x * vb[j].x + vb[j].y * vb[j].y) + (vb[j].z * vb[j].z + vb[j].w * vb[j].w); }
#pragma unroll
    for (int o = 1; o < 64; o <<= 1) { sa += __shfl_xor(sa, o); sb += __shfl_xor(sb, o); }
    const float ra = 1.0f / sqrtf(sa * (1.f / D) + 1e-6f), rb = 1.0f / sqrtf(sb * (1.f / D) + 1e-6f);
    u32x2* oa = (u32x2*)(dst + (size_t)m0 * D) + lane; u32x2* ob = (u32x2*)(dst + (size_t)m1 * D) + lane;
#pragma unroll
    for (int j = 0; j < 4; ++j) { const f32x4 gg = ((const f32x4*)g)[lane + 64 * j]; oa[64 * j] = pack4(va[j] * ra * gg); ob[64 * j] = pack4(vb[j] * rb * gg); }
}

DI void p0_prologue(const Params& P, LAS unsigned char* lds) {
    const int tid = threadIdx.x, lane = tid & 63, wv = tid >> 6;
    LAS float* scr = (LAS float*)(lds + wv * 16384);
    const int gw = blockIdx.x * 8 + wv, NGW = gridDim.x * 8;
    unsigned char* ws = P.ws;
    constexpr int I0 = 16 * (NMIXP / 32), I1 = 16 * (NGATE / 32), I2 = 8 * 32, I3 = 8 * 32, I4 = 16 * 32, I5 = 16 * (NUP / 32), I6 = 44 * 32, I7 = 16, I8 = 16, I9 = 16, I10 = 32;
    constexpr int NIT = I0 + I1 + I2 + I3 + I4 + I5 + I6 + I7 + I8 + I9 + I10;
    for (int it = gw; it < NIT; it += NGW) {
        int r = it;
        if (r < I0) { const int nb = r % (NMIXP / 32), kb = r / (NMIXP / 32); tr_item(P.in[I_WIN], NPROJ, 64 * kb, 32 * nb < NMIX ? 32 * nb : -1, (bf16*)(ws + WS_WMIX), D, 32 * nb, scr, lane); continue; } r -= I0;
        if (r < I1) { const int nb = r % (NGATE / 32), kb = r / (NGATE / 32); tr_item(P.in[I_WIN], NPROJ, 64 * kb, NMIX + 32 * nb, (bf16*)(ws + WS_WGATE), D, 32 * nb, scr, lane); continue; } r -= I1;
        if (r < I2) { const int nb = r % 32, kb = r / 32; tr_item(P.in[I_GPROJ], D, 64 * kb, 32 * nb, (bf16*)(ws + WS_WGP), 512, 32 * nb, scr, lane); continue; } r -= I2;
        if (r < I3) { const int nb = r % 32, kb = r / 32; tr_item(P.in[I_RPROJ], D, 64 * kb, 32 * nb, (bf16*)(ws + WS_WRP), 512, 32 * nb, scr, lane); continue; } r -= I3;
        if (r < I4) { const int nb = r % 32, kb = r / 32; tr_item(P.in[I_WOUT], D, 64 * kb, 32 * nb, (bf16*)(ws + WS_WOUT), D, 32 * nb, scr, lane); continue; } r -= I4;
        if (r < I5) { const int nb = r % (NUP / 32), kb = r / (NUP / 32); const int n = 32 * nb, j = n >> 8, i = n & 255, ff = 128 * j + (i & 127);
            tr_item(P.in[I_FUP], NUPSRC, 64 * kb, ff < DFF ? (i < 128 ? ff : DFF + ff) : -1, (bf16*)(ws + WS_WUP), D, n, scr, lane); continue; } r -= I5;
        if (r < I6) { const int nb = r % 32, kb = r / 32; tr_item(P.in[I_FDN], D, 64 * kb, kb < 43 ? 32 * nb : -1, (bf16*)(ws + WS_WDN), DFFP, 32 * nb, scr, lane); continue; } r -= I6;
        if (r < I7) { tr_item(P.in[I_W2F], 512, 0, 32 * r, (bf16*)(ws + WS_LW2F), 64, 32 * r, scr, lane); continue; } r -= I7;
        if (r < I8) { tr_item(P.in[I_W2B], 512, 0, 32 * r, (bf16*)(ws + WS_LW2B), 64, 32 * r, scr, lane); continue; } r -= I8;
        if (r < I9) { tr_item(P.in[I_A2], 512, 0, 32 * r, (bf16*)(ws + WS_LA2), 64, 32 * r, scr, lane); continue; } r -= I9;
        { const int nb = r % 16, kb = r / 16; tr_item(P.in[I_G2], 512, 64 * kb, 32 * nb, (bf16*)(ws + WS_LG2), 128, 32 * nb, scr, lane); }
    }
    bf16* HB = (bf16*)(ws + WS_HB);
    for (int m = gw; m < M; m += 2 * NGW) rms_rows2_bf16(P.in[I_X], P.in[I_N1G], HB, m, m + NGW, lane);
}
#define XB_TMO      128
#define XB_XCNT(j)  (256  + 64 * (j))
#define XB_XSUB(j)  (1280 + 64 * (j))
#define XB_XGEN(j)  (2304 + 64 * (j))
#define XB_TOP      3328
#define XB_TOPGEN   3392
#define XCD_BAR_WORDS 3456
#define XB_SPIN_CAP (1u << 18)

__device__ __forceinline__ unsigned xb_ld(unsigned* p)              { return __hip_atomic_load(p, __ATOMIC_RELAXED, __HIP_MEMORY_SCOPE_AGENT); }
__device__ __forceinline__ unsigned xb_add(unsigned* p, unsigned v) { return __hip_atomic_fetch_add(p, v, __ATOMIC_RELAXED, __HIP_MEMORY_SCOPE_AGENT); }
__device__ __forceinline__ unsigned xb_xcc_id() { return (unsigned)__builtin_amdgcn_s_getreg((3 << 11) | 20) & 0xFu; }
#define XB_SPIN(cond, bar) do { unsigned _sp = 0; while (cond) { __builtin_amdgcn_s_sleep(1); \
    if ((++_sp & 255u) == 0u) { if (xb_ld(&(bar)[XB_TMO])) break; if (_sp > XB_SPIN_CAP) { atomicAdd(&(bar)[XB_TMO], 1u); break; } } } } while (0)

struct XcdBarrier {
    unsigned* bar; unsigned x;
    volatile LAS unsigned* st;
};

__device__ __forceinline__ XcdBarrier xcd_barrier_post(unsigned* bar, volatile LAS unsigned* st) {
    XcdBarrier b; b.bar = bar; b.x = xb_xcc_id(); b.st = st;
    if (threadIdx.x == 0) (void)xb_add(&bar[XB_XCNT(b.x)], 1u);
    return b;
}
__device__ __forceinline__ void xcd_barrier_complete(unsigned* bar, unsigned x, unsigned& nloc, unsigned& nx) {
    const unsigned G = gridDim.x * gridDim.y * gridDim.z;
    unsigned sum, cnt, mine, sp = 0u;
    for (;;) {
        sum = 0u; cnt = 0u; mine = 0u;
#pragma unroll
        for (unsigned j = 0; j < 16; ++j) { const unsigned c = xb_ld(&bar[XB_XCNT(j)]); sum += c; cnt += (c > 0u) ? 1u : 0u; mine = (j == x) ? c : mine; }
        if (sum == G) break;
        __builtin_amdgcn_s_sleep(1);
        if ((++sp & 255u) == 0u) { if (xb_ld(&bar[XB_TMO])) break; if (sp > XB_SPIN_CAP) { atomicAdd(&bar[XB_TMO], 1u); break; } }
    }
    nloc = mine > 0u ? mine : 1u; nx = cnt > 0u ? cnt : 1u;
}

__device__ __forceinline__ void xcd_barrier(const XcdBarrier& b) {
    asm volatile("s_waitcnt vmcnt(0)" ::: "memory");
    __syncthreads();
    if (threadIdx.x == 0) {
        unsigned* bar = b.bar;
        __builtin_amdgcn_s_waitcnt(0);
        unsigned nloc = b.st[0], nx = b.st[1];
        if (nloc == 0u) { xcd_barrier_complete(bar, b.x, nloc, nx); b.st[0] = nloc; b.st[1] = nx; }
        const unsigned old = xb_add(&bar[XB_XSUB(b.x)], 1u);
        const unsigned gen = old / nloc;
        if (old + 1u == (gen + 1u) * nloc) {
            __builtin_amdgcn_fence(__ATOMIC_RELEASE, "agent");
            asm volatile("s_waitcnt vmcnt(0)" ::: "memory");
            const unsigned og = xb_add(&bar[XB_TOP], 1u);
            const unsigned tg = og / nx;
            if (og + 1u == (tg + 1u) * nx) xb_add(&bar[XB_TOPGEN], 1u);
            else XB_SPIN(xb_ld(&bar[XB_TOPGEN]) == tg, bar);
            __builtin_amdgcn_fence(__ATOMIC_ACQUIRE, "agent");
            xb_add(&bar[XB_XGEN(b.x)], 1u);
            asm volatile("s_waitcnt vmcnt(0)" ::: "memory");
        } else {
            XB_SPIN(xb_ld(&bar[XB_XGEN(b.x)]) == gen, bar);
            __builtin_amdgcn_fence(__ATOMIC_ACQUIRE, "agent");
            asm volatile("s_waitcnt vmcnt(0)" ::: "memory");
        }
    }
    __syncthreads();
}


DI void gla_unit(const Params& P, LAS unsigned char* lds, int unit) {
    const int tid = threadIdx.x, lane = tid & 63, wv = __builtin_amdgcn_readfirstlane(tid >> 6), fr = lane & 15, q4 = lane >> 4;
    const int dir = unit & 1, h = (unit >> 1) & 3, b = unit >> 3;
    LAS bf16* QI = (LAS bf16*)lds; LAS bf16* KI = QI + 64 * 72; LAS bf16* QE = KI + 64 * 72; LAS bf16* KDT = QE + 64 * 72; LAS bf16* AS = KDT + 64 * 72;
    LAS bf16* VT = AS + 64 * 72; LAS bf16* ST = VT + 128 * 72;
    LAS float* BL = (LAS float*)(ST + 128 * 72); LAS float* AF = BL + 64 * 64; LAS float* GT = AF + 64 * 16;
    const bf16* PM = (const bf16*)(P.ws + WS_PM);
    bf16* GO = (bf16*)(P.ws + WS_GO) + (size_t)dir * M * 512;
    const float* wa2 = dir ? P.in[I_GWA2B] : P.in[I_GWA2F];
    const float* ba = dir ? P.in[I_GBAB] : P.in[I_GBAF];
    const int kq = tid & 63, cgp = tid >> 6;
    float wcol[16];
#pragma unroll
    for (int r = 0; r < 16; ++r) wcol[r] = wa2[r * 256 + 64 * h + kq];
    const float bak = ba[64 * h + kq];
    f32x4 Sacc[4];
#pragma unroll
    for (int i = 0; i < 4; ++i) Sacc[i] = (f32x4){0.f, 0.f, 0.f, 0.f};
    for (int i = tid; i < 128 * 72 / 2; i += 512) ((LAS unsigned*)ST)[i] = 0u;
    const size_t rowbase = (size_t)b * T;
    const int afcol = dir ? C_GAB : C_GAF;
    u32x4 paf = (u32x4){0u, 0u, 0u, 0u}, pq, pk, pva, pvb;
#define GLA_PREFETCH(nn) do { const int chunk_ = dir ? 31 - (nn) : (nn); const size_t tk0_ = rowbase + chunk_ * 64; \
        if (tid < 128) paf = *(const u32x4*)(PM + (tk0_ + (dir ? 63 - (tid >> 1) : (tid >> 1))) * NMIX + afcol + 8 * (tid & 1)); \
        const bf16* rp_ = PM + (tk0_ + (dir ? 63 - (tid >> 3) : (tid >> 3))) * NMIX; \
        pq = *(const u32x4*)(rp_ + C_GQ + 64 * h + 8 * (tid & 7)); pk = *(const u32x4*)(rp_ + C_GK + 64 * h + 8 * (tid & 7)); \
        pva = *(const u32x4*)(rp_ + C_GV + 128 * h + 16 * (tid & 7)); pvb = *(const u32x4*)(rp_ + C_GV + 128 * h + 16 * (tid & 7) + 8); } while (0)
    GLA_PREFETCH(0);
    for (int n = 0; n < 32; ++n) {
        const int chunk = dir ? 31 - n : n;
        const size_t tok0 = rowbase + chunk * 64;
#define GTOK(c) (tok0 + (dir ? 63 - (c) : (c)))
        if (tid < 128) { const int c = tid >> 1, hf = tid & 1; const F8 f = unpack8(paf);
            *(LAS f32x4*)(AF + c * 16 + 8 * hf) = f.a; *(LAS f32x4*)(AF + c * 16 + 8 * hf + 4) = f.b; }
        LDS_BARRIER();
        float pre[8]; float run = 0.f;
#pragma unroll
        for (int j = 0; j < 8; ++j) { const int c = 8 * cgp + j; float z = bak;
#pragma unroll
            for (int r4 = 0; r4 < 4; ++r4) { const f32x4 a = *(LAS f32x4*)(AF + c * 16 + 4 * r4); z += a[0] * wcol[4 * r4] + a[1] * wcol[4 * r4 + 1] + a[2] * wcol[4 * r4 + 2] + a[3] * wcol[4 * r4 + 3]; }
            const float la = -(fmaxf(-z, 0.f) + __logf(1.f + __expf(-fabsf(z)))) * (1.f / 16.f); run += la; pre[j] = run; }
        GT[cgp * 64 + kq] = run;
        LDS_BARRIER();
        float off = 0.f;
#pragma unroll
        for (int g = 0; g < 8; ++g) off += (g < cgp) ? GT[g * 64 + kq] : 0.f;
#pragma unroll
        for (int j = 0; j < 8; ++j) BL[(8 * cgp + j) * 64 + kq] = off + pre[j];
        LDS_BARRIER();
        {   const int c = tid >> 3, k0 = 8 * (tid & 7);
            const F8 q = unpack8(pq), k = unpack8(pk);
            const u32x4 va = pva, vb = pvb;
            f32x4 qi[2], ki[2], qe[2], kd[2];
#pragma unroll
            for (int hh = 0; hh < 2; ++hh) { const f32x4 bl = *(LAS f32x4*)(BL + c * 64 + k0 + 4 * hh), br = *(LAS f32x4*)(BL + 32 * 64 + k0 + 4 * hh), bt = *(LAS f32x4*)(BL + 63 * 64 + k0 + 4 * hh);
                const f32x4 qq = (hh ? q.b : q.a) * 0.125f, kk = hh ? k.b : k.a;
#pragma unroll
                for (int j = 0; j < 4; ++j) { qi[hh][j] = qq[j] * __expf(bl[j] - br[j]); ki[hh][j] = kk[j] * __expf(br[j] - bl[j]); qe[hh][j] = qq[j] * __expf(bl[j]); kd[hh][j] = kk[j] * __expf(bt[j] - bl[j]); } }
            *(LAS u32x4*)(QI + c * 72 + k0) = pack8(qi[0], qi[1]); *(LAS u32x4*)(KI + c * 72 + k0) = pack8(ki[0], ki[1]); *(LAS u32x4*)(QE + c * 72 + k0) = pack8(qe[0], qe[1]);
#pragma unroll
            for (int j = 0; j < 4; ++j) { KDT[(k0 + j) * 72 + c] = (bf16)f2bf(kd[0][j]); KDT[(k0 + 4 + j) * 72 + c] = (bf16)f2bf(kd[1][j]); }
            const int v0 = 16 * (tid & 7);
            VT[(v0 + 0) * 72 + c] = (bf16)(va.x & 0xffffu); VT[(v0 + 1) * 72 + c] = (bf16)(va.x >> 16); VT[(v0 + 2) * 72 + c] = (bf16)(va.y & 0xffffu); VT[(v0 + 3) * 72 + c] = (bf16)(va.y >> 16);
            VT[(v0 + 4) * 72 + c] = (bf16)(va.z & 0xffffu); VT[(v0 + 5) * 72 + c] = (bf16)(va.z >> 16); VT[(v0 + 6) * 72 + c] = (bf16)(va.w & 0xffffu); VT[(v0 + 7) * 72 + c] = (bf16)(va.w >> 16);
            VT[(v0 + 8) * 72 + c] = (bf16)(vb.x & 0xffffu); VT[(v0 + 9) * 72 + c] = (bf16)(vb.x >> 16); VT[(v0 + 10) * 72 + c] = (bf16)(vb.y & 0xffffu); VT[(v0 + 11) * 72 + c] = (bf16)(vb.y >> 16);
            VT[(v0 + 12) * 72 + c] = (bf16)(vb.z & 0xffffu); VT[(v0 + 13) * 72 + c] = (bf16)(vb.z >> 16); VT[(v0 + 14) * 72 + c] = (bf16)(vb.w & 0xffffu); VT[(v0 + 15) * 72 + c] = (bf16)(vb.w >> 16);
        }
        if (n + 1 < 32) GLA_PREFETCH(n + 1);
        LDS_BARRIER();
        {   const int ct = wv >> 1;
#pragma unroll
            for (int tt = 0; tt < 2; ++tt) { const int st = 2 * (wv & 1) + tt;
                f32x4 acc = (f32x4){0.f, 0.f, 0.f, 0.f};
#pragma unroll
                for (int ks = 0; ks < 2; ++ks) { const bf16x8 a = *(LAS bf16x8*)(KI + (16 * st + fr) * 72 + 32 * ks + 8 * q4), bb = *(LAS bf16x8*)(QI + (16 * ct + fr) * 72 + 32 * ks + 8 * q4); acc = MFMA16(a, bb, acc); }
                MFMA_GUARD(acc);
                const int cg0 = 16 * ct + fr, sg0 = 16 * st + 4 * q4;
#pragma unroll
                for (int j = 0; j < 4; ++j) acc[j] = (cg0 >= sg0 + j) ? acc[j] : 0.f;
                *(LAS u32x2*)(AS + (16 * ct + fr) * 72 + 16 * st + 4 * q4) = pack4(acc); }
        }
        LDS_BARRIER();
        {   bf16x8 av[2], as_[2];
#pragma unroll
            for (int ks = 0; ks < 2; ++ks) { av[ks] = *(LAS bf16x8*)(VT + (16 * wv + fr) * 72 + 32 * ks + 8 * q4); as_[ks] = *(LAS bf16x8*)(ST + (16 * wv + fr) * 72 + 32 * ks + 8 * q4); }
#pragma unroll
            for (int ct = 0; ct < 4; ++ct) { f32x4 o = (f32x4){0.f, 0.f, 0.f, 0.f};
#pragma unroll
                for (int ks = 0; ks < 2; ++ks) { const bf16x8 bb = *(LAS bf16x8*)(AS + (16 * ct + fr) * 72 + 32 * ks + 8 * q4); o = MFMA16(av[ks], bb, o); }
#pragma unroll
                for (int ks = 0; ks < 2; ++ks) { const bf16x8 bb = *(LAS bf16x8*)(QE + (16 * ct + fr) * 72 + 32 * ks + 8 * q4); o = MFMA16(as_[ks], bb, o); }
                MFMA_GUARD(o);
                *(u32x2*)(GO + GTOK(16 * ct + fr) * 512 + 128 * h + 16 * wv + 4 * q4) = pack4(o); }
#pragma unroll
            for (int kt = 0; kt < 4; ++kt) { const f32x4 bt = *(LAS f32x4*)(BL + 63 * 64 + 16 * kt + 4 * q4);
                f32x4 s = Sacc[kt]; s[0] *= __expf(bt[0]); s[1] *= __expf(bt[1]); s[2] *= __expf(bt[2]); s[3] *= __expf(bt[3]);
#pragma unroll
                for (int ks = 0; ks < 2; ++ks) { const bf16x8 a = *(LAS bf16x8*)(KDT + (16 * kt + fr) * 72 + 32 * ks + 8 * q4); s = MFMA16(a, av[ks], s); }
                MFMA_GUARD(s); Sacc[kt] = s; }
        }
        LDS_BARRIER();
#pragma unroll
        for (int kt = 0; kt < 4; ++kt) *(LAS u32x2*)(ST + (16 * wv + fr) * 72 + 16 * kt + 4 * q4) = pack4(Sacc[kt]);
#undef GTOK
    }
#undef GLA_PREFETCH
    LDS_BARRIER();
}
DI void gla_post(const Params& P) {
    const int tid = threadIdx.x, lane = tid & 63, wv = tid >> 6;
    const bf16* PM = (const bf16*)(P.ws + WS_PM); const bf16* GO = (const bf16*)(P.ws + WS_GO); bf16* O = (bf16*)(P.ws + WS_O);
    const F8 ng = {*(const f32x4*)(P.in[I_GNG] + 8 * lane), *(const f32x4*)(P.in[I_GNG] + 8 * lane + 4)};
    for (int m = blockIdx.x * 8 + wv; m < M; m += gridDim.x * 8) {
        const F8 a = unpack8(*(const u32x4*)(GO + (size_t)m * 512 + 8 * lane)), bq = unpack8(*(const u32x4*)(GO + (size_t)(M + m) * 512 + 8 * lane));
        const F8 og = unpack8(*(const u32x4*)(PM + (size_t)m * NMIX + C_GOG + 8 * lane));
        const f32x4 o0 = a.a + bq.a, o1 = a.b + bq.b;
        float ss = (o0[0] * o0[0] + o0[1] * o0[1]) + (o0[2] * o0[2] + o0[3] * o0[3]) + (o1[0] * o1[0] + o1[1] * o1[1]) + (o1[2] * o1[2] + o1[3] * o1[3]);
        ss += __shfl_xor(ss, 1); ss += __shfl_xor(ss, 2); ss += __shfl_xor(ss, 4); ss += __shfl_xor(ss, 8);
        const float rs = 1.0f / sqrtf(ss * (1.f / 128.f) + 1e-5f);
        f32x4 r0, r1;
#pragma unroll
        for (int j = 0; j < 4; ++j) { r0[j] = o0[j] * rs * ng.a[j] * (og.a[j] * sigm(og.a[j])); r1[j] = o1[j] * rs * ng.b[j] * (og.b[j] * sigm(og.b[j])); }
        *(u32x4*)(O + (size_t)m * 512 + 8 * lane) = pack8(r0, r1);
    }
}

template <int K> DI void lora_mma(f32x4 (&acc)[4][4], const bf16* Wt, LAS bf16* X, int ldx, int fr, int q4) {
#pragma unroll
    for (int a = 0; a < 4; ++a)
#pragma unroll
        for (int c = 0; c < 4; ++c) acc[a][c] = (f32x4){0.f, 0.f, 0.f, 0.f};
#pragma unroll
    for (int ks = 0; ks < K / 32; ++ks) { bf16x8 af[4];
#pragma unroll
        for (int nt = 0; nt < 4; ++nt) af[nt] = *(const bf16x8*)(Wt + (size_t)(32 * (nt >> 1) + 8 * (fr >> 2) + 4 * (nt & 1) + (fr & 3)) * K + 32 * ks + 8 * q4);
#pragma unroll
        for (int mt = 0; mt < 4; ++mt) { const bf16x8 bb = *(LAS bf16x8*)(X + (16 * mt + fr) * ldx + 32 * ks + 8 * q4);
#pragma unroll
            for (int nt = 0; nt < 4; ++nt) acc[nt][mt] = MFMA16(af[nt], bb, acc[nt][mt]); } }
    __builtin_amdgcn_sched_barrier(0); asm volatile("s_nop 7\n\ts_nop 7" ::: "memory"); __builtin_amdgcn_sched_barrier(0);
}
DI f32x4 shift4(const bf16* rp, bool hp, bool hn, const float* mup, const float* mun) {
    const f32x4 c = unpack4(*(const u32x2*)rp);
    const f32x4 pp = hp ? unpack4(*(const u32x2*)(rp - NMIX)) : (f32x4){0.f, 0.f, 0.f, 0.f};
    const f32x4 pn = hn ? unpack4(*(const u32x2*)(rp + NMIX)) : (f32x4){0.f, 0.f, 0.f, 0.f};
    return c + *(const f32x4*)mup * (pp - c) + *(const f32x4*)mun * (pn - c);
}
DI F8 shift8(const bf16* rp, bool hp, bool hn, const float* mup, const float* mun) {
    const F8 c = unpack8(*(const u32x4*)rp);
    F8 pp, pn; const f32x4 z = (f32x4){0.f, 0.f, 0.f, 0.f};
    if (hp) pp = unpack8(*(const u32x4*)(rp - NMIX)); else { pp.a = z; pp.b = z; }
    if (hn) pn = unpack8(*(const u32x4*)(rp + NMIX)); else { pn.a = z; pn.b = z; }
    F8 r; r.a = c.a + *(const f32x4*)mup * (pp.a - c.a) + *(const f32x4*)mun * (pn.a - c.a);
    r.b = c.b + *(const f32x4*)(mup + 4) * (pp.b - c.b) + *(const f32x4*)(mun + 4) * (pn.b - c.b); return r;
}
DI void r1_tile(const Params& P, LAS unsigned char* lds, int tile) {
    const int tid = threadIdx.x, lane = tid & 63, hd = __builtin_amdgcn_readfirstlane(tid >> 6), fr = lane & 15, q4 = lane >> 4;
    LAS bf16* XW = (LAS bf16*)lds; LAS bf16* XA = XW + 64 * 72; LAS bf16* XG = XA + 64 * 72;
    const bf16* PM = (const bf16*)(P.ws + WS_PM);
    const float* mup = P.in[I_MUP]; const float* mun = P.in[I_MUN];
    const int t0 = tile * 64;
    {   const int row = tid >> 3, g8 = tid & 7; const int tok = t0 + row, tpos = tok & (T - 1);
        const bool hp = tpos > 0, hn = tpos < T - 1;
        const bf16* rp = PM + (size_t)tok * NMIX + C_R0 + 1536 + 32 * g8;
#pragma unroll
        for (int v4 = 0; v4 < 4; ++v4) { F8 s = shift8(rp + 8 * v4, hp, hn, mup + 1536 + 32 * g8 + 8 * v4, mun + 1536 + 32 * g8 + 8 * v4);
            if (g8 < 2) {
#pragma unroll
                for (int j = 0; j < 4; ++j) { s.a[j] = 1.f - 2.f * __builtin_amdgcn_rcpf(__expf(2.f * s.a[j]) + 1.f); s.b[j] = 1.f - 2.f * __builtin_amdgcn_rcpf(__expf(2.f * s.b[j]) + 1.f); }
                *(LAS u32x4*)(XW + row * 72 + 32 * g8 + 8 * v4) = pack8(s.a, s.b);
            } else if (g8 < 4) { *(LAS u32x4*)(XA + row * 72 + 32 * (g8 - 2) + 8 * v4) = pack8(s.a, s.b);
            } else {
#pragma unroll
                for (int j = 0; j < 4; ++j) { s.a[j] = sigm(s.a[j]); s.b[j] = sigm(s.b[j]); }
                *(LAS u32x4*)(XG + row * 136 + 32 * (g8 - 4) + 8 * v4) = pack8(s.a, s.b); } }
    }
    __syncthreads();
    unsigned char* dout = (unsigned char*)P.out;
    bf16* KP = (bf16*)dout; bf16* KKn = KP + (size_t)M * 512; bf16* BB = KKn + (size_t)M * 512; bf16* GG = BB + (size_t)M * 512;
    unsigned short* EF = (unsigned short*)(P.ws + WS_E); unsigned short* EB = EF + (size_t)M * 512;
    float* BON = (float*)(P.ws + WS_BON);
    const int ch8 = 64 * hd + 8 * q4;
    f32x4 acc[4][4];
    lora_mma<64>(acc, (const bf16*)(P.ws + WS_LA2) + (size_t)(64 * hd) * 64, XA, 72, fr, q4);
#pragma unroll
    for (int np = 0; np < 2; ++np) { const f32x4 a0a = *(const f32x4*)(P.in[I_A0] + ch8 + 32 * np), a0b = *(const f32x4*)(P.in[I_A0] + ch8 + 32 * np + 4);
#pragma unroll
        for (int mt = 0; mt < 4; ++mt)
#pragma unroll
            for (int j = 0; j < 4; ++j) { acc[2 * np][mt][j] = sigm(acc[2 * np][mt][j] + a0a[j]); acc[2 * np + 1][mt][j] = sigm(acc[2 * np + 1][mt][j] + a0b[j]); } }
#pragma unroll
    for (int mt = 0; mt < 4; ++mt) { const int tok = t0 + 16 * mt + fr, tpos = tok & (T - 1); const bool hp = tpos > 0, hn = tpos < T - 1;
        const bf16* rp = PM + (size_t)tok * NMIX + C_R0 + ch8;
        F8 ks[2]; float ss = 0.f;
#pragma unroll
        for (int np = 0; np < 2; ++np) { ks[np] = shift8(rp + 512 + 32 * np, hp, hn, mup + 512 + ch8 + 32 * np, mun + 512 + ch8 + 32 * np);
            const f32x4 k0 = ks[np].a * *(const f32x4*)(P.in[I_KK] + ch8 + 32 * np), k1 = ks[np].b * *(const f32x4*)(P.in[I_KK] + ch8 + 32 * np + 4);
            ss += ((k0[0] * k0[0] + k0[1] * k0[1]) + (k0[2] * k0[2] + k0[3] * k0[3])) + ((k1[0] * k1[0] + k1[1] * k1[1]) + (k1[2] * k1[2] + k1[3] * k1[3])); }
        ss += __shfl_xor(ss, 16); ss += __shfl_xor(ss, 32);
        const float inv = 1.0f / fmaxf(sqrtf(ss), 1e-12f);
        float bon = 0.f;
#pragma unroll
        for (int np = 0; np < 2; ++np) { const f32x4 aa = acc[2 * np][mt], ab = acc[2 * np + 1][mt];
            const f32x4 kka = *(const f32x4*)(P.in[I_KK] + ch8 + 32 * np), kkb = *(const f32x4*)(P.in[I_KK] + ch8 + 32 * np + 4);
            const f32x4 kaa = *(const f32x4*)(P.in[I_KA] + ch8 + 32 * np), kab = *(const f32x4*)(P.in[I_KA] + ch8 + 32 * np + 4);
            const f32x4 kn0 = ks[np].a * kka * inv, kn1 = ks[np].b * kkb * inv;
            const f32x4 kp0 = ks[np].a * (1.0f + (aa - 1.0f) * kaa), kp1 = ks[np].b * (1.0f + (ab - 1.0f) * kab);
            const f32x4 bb0 = kn0 * aa, bb1 = kn1 * ab;
            const F8 rs = shift8(rp + 32 * np, hp, hn, mup + ch8 + 32 * np, mun + ch8 + 32 * np);
            const f32x4 rk0 = *(const f32x4*)(P.in[I_RK] + ch8 + 32 * np), rk1 = *(const f32x4*)(P.in[I_RK] + ch8 + 32 * np + 4);
            bon += ((rs.a[0] * kp0[0] * rk0[0] + rs.a[1] * kp0[1] * rk0[1]) + (rs.a[2] * kp0[2] * rk0[2] + rs.a[3] * kp0[3] * rk0[3]))
                 + ((rs.b[0] * kp1[0] * rk1[0] + rs.b[1] * kp1[1] * rk1[1]) + (rs.b[2] * kp1[2] * rk1[2] + rs.b[3] * kp1[3] * rk1[3]));
            const size_t o = (size_t)tok * 512 + ch8 + 32 * np;
            *(u32x4*)(KP + o) = pack8(kp0, kp1); *(u32x4*)(KKn + o) = pack8(kn0, kn1); *(u32x4*)(BB + o) = pack8(bb0, bb1); }
        bon += __shfl_xor(bon, 16); bon += __shfl_xor(bon, 32);
        if (q4 == 0) BON[(size_t)tok * 8 + hd] = bon; }
#pragma unroll
    for (int d = 0; d < 2; ++d) {
        lora_mma<64>(acc, (const bf16*)(P.ws + (d ? WS_LW2B : WS_LW2F)) + (size_t)(64 * hd) * 64, XW, 72, fr, q4);
        unsigned short* E = d ? EB : EF; const float* w0 = d ? P.in[I_W0B] : P.in[I_W0F];
#pragma unroll
        for (int np = 0; np < 2; ++np) { const f32x4 w0a = *(const f32x4*)(w0 + ch8 + 32 * np), w0b = *(const f32x4*)(w0 + ch8 + 32 * np + 4);
#pragma unroll
            for (int mt = 0; mt < 4; ++mt) { const f32x4 a = acc[2 * np][mt], c = acc[2 * np + 1][mt]; u32x4 w;
                w.x = pkh2(0.60653066f * sigm(a[0] + w0a[0]), 0.60653066f * sigm(a[1] + w0a[1])); w.y = pkh2(0.60653066f * sigm(a[2] + w0a[2]), 0.60653066f * sigm(a[3] + w0a[3]));
                w.z = pkh2(0.60653066f * sigm(c[0] + w0b[0]), 0.60653066f * sigm(c[1] + w0b[1])); w.w = pkh2(0.60653066f * sigm(c[2] + w0b[2]), 0.60653066f * sigm(c[3] + w0b[3]));
                *(u32x4*)(E + (size_t)(t0 + 16 * mt + fr) * 512 + ch8 + 32 * np) = w; } }
    }
    lora_mma<128>(acc, (const bf16*)(P.ws + WS_LG2) + (size_t)(64 * hd) * 128, XG, 136, fr, q4);
#pragma unroll
    for (int np = 0; np < 2; ++np)
#pragma unroll
        for (int mt = 0; mt < 4; ++mt) *(u32x4*)(GG + (size_t)(t0 + 16 * mt + fr) * 512 + ch8 + 32 * np) = pack8(acc[2 * np][mt], acc[2 * np + 1][mt]);
    __syncthreads();
}

constexpr int TC = 16;
#define OPI(buf, d, arr) (OP + ((((buf) * 2 + (d)) * 6 + (arr)) * (TC * 64)))
DI void scan_load(const Params& P, LAS float* OP, int buf, int ci, int b, int hd, int ltid) {
    const int d = ltid >> 7, i = (ltid >> 3) & 15, c8 = ltid & 7;
    const int step = TC * ci + i, tpos = d ? T - 1 - step : step; const size_t tok = (size_t)b * T + tpos;
    const int ch0 = 64 * hd + 8 * c8;
    const bf16* PM = (const bf16*)(P.ws + WS_PM);
    const bf16* KP = (const bf16*)P.out; const bf16* KKn = KP + (size_t)M * 512; const bf16* BB = KKn + (size_t)M * 512;
    const unsigned short* E = (const unsigned short*)(P.ws + WS_E) + (size_t)d * M * 512;
    const F8 kp = unpack8(*(const u32x4*)(KP + tok * 512 + ch0)), kk = unpack8(*(const u32x4*)(KKn + tok * 512 + ch0)), bb = unpack8(*(const u32x4*)(BB + tok * 512 + ch0));
    const u32x4 ew = *(const u32x4*)(E + tok * 512 + ch0);
    const bool hp = tpos > 0, hn = tpos < T - 1;
    const bf16* rp = PM + tok * NMIX + C_R0 + ch0;
    const F8 r = shift8(rp, hp, hn, P.in[I_MUP] + ch0, P.in[I_MUN] + ch0), v = shift8(rp + 1024, hp, hn, P.in[I_MUP] + 1024 + ch0, P.in[I_MUN] + 1024 + ch0);
    const int o = i * 64 + 8 * c8;
    *(LAS f32x4*)(OPI(buf, d, 0) + o) = -kk.a; *(LAS f32x4*)(OPI(buf, d, 0) + o + 4) = -kk.b;
    f32x4 w0, w1; w0[0] = __expf(-hlo(ew.x)); w0[1] = __expf(-hhi(ew.x)); w0[2] = __expf(-hlo(ew.y)); w0[3] = __expf(-hhi(ew.y));
    w1[0] = __expf(-hlo(ew.z)); w1[1] = __expf(-hhi(ew.z)); w1[2] = __expf(-hlo(ew.w)); w1[3] = __expf(-hhi(ew.w));
    *(LAS f32x4*)(OPI(buf, d, 1) + o) = w0; *(LAS f32x4*)(OPI(buf, d, 1) + o + 4) = w1;
    *(LAS f32x4*)(OPI(buf, d, 2) + o) = bb.a; *(LAS f32x4*)(OPI(buf, d, 2) + o + 4) = bb.b;
    *(LAS f32x4*)(OPI(buf, d, 3) + o) = kp.a; *(LAS f32x4*)(OPI(buf, d, 3) + o + 4) = kp.b;
    *(LAS f32x4*)(OPI(buf, d, 4) + o) = r.a; *(LAS f32x4*)(OPI(buf, d, 4) + o + 4) = r.b;
    *(LAS f32x4*)(OPI(buf, d, 5) + o) = v.a; *(LAS f32x4*)(OPI(buf, d, 5) + o + 4) = v.b;
}
DI void scan_flush(const Params& P, LAS float* YB, int buf, int ci, int b, int hd, int ltid) {
    const int d = ltid >> 7, i = (ltid >> 3) & 15, c8 = ltid & 7;
    const int step = TC * ci + i, tpos = d ? T - 1 - step : step; const size_t tok = (size_t)b * T + tpos;
    bf16* Y = (bf16*)(P.ws + WS_GO) + (size_t)d * M * 512;
    const LAS float* y = YB + (buf * 2 + d) * (TC * 64) + i * 64 + 8 * c8;
    *(u32x4*)(Y + tok * 512 + 64 * hd + 8 * c8) = pack8(*(const LAS f32x4*)y, *(const LAS f32x4*)(y + 4));
}
struct ScanOps { f32x2 nk[4], w[4], bb[4], kx[4], rx[4]; f32x4 vv; };
DI void scan_ops_load(ScanOps& o, const LAS float* base, const LAS float* vb, int i) {
#pragma unroll
    for (int hh = 0; hh < 2; ++hh) { const f32x4 t0 = *(const LAS f32x4*)(base + 0 * TC * 64 + i * 64 + 4 * hh), t1 = *(const LAS f32x4*)(base + 1 * TC * 64 + i * 64 + 4 * hh), t2 = *(const LAS f32x4*)(base + 2 * TC * 64 + i * 64 + 4 * hh),
                                                   t3 = *(const LAS f32x4*)(base + 3 * TC * 64 + i * 64 + 4 * hh), t4 = *(const LAS f32x4*)(base + 4 * TC * 64 + i * 64 + 4 * hh);
        o.nk[2 * hh] = (f32x2){t0[0], t0[1]}; o.nk[2 * hh + 1] = (f32x2){t0[2], t0[3]}; o.w[2 * hh] = (f32x2){t1[0], t1[1]}; o.w[2 * hh + 1] = (f32x2){t1[2], t1[3]};
        o.bb[2 * hh] = (f32x2){t2[0], t2[1]}; o.bb[2 * hh + 1] = (f32x2){t2[2], t2[3]}; o.kx[2 * hh] = (f32x2){t3[0], t3[1]}; o.kx[2 * hh + 1] = (f32x2){t3[2], t3[3]};
        o.rx[2 * hh] = (f32x2){t4[0], t4[1]}; o.rx[2 * hh + 1] = (f32x2){t4[2], t4[3]}; }
    o.vv = *(const LAS f32x4*)(vb + i * 64);
}
DI void scan_step(f32x2 (&S)[4][4], const ScanOps& o, LAS float* yb, int i, int c8) {
    float sa[4];
#pragma unroll
    for (int j = 0; j < 4; ++j) { f32x2 a = S[j][0] * o.nk[0]; a = S[j][1] * o.nk[1] + a; a = S[j][2] * o.nk[2] + a; a = S[j][3] * o.nk[3] + a; sa[j] = oct_sum(a.x + a.y); }
    f32x4 yo;
#pragma unroll
    for (int j = 0; j < 4; ++j) { const f32x2 sav = (f32x2){sa[j], sa[j]}, vjv = (f32x2){o.vv[j], o.vv[j]};
#pragma unroll
        for (int p = 0; p < 4; ++p) S[j][p] = S[j][p] * o.w[p] + (sav * o.bb[p] + vjv * o.kx[p]);
        f32x2 y = S[j][0] * o.rx[0]; y = S[j][1] * o.rx[1] + y; y = S[j][2] * o.rx[2] + y; y = S[j][3] * o.rx[3] + y; yo[j] = oct_sum(y.x + y.y); }
    if (c8 == 0) *(LAS f32x4*)(yb + i * 64) = yo;
}
DI void scan_unit(const Params& P, LAS unsigned char* lds, int bh) {
    const int tid = threadIdx.x, lane = tid & 63, wv = __builtin_amdgcn_readfirstlane(tid >> 6);
    const int b = bh >> 3, hd = bh & 7;
    LAS float* OP = (LAS float*)lds; LAS float* YB = OP + 2 * 2 * 6 * TC * 64;
    constexpr int NCH = T / TC;
    const bool loader = wv >= 4; const int ltid = tid - 256;
    const int d = wv >> 1, c8 = lane & 7, rbase = 32 * (wv & 1) + 4 * (lane >> 3);
    f32x2 S[4][4];
#pragma unroll
    for (int j = 0; j < 4; ++j)
#pragma unroll
        for (int p = 0; p < 4; ++p) S[j][p] = (f32x2){0.f, 0.f};
    if (loader) scan_load(P, OP, 0, 0, b, hd, ltid);
    __syncthreads();
    for (int ci = 0; ci < NCH; ++ci) {
        const int buf = ci & 1;
        if (loader) {
            if (ci + 1 < NCH) scan_load(P, OP, buf ^ 1, ci + 1, b, hd, ltid);
            if (ci > 0) scan_flush(P, YB, buf ^ 1, ci - 1, b, hd, ltid);
        } else {
            const LAS float* base = OPI(buf, d, 0) + 8 * c8;
            const LAS float* vb = OPI(buf, d, 5) + rbase;
            LAS float* yb = YB + (buf * 2 + d) * (TC * 64) + rbase;
            ScanOps cur, nxt; scan_ops_load(cur, base, vb, 0);
#pragma unroll 1
            for (int i = 0; i < TC; i += 2) {
                scan_ops_load(nxt, base, vb, i + 1);
                scan_step(S, cur, yb, i, c8);
                if (i + 2 < TC) scan_ops_load(cur, base, vb, i + 2);
                scan_step(S, nxt, yb, i + 1, c8);
            }
        }
        __syncthreads();
    }
    if (loader) scan_flush(P, YB, (NCH - 1) & 1, NCH - 1, b, hd, ltid);
    __syncthreads();
}
DI void r3_post(const Params& P) {
    const int tid = threadIdx.x, lane = tid & 63, wv = tid >> 6;
    const bf16* PM = (const bf16*)(P.ws + WS_PM); const bf16* Y = (const bf16*)(P.ws + WS_GO); bf16* O = (bf16*)(P.ws + WS_O);
    const bf16* GG = (const bf16*)P.out + (size_t)3 * M * 512; const float* BON = (const float*)(P.ws + WS_BON);
    const F8 lw = {*(const f32x4*)(P.in[I_LNW] + 8 * lane), *(const f32x4*)(P.in[I_LNW] + 8 * lane + 4)}, lb = {*(const f32x4*)(P.in[I_LNB] + 8 * lane), *(const f32x4*)(P.in[I_LNB] + 8 * lane + 4)};
    for (int m = blockIdx.x * 8 + wv; m < M; m += gridDim.x * 8) {
        const int tpos = m & (T - 1);
        const F8 a = unpack8(*(const u32x4*)(Y + (size_t)m * 512 + 8 * lane)), bq = unpack8(*(const u32x4*)(Y + (size_t)(M + m) * 512 + 8 * lane));
        const F8 g = unpack8(*(const u32x4*)(GG + (size_t)m * 512 + 8 * lane));
        const F8 v = shift8(PM + (size_t)m * NMIX + C_R0 + 1024 + 8 * lane, tpos > 0, tpos < T - 1, P.in[I_MUP] + 1024 + 8 * lane, P.in[I_MUN] + 1024 + 8 * lane);
        const float bon = BON[(size_t)m * 8 + (lane >> 3)];
        const f32x4 y0 = a.a + bq.a, y1 = a.b + bq.b;
        float s = (y0[0] + y0[1]) + (y0[2] + y0[3]) + (y1[0] + y1[1]) + (y1[2] + y1[3]);
        s += __shfl_xor(s, 1); s += __shfl_xor(s, 2); s += __shfl_xor(s, 4);
        const float mu = s * (1.f / 64.f);
        const f32x4 d0 = y0 - mu, d1 = y1 - mu;
        float q = (d0[0] * d0[0] + d0[1] * d0[1]) + (d0[2] * d0[2] + d0[3] * d0[3]) + (d1[0] * d1[0] + d1[1] * d1[1]) + (d1[2] * d1[2] + d1[3] * d1[3]);
        q += __shfl_xor(q, 1); q += __shfl_xor(q, 2); q += __shfl_xor(q, 4);
        const float rs = 1.0f / sqrtf(q * (1.f / 64.f) + 64.f * 1e-5f);
        const f32x4 o0 = (d0 * rs * lw.a + lb.a + bon * v.a) * g.a, o1 = (d1 * rs * lw.b + lb.b + bon * v.b) * g.b;
        *(u32x4*)(O + (size_t)(M + m) * 512 + 8 * lane) = pack8(o0, o1);
    }
}

DI void conv_phase(const Params& P, int half, int sel = 0) {
    const bf16* U = (const bf16*)(P.ws + WS_U); bf16* ACT = (bf16*)(P.ws + WS_ACT);
    const float* cw = P.in[I_FCW]; const float* cb = P.in[I_FCB];
    constexpr int NCG = DFFP / 8;
    const int nitems = (MH / 8) * NCG;
    for (int it = blockIdx.x * 512 + threadIdx.x; it < nitems; it += gridDim.x * 512) {
        const int run = it / NCG, cgp = it - run * NCG, j0 = 8 * cgp;
        const int tl0 = run * 8, tg0 = half * MH + tl0, tpos0 = tg0 & (T - 1);
        bf16* ap = ACT + (size_t)tg0 * DFFP + j0;
        if (j0 >= DFF) {
#pragma unroll
            for (int rr = 0; rr < 8; ++rr) *(u32x4*)(ap + (size_t)rr * DFFP) = (u32x4){0u, 0u, 0u, 0u};
            continue; }
        const int ucol = 256 * (j0 >> 7) + (j0 & 127);
        F8 wg[3], wvv[3];
#pragma unroll
        for (int t = 0; t < 3; ++t) { wg[t].a = *(const f32x4*)(cw + t * NUPSRC + j0); wg[t].b = *(const f32x4*)(cw + t * NUPSRC + j0 + 4); wvv[t].a = *(const f32x4*)(cw + t * NUPSRC + DFF + j0); wvv[t].b = *(const f32x4*)(cw + t * NUPSRC + DFF + j0 + 4); }
        const F8 bg = {*(const f32x4*)(cb + j0), *(const f32x4*)(cb + j0 + 4)}, bv = {*(const f32x4*)(cb + DFF + j0), *(const f32x4*)(cb + DFF + j0 + 4)};
        const bf16* up = U + (size_t)tl0 * NUP + ucol;
        const f32x4 z = (f32x4){0.f, 0.f, 0.f, 0.f};
        F8 pg, pv, cg_, cv, ng, nv;
        if (tpos0 > 0) { pg = unpack8(*(const u32x4*)(up - NUP)); pv = unpack8(*(const u32x4*)(up - NUP + 128)); } else { pg.a = z; pg.b = z; pv.a = z; pv.b = z; }
        cg_ = unpack8(*(const u32x4*)up); cv = unpack8(*(const u32x4*)(up + 128));
#pragma unroll
        for (int rr = 0; rr < 8; ++rr) {
            if (tpos0 + rr + 1 < T) { ng = unpack8(*(const u32x4*)(up + (size_t)(rr + 1) * NUP)); nv = unpack8(*(const u32x4*)(up + (size_t)(rr + 1) * NUP + 128)); } else { ng.a = z; ng.b = z; nv.a = z; nv.b = z; }
            const f32x4 g0 = wg[0].a * pg.a + wg[1].a * cg_.a + wg[2].a * ng.a + bg.a, g1 = wg[0].b * pg.b + wg[1].b * cg_.b + wg[2].b * ng.b + bg.b;
            const f32x4 x0 = wvv[0].a * pv.a + wvv[1].a * cv.a + wvv[2].a * nv.a + bv.a, x1 = wvv[0].b * pv.b + wvv[1].b * cv.b + wvv[2].b * nv.b + bv.b;
            f32x4 o0, o1;
#pragma unroll
            for (int j = 0; j < 4; ++j) { o0[j] = g0[j] * sigm(g0[j]) * x0[j]; o1[j] = g1[j] * sigm(g1[j]) * x1[j]; }
            { const int rt_ = (tl0 + rr) & 255; const bool edge = (rt_ == 0 || rt_ == 255);
              if (sel == 0 || (sel == 1 && edge) || (sel == 2 && !edge)) *(u32x4*)(ap + (size_t)rr * DFFP) = pack8(o0, o1); }
            pg = cg_; pv = cv; cg_ = ng; cv = nv;
        }
    }
}
#ifndef DBG_UDUMP
#define DBG_UDUMP 0
#endif
DI void conv_fix(const Params& P) {
    const float* SB = (const float*)(P.ws + (DBG_UDUMP ? 868 * MiB : WS_SB)); bf16* ACT = (bf16*)(P.ws + WS_ACT);
    const float* cw = P.in[I_FCW]; const float* cb = P.in[I_FCB];
    constexpr int NG = DFFP / 4;
    const int nitems = 256 * 2 * NG;
    for (int it = blockIdx.x * 512 + threadIdx.x; it < nitems; it += gridDim.x * 512) {
        const int jg = it % NG, rw = it / NG, which = rw & 1, pm = rw >> 1, j = 4 * jg;
        bf16* ap = ACT + (size_t)(pm * 256 + (which ? 255 : 0)) * DFFP + j;
        if (j >= DFF) { *(u32x2*)ap = (u32x2){0u, 0u}; continue; }
        const int col = 256 * (j >> 7) + (j & 127);
        const f32x4 z = (f32x4){0.f, 0.f, 0.f, 0.f};
        const float* cur = SB + (size_t)(pm * 4 + (which ? 3 : 0)) * NUP + col;
        const float* prv = which ? SB + (size_t)(pm * 4 + 2) * NUP + col : ((pm & 7) ? SB + (size_t)((pm - 1) * 4 + 3) * NUP + col : nullptr);
        const float* nxt = which ? (((pm & 7) != 7) ? SB + (size_t)((pm + 1) * 4 + 0) * NUP + col : nullptr) : SB + (size_t)(pm * 4 + 1) * NUP + col;
        const f32x4 cgv = *(const f32x4*)cur, cvv = *(const f32x4*)(cur + 128);
        const f32x4 pg = prv ? *(const f32x4*)prv : z, pv = prv ? *(const f32x4*)(prv + 128) : z;
        const f32x4 ng = nxt ? *(const f32x4*)nxt : z, nv = nxt ? *(const f32x4*)(nxt + 128) : z;
        const f32x4 g = *(const f32x4*)(cw + j) * pg + *(const f32x4*)(cw + NUPSRC + j) * cgv + *(const f32x4*)(cw + 2 * NUPSRC + j) * ng + *(const f32x4*)(cb + j);
        const f32x4 v = *(const f32x4*)(cw + DFF + j) * pv + *(const f32x4*)(cw + NUPSRC + DFF + j) * cvv + *(const f32x4*)(cw + 2 * NUPSRC + DFF + j) * nv + *(const f32x4*)(cb + DFF + j);
        f32x4 o;
#pragma unroll
        for (int i = 0; i < 4; ++i) o[i] = g[i] * sigm(g[i]) * v[i];
        *(u32x2*)ap = pack4(o);
    }
}
#ifndef DBG_SKIPMASK
#define DBG_SKIPMASK 0
#endif
#ifndef FUSE_NORM2
#define FUSE_NORM2 1
#endif
#ifndef FUSE_CONV
#define FUSE_CONV 1
#endif
#ifndef SEAM_ACQ
#define SEAM_ACQ 0
#endif
#ifndef USE_CG_SYNC
#define USE_CG_SYNC 0
#endif
#ifndef N_PHASE_LAUNCH
#define N_PHASE_LAUNCH 0
#endif
constexpr int NPHASES = 16;
__global__ void __launch_bounds__(512, 2) fwd_kernel(Params P, int ph_lo, int ph_hi) {
    extern __shared__ __attribute__((aligned(16))) unsigned char lds_raw[];
    LAS unsigned char* lds = (LAS unsigned char*)lds_raw;
    const int tid = threadIdx.x, wv = tid >> 6, lane = tid & 63;
    unsigned char* ws = P.ws;
    bf16* HB = (bf16*)(ws + WS_HB);
    const int G = gridDim.x, bx = blockIdx.x;
#if N_PHASE_LAUNCH
#define SEAM() do {} while (0)
#define SEAM0() do {} while (0)
#else
    cg::grid_group grid = cg::this_grid();
    volatile LAS unsigned* xst = (volatile LAS unsigned*)(lds + 131072 + 64);
    if (tid < 2) xst[tid] = 0u;
    __syncthreads();
    const XcdBarrier xbar = xcd_barrier_post((unsigned*)ws, xst);
#define SEAM0() grid.sync()
#if USE_CG_SYNC
#define SEAM() grid.sync()
#else
#if SEAM_ACQ
#define SEAM() do { xcd_barrier(xbar); __builtin_amdgcn_fence(__ATOMIC_ACQUIRE, "agent"); } while (0)
#else
#define SEAM() xcd_barrier(xbar)
#endif
#endif
#endif
#define IN(k) (ph_lo <= (k) && (k) < ph_hi)
#define GEMM_CALL(EPI, A_, B_, M_, N_, K_, E_) do { pg8::Gemm g{(const pg8::bf16_t*)(A_), (const pg8::bf16_t*)(B_), (M_), (N_), (K_)}; pg8::StaticOrder S; S.init((M_), (N_), G, bx); \
        pg8::gemm_phase<EPI, pg8::StaticOrder, PG8_ALIGN, PG8_SP2>(lds, g, S, (E_)); } while (0)
    if (IN(0)) { p0_prologue(P, lds); SEAM0(); }
    if (IN(1)) { pg8::EpiStore E{(pg8::bf16_t*)(ws + WS_PM), NMIX, NMIX, 0, nullptr}; GEMM_CALL(pg8::EpiStore, HB, ws + WS_WMIX, M, NMIXP, D, E);
#ifdef PROBE_G1A2
                 __syncthreads(); GEMM_CALL(pg8::EpiStore, HB, ws + WS_WMIX, M, NMIXP, D, E);
#endif
                 SEAM(); }
    if (IN(2)) { for (int u = bx; u < 256; u += G) gla_unit(P, lds, u);
                 for (int t = bx; t < M / 64; t += G) r1_tile(P, lds, t);
                 SEAM(); }
    if (IN(5)) { gla_post(P); __syncthreads();
                 for (int u = bx; u < 256; u += G) scan_unit(P, lds, u);
#ifdef PROBE_SCAN2
                 for (int u = bx; u < 256; u += G) scan_unit(P, lds, u);
#endif
                 SEAM(); }
    if (IN(6)) { r3_post(P); __syncthreads();
                 pg8::EpiStore E{(pg8::bf16_t*)(ws + WS_E), D, D, D, (pg8::bf16_t*)P.out}; GEMM_CALL(pg8::EpiStore, HB, ws + WS_WGATE, M, NGATE, D, E); SEAM(); }
    if (IN(7)) { { pg8::EpiGate<0> E{(const pg8::bf16_t*)(ws + WS_E), (pg8::bf16_t*)HB, D}; GEMM_CALL(pg8::EpiGate<0>, ws + WS_O, ws + WS_WGP, M, D, 512, E); }
                 __syncthreads();
                 { pg8::EpiGate<1> E{(const pg8::bf16_t*)P.out, (pg8::bf16_t*)HB, D}; GEMM_CALL(pg8::EpiGate<1>, ws + WS_O + (size_t)M * 512 * 2, ws + WS_WRP, M, D, 512, E); }
                 SEAM(); }
#if FUSE_NORM2
    if (IN(8)) { pg8::EpiResNorm E{P.in[I_X], P.out, (pg8::bf16_t*)(ws + WS_H2), P.in[I_N2G], (float*)(ws + 65536), D}; GEMM_CALL(pg8::EpiResNorm, HB, ws + WS_WOUT, M, D, D, E); SEAM(); }
#else
    if (IN(8)) { pg8::EpiRes E{P.in[I_X], P.out, D}; GEMM_CALL(pg8::EpiRes, HB, ws + WS_WOUT, M, D, D, E); SEAM(); }
#endif
#if !FUSE_NORM2
    if (IN(9)) { for (int m = bx * 8 + wv; m < M; m += G * 16) rms_rows2_bf16(P.out, P.in[I_N2G], HB, m, m + G * 8, lane); SEAM(); }
#endif
#if FUSE_CONV
    if (IN(10)) { pg8::EpiConv E{(pg8::bf16_t*)(ws + WS_ACT), (float*)(ws + (DBG_UDUMP ? 868 * MiB : WS_SB)), P.in[I_FCW], P.in[I_FCB], (PG8_LAS float*)(lds + 131072 + 256), DBG_UDUMP ? (pg8::bf16_t*)(ws + WS_U) : nullptr, FUSE_NORM2 ? (const float*)(ws + 65536) : nullptr};
                  GEMM_CALL(pg8::EpiConv, FUSE_NORM2 ? (bf16*)(ws + WS_H2) : HB, ws + WS_WUP, M, NUP, D, E); SEAM(); }
    if (IN(11)) { conv_fix(P); SEAM(); }
#if DBG_UDUMP
    if (IN(12)) { conv_phase(P, 0, 2); SEAM(); }
#endif
#ifdef DBG_SEL
#pragma unroll 1
    for (int half = 0; half < 2; ++half) {
        if (IN(12)) { pg8::EpiStore E{(pg8::bf16_t*)(ws + WS_U), NUP, NUP, 0, nullptr}; GEMM_CALL(pg8::EpiStore, HB + (size_t)half * MH * D, ws + WS_WUP, MH, NUP, D, E); SEAM(); }
        if (IN(12)) { conv_phase(P, half, DBG_SEL); SEAM(); }
    }
#endif
#else
#pragma unroll 1
    for (int half = 0; half < 2; ++half) {
        if (IN(10 + 2 * half)) { pg8::EpiStore E{(pg8::bf16_t*)(ws + WS_U), NUP, NUP, 0, nullptr}; GEMM_CALL(pg8::EpiStore, HB + (size_t)half * MH * D, ws + WS_WUP, MH, NUP, D, E); SEAM(); }
        if (IN(11 + 2 * half)) { conv_phase(P, half); SEAM(); }
    }
#endif
    if (IN(14)) { pg8::EpiRes E{P.out, (float*)(ws + WS_X2), D}; GEMM_CALL(pg8::EpiRes, ws + WS_ACT, ws + WS_WDN, M, D, DFFP, E); SEAM(); }
    if (IN(15)) { for (int m = bx * 8 + wv; m < M; m += G * 16) rms_rows2_f32(ws + WS_X2, P.out, m, m + G * 8, P.in[I_NFG], lane); }
#ifdef DBG_DUMP
    if (IN(20)) { const bf16* src = (const bf16*)(ws + DBG_SRC); for (size_t i = (size_t)bx * 512 + tid; i < (size_t)M * D; i += (size_t)G * 512) P.out[i] = bfl(src[i]); }
#endif
}

extern "C" void kernel_launch(void* const* d_in, const int* in_sizes, int n_in, void* d_out, int out_size, void* d_ws, size_t ws_size, hipStream_t stream) {
    static int grid = 0;
    if (grid == 0) {
        if (n_in != 31 || in_sizes[0] != M * D || out_size != M * D || ws_size < 1024 * MiB) { fprintf(stderr, "kernel_launch: unexpected shapes (n_in %d, in0 %d, out %d, ws %zu)\n", n_in, n_in > 0 ? in_sizes[0] : -1, out_size, ws_size); grid = -1; return; }
        int dev = 0, cus = 0, per_cu = 0;
        if (hipGetDevice(&dev) != hipSuccess || hipDeviceGetAttribute(&cus, hipDeviceAttributeMultiprocessorCount, dev) != hipSuccess) { grid = -1; return; }
        if (hipFuncSetAttribute((const void*)fwd_kernel, hipFuncAttributeMaxDynamicSharedMemorySize, LDS_BYTES) != hipSuccess) { fprintf(stderr, "kernel_launch: hipFuncSetAttribute failed\n"); grid = -1; return; }
        if (hipOccupancyMaxActiveBlocksPerMultiprocessor(&per_cu, (const void*)fwd_kernel, 512, LDS_BYTES) != hipSuccess || per_cu < 1) { fprintf(stderr, "kernel_launch: occupancy query says %d\n", per_cu); per_cu = 1; }
        (void)hipGetLastError();
        grid = cus * 1;
    }
    if (grid < 0) return;
    Params p{};
    for (int i = 0; i < 31; ++i) p.in[i] = (const float*)d_in[i];
    p.out = (float*)d_out; p.ws = (unsigned char*)d_ws;
#if N_PHASE_LAUNCH
#ifdef DBG_DUMP
    for (int ph = 0; ph <= DBG_DUMP; ++ph) { if (DBG_SKIPMASK & (1 << ph)) continue; hipLaunchKernelGGL(fwd_kernel, dim3(grid), dim3(512), LDS_BYTES, stream, p, ph, ph + 1); }
    if (DBG_DUMP < 14) hipLaunchKernelGGL(fwd_kernel, dim3(grid), dim3(512), LDS_BYTES, stream, p, 20, 21);
#else
    for (int ph = 0; ph < NPHASES; ++ph) { hipLaunchKernelGGL(fwd_kernel, dim3(grid), dim3(512), LDS_BYTES, stream, p, ph, ph + 1); }
#endif
#else
    if (hipMemsetAsync(d_ws, 0, 65536 + 262144, stream) != hipSuccess) { fprintf(stderr, "kernel_launch: memset failed\n"); return; }
    int lo = 0, hi = NPHASES;
    void* args[] = {&p, &lo, &hi};
    hipError_t e = hipLaunchCooperativeKernel((const void*)fwd_kernel, dim3(grid), dim3(512), args, LDS_BYTES, stream);
    if (e != hipSuccess) fprintf(stderr, "kernel_launch: cooperative launch failed: %s (grid %d)\n", hipGetErrorString(e), grid);
#endif
}
```

```cpp
#include <hip/hip_runtime.h>
#include <hip/hip_cooperative_groups.h>
#include <cstdio>
#include <cstdint>
namespace cg = cooperative_groups;
#define N_PHASE_LAUNCH 0
#define FUSE_NORM2 0
namespace pg8 {
#define PG8_LAS __attribute__((address_space(3)))
typedef unsigned short bf16_t;
typedef short bf16x8 __attribute__((ext_vector_type(8)));
typedef float f32x4 __attribute__((ext_vector_type(4)));
typedef unsigned u32x4 __attribute__((ext_vector_type(4)));
constexpr int BM = 256, BK = 64, HALF = 128, HTB = HALF * BK * 2  , STAGE_BYTES = 8 * HTB, NXCD = 8, WGM = 8;

__host__ __device__ __forceinline__ int lds_byte(int r, int c) { const int st = (r >> 4) * 2 + (c >> 5), rr = r & 15, cc = c & 31, ob = rr * 64 + cc * 2; return st * 1024 + (ob ^ (((ob >> 9) & 1) << 5)); }
__host__ __device__ __forceinline__ void stage_rc(int b, int& R, int& C) { const int st = b / 1024, sb = b % 1024, swz = sb ^ (((sb >> 9) & 1) << 5); R = (st >> 1) * 16 + swz / 64; C = (st & 1) * 32 + (swz % 64) / 2; }
__host__ __device__ __forceinline__ int perm32(int rho) { const int n = rho >> 4, i = rho & 15; return 8 * (i >> 2) + 4 * n + (i & 3); }

struct Unit { int pm, pn; };
struct Gemm { const bf16_t* A; const bf16_t* Bt; int M, N, K; };

struct StaticOrder {
    int nM, nN, nwg, G, c;
    __host__ __device__ void init(int M, int N, int G_, int c_) { nM = M / BM; nN = N / BM; nwg = nM * nN; G = G_; c = c_; }
    __host__ __device__ bool next(int i, Unit& u) const {
        const long L = (long)i * G + c; if (L >= nwg) return false;
        int wgid = (int)L; { const int q = nwg / NXCD, r = nwg % NXCD, xcd = wgid % NXCD, off = wgid / NXCD; wgid = (xcd < r ? xcd * (q + 1) : r * (q + 1) + (xcd - r) * q) + off; }
        const int nig = WGM * nN, gid = wgid / nig, fm = gid * WGM, gsz = (nM - fm) < WGM ? (nM - fm) : WGM;
        u.pm = fm + ((wgid % nig) % gsz); u.pn = (wgid % nig) / gsz; return true;
    }
    __device__ __forceinline__ void a_ready(const Unit&) const {}
    __device__ __forceinline__ void done(const Unit&) const {}
};

__device__ __forceinline__ unsigned cvt_pk_bf16(float lo, float hi) { unsigned r; asm volatile("v_cvt_pk_bf16_f32 %0, %1, %2" : "=v"(r) : "v"(lo), "v"(hi)); return r; }

template <class Epi, class Sched, bool ALIGN_EPI = false, bool SP2 = false>
__device__ __forceinline__ void gemm_phase(PG8_LAS unsigned char* lds, const Gemm g, const Sched& S, const Epi& E) {
    const int tid = threadIdx.x, wid = __builtin_amdgcn_readfirstlane(tid >> 6), lane = tid & 63, wr = wid >> 2, wc = wid & 3, fr = lane & 15, fq = lane >> 4;
    const int K = g.K, nt = K / BK;
    unsigned voffA[2], voffB[2];
#pragma unroll
    for (int i = 0; i < 2; ++i) { int R, C; stage_rc(tid * 16 + i * 8192, R, C); const int Rb = Epi::PERM ? ((R & ~31) + perm32(R & 31)) : R;
        voffA[i] = (unsigned)(R * K + C) * 2u; voffB[i] = (unsigned)(Rb * K + C) * 2u; }
    const size_t kstep = (size_t)(BK * 2);
    const size_t hstep = (size_t)HALF * K * 2;
    const size_t tstep = 2 * hstep;
    const unsigned ldsw = (unsigned)wid * 1024u;
    const int aoff = lds_byte(wr * 64 + fr, fq * 8), boff = lds_byte(wc * 32 + fr, fq * 8);
#define PG8_SA(b, h) (((b) * 2 + (h)) * HTB)
#define PG8_SB(b, h) ((4 + (b) * 2 + (h)) * HTB)
#define PG8_STAGE(bufoff, gbase, voff) do { _Pragma("unroll") for (int _i = 0; _i < 2; ++_i) \
        __builtin_amdgcn_global_load_lds((const unsigned*)((const char*)(gbase) + (voff)[_i]), (PG8_LAS unsigned*)(lds + (bufoff) + ldsw + _i * 8192), 16, 0, 0); } while (0)
#define PG8_LDA(dst, b, h) do { _Pragma("unroll") for (int m = 0; m < 4; ++m) _Pragma("unroll") for (int k = 0; k < 2; ++k) dst[m][k] = *(const PG8_LAS bf16x8*)(lds + PG8_SA(b, h) + aoff + m * 2048 + k * 1024); } while (0)
#define PG8_LDB(dst, b, h) do { _Pragma("unroll") for (int n = 0; n < 2; ++n) _Pragma("unroll") for (int k = 0; k < 2; ++k) dst[n][k] = *(const PG8_LAS bf16x8*)(lds + PG8_SB(b, h) + boff + n * 2048 + k * 1024); } while (0)
#define PG8_MMA(ai, bj, At, Bt) do { __builtin_amdgcn_s_setprio(1); _Pragma("unroll") for (int m = 0; m < 4; ++m) _Pragma("unroll") for (int n = 0; n < 2; ++n) _Pragma("unroll") for (int k = 0; k < 2; ++k) \
        acc[ai][bj][m][n] = __builtin_amdgcn_mfma_f32_16x16x32_bf16(Bt[n][k], At[m][k], acc[ai][bj][m][n], 0, 0, 0); __builtin_amdgcn_s_setprio(0); } while (0)
#define PG8_WAIT_V(n) asm volatile("s_waitcnt vmcnt(" #n ")" ::: "memory")
#define PG8_WAIT_L(n) asm volatile("s_waitcnt lgkmcnt(" #n ")" ::: "memory")
#define PG8_BAR __builtin_amdgcn_s_barrier()
#define PG8_SCHED __builtin_amdgcn_sched_barrier(0)
    Unit cur, nxt; int ui = 0;
    if (!S.next(0, cur)) return;
    f32x4 acc[2][2][4][2];
#pragma unroll
    for (int a = 0; a < 2; ++a)
#pragma unroll
        for (int b = 0; b < 2; ++b)
#pragma unroll
            for (int m = 0; m < 4; ++m)
#pragma unroll
                for (int n = 0; n < 2; ++n) acc[a][b][m][n] = (f32x4){0.f, 0.f, 0.f, 0.f};
    bf16x8 At[4][2], B0[2][2], B1[2][2];
    const char* cA = (const char*)g.A + (size_t)cur.pm * tstep; const char* cB = (const char*)g.Bt + (size_t)cur.pn * tstep;
    S.a_ready(cur);
    if constexpr (SP2) {
        PG8_STAGE(PG8_SB(0, 0), cB, voffB); PG8_STAGE(PG8_SB(0, 1), cB + hstep, voffB); PG8_STAGE(PG8_SA(0, 0), cA, voffA); PG8_STAGE(PG8_SA(0, 1), cA + hstep, voffA);
        if (wr == 1) PG8_BAR;
        PG8_WAIT_V(2); PG8_BAR;
        PG8_STAGE(PG8_SB(1, 0), cB + kstep, voffB); PG8_STAGE(PG8_SA(1, 0), cA + kstep, voffA); PG8_STAGE(PG8_SB(1, 1), cB + hstep + kstep, voffB);
        PG8_WAIT_V(6); PG8_BAR;
    } else {
        PG8_STAGE(PG8_SB(0, 0), cB, voffB); PG8_STAGE(PG8_SA(0, 0), cA, voffA); PG8_STAGE(PG8_SB(0, 1), cB + hstep, voffB); PG8_STAGE(PG8_SA(0, 1), cA + hstep, voffA);
        if (wr == 1) PG8_BAR;
        PG8_WAIT_V(4); PG8_BAR;
        PG8_STAGE(PG8_SB(1, 0), cB + kstep, voffB); PG8_STAGE(PG8_SA(1, 0), cA + kstep, voffA); PG8_STAGE(PG8_SB(1, 1), cB + hstep + kstep, voffB);
        PG8_WAIT_V(6); PG8_BAR;
    }
    for (;;) {
        const bool has_next = S.next(ui + 1, nxt);
        const char* nA = has_next ? (const char*)g.A + (size_t)nxt.pm * tstep : cA; const char* nB = has_next ? (const char*)g.Bt + (size_t)nxt.pn * tstep : cB;
        for (int t = 0; t < nt; t += 2) {
            if constexpr (Epi::MID) { if (t == (nt >> 1)) {
                __builtin_amdgcn_sched_barrier(0); asm volatile("s_nop 7\n\ts_nop 7" ::: "memory"); __builtin_amdgcn_sched_barrier(0);
                E.mid(acc, cur, wr, wc, fr, fq);
                __builtin_amdgcn_sched_barrier(0); asm volatile("s_nop 7" ::: "memory"); __builtin_amdgcn_sched_barrier(0); } }
            const bool last = (t == nt - 2);
            const char* a1 = cA + (size_t)(t + 1) * kstep;
            const char* a2 = last ? nA : cA + (size_t)(t + 2) * kstep; const char* b2 = last ? nB : cB + (size_t)(t + 2) * kstep;
            const char* a3 = a2 + kstep; const char* b3 = b2 + kstep;
            if (last && has_next) S.a_ready(nxt);
            if constexpr (SP2) {
            PG8_LDB(B0, 0, 0); PG8_LDB(B1, 0, 1); PG8_SCHED; PG8_LDA(At, 0, 0); PG8_STAGE(PG8_SA(1, 1), a1 + hstep, voffA);
            PG8_WAIT_V(8); PG8_WAIT_L(0); PG8_BAR; PG8_MMA(0, 0, At, B0); PG8_MMA(0, 1, At, B1); PG8_BAR; PG8_SCHED;
            PG8_LDA(At, 0, 1); PG8_STAGE(PG8_SB(0, 0), b2, voffB); PG8_STAGE(PG8_SB(0, 1), b2 + hstep, voffB); PG8_STAGE(PG8_SA(0, 0), a2, voffA);
            PG8_WAIT_V(8); PG8_WAIT_L(0); PG8_BAR; PG8_MMA(1, 0, At, B0); PG8_MMA(1, 1, At, B1); PG8_BAR; PG8_SCHED;
            PG8_LDB(B0, 1, 0); PG8_LDB(B1, 1, 1); PG8_SCHED; PG8_LDA(At, 1, 0); PG8_STAGE(PG8_SA(0, 1), a2 + hstep, voffA);
            PG8_WAIT_V(8); PG8_WAIT_L(0); PG8_BAR; PG8_MMA(0, 0, At, B0); PG8_MMA(0, 1, At, B1); PG8_BAR; PG8_SCHED;
            PG8_LDA(At, 1, 1); PG8_STAGE(PG8_SB(1, 0), b3, voffB); PG8_STAGE(PG8_SB(1, 1), b3 + hstep, voffB); PG8_STAGE(PG8_SA(1, 0), a3, voffA);
            PG8_WAIT_V(8); PG8_WAIT_L(0); PG8_BAR; PG8_MMA(1, 0, At, B0); PG8_MMA(1, 1, At, B1); PG8_BAR; PG8_SCHED;
            } else {
            PG8_LDB(B0, 0, 0); PG8_SCHED; PG8_LDA(At, 0, 0); PG8_STAGE(PG8_SA(1, 1), a1 + hstep, voffA);
            PG8_WAIT_L(8); PG8_BAR; PG8_WAIT_L(0); PG8_MMA(0, 0, At, B0); PG8_BAR; PG8_SCHED;
            PG8_LDB(B1, 0, 1); PG8_STAGE(PG8_SB(0, 0), b2, voffB);
            PG8_BAR; PG8_WAIT_L(0); PG8_MMA(0, 1, At, B1); PG8_BAR;
            PG8_LDA(At, 0, 1); PG8_STAGE(PG8_SA(0, 0), a2, voffA);
            PG8_BAR; PG8_WAIT_L(0); PG8_MMA(1, 0, At, B0); PG8_BAR; PG8_SCHED;
            PG8_STAGE(PG8_SB(0, 1), b2 + hstep, voffB);
            PG8_WAIT_V(6); PG8_BAR; PG8_MMA(1, 1, At, B1); PG8_BAR;
            PG8_LDB(B0, 1, 0); PG8_SCHED; PG8_LDA(At, 1, 0); PG8_STAGE(PG8_SA(0, 1), a2 + hstep, voffA);
            PG8_WAIT_L(8); PG8_BAR; PG8_WAIT_L(0); PG8_MMA(0, 0, At, B0); PG8_BAR; PG8_SCHED;
            PG8_LDB(B1, 1, 1); PG8_STAGE(PG8_SB(1, 0), b3, voffB);
            PG8_BAR; PG8_WAIT_L(0); PG8_MMA(0, 1, At, B1); PG8_BAR;
            PG8_LDA(At, 1, 1); PG8_STAGE(PG8_SA(1, 0), a3, voffA);
            PG8_BAR; PG8_WAIT_L(0); PG8_MMA(1, 0, At, B0); PG8_BAR; PG8_SCHED;
            PG8_STAGE(PG8_SB(1, 1), b3 + hstep, voffB);
            PG8_WAIT_V(6); PG8_BAR; PG8_MMA(1, 1, At, B1); PG8_BAR;
            }
        }
        if constexpr (ALIGN_EPI) { if (wr == 0) PG8_BAR; }
        __builtin_amdgcn_sched_barrier(0); asm volatile("s_nop 7\n\ts_nop 7" ::: "memory"); __builtin_amdgcn_sched_barrier(0);
        if constexpr (!Epi::AFTER_DRAIN) { E(acc, cur, wr, wc, fr, fq); S.done(cur); }
        if (!has_next) break;
#pragma unroll
        for (int a = 0; a < 2; ++a)
#pragma unroll
            for (int b = 0; b < 2; ++b)
#pragma unroll
                for (int m = 0; m < 4; ++m)
#pragma unroll
                    for (int n = 0; n < 2; ++n) acc[a][b][m][n] = (f32x4){0.f, 0.f, 0.f, 0.f};
        cur = nxt; cA = nA; cB = nB; ++ui;
        if constexpr (ALIGN_EPI) { if (wr == 1) PG8_BAR; }
    }
    PG8_WAIT_V(0);
    if constexpr (!ALIGN_EPI) { if (wr == 0) PG8_BAR; }
    PG8_BAR;
    if constexpr (Epi::AFTER_DRAIN) { E.fused(acc, cur, wr, wc, fr, fq, lds, wid, lane); S.done(cur); }
#undef PG8_SA
#undef PG8_SB
#undef PG8_STAGE
#undef PG8_LDA
#undef PG8_LDB
#undef PG8_MMA
#undef PG8_WAIT_V
#undef PG8_WAIT_L
#undef PG8_BAR
#undef PG8_SCHED
}
}

#ifndef PG8_SP2
#define PG8_SP2 true
#endif
#ifndef PG8_ALIGN
#define PG8_ALIGN true
#endif
namespace pg8 {
typedef unsigned u32x2 __attribute__((ext_vector_type(2)));
__device__ __forceinline__ float bfl(unsigned w) { return __uint_as_float(w << 16); }
__device__ __forceinline__ float bfh(unsigned w) { return __uint_as_float(w & 0xffff0000u); }
__device__ __forceinline__ float sigm(float x) { return __builtin_amdgcn_rcpf(1.0f + __expf(-x)); }
struct EpiStore {
    static constexpr bool PERM = true, AFTER_DRAIN = false, MID = false;
    bf16_t* O; int ldc; int nvalid; int split_cols; bf16_t* O2;
    __device__ __forceinline__ void operator()(const f32x4 (&acc)[2][2][4][2], const Unit& u, int wr, int wc, int fr, int fq) const {
        const int row0 = u.pm * BM + wr * 64 + fr; int colt = u.pn * BM; bf16_t* base = O;
        if (split_cols && colt >= split_cols) { base = O2; colt -= split_cols; }
        const int col0 = colt + wc * 32 + 8 * fq;
#pragma unroll
        for (int ai = 0; ai < 2; ++ai)
#pragma unroll
            for (int m = 0; m < 4; ++m) { bf16_t* rowp = base + (size_t)(row0 + ai * HALF + m * 16) * ldc + col0;
#pragma unroll
                for (int bj = 0; bj < 2; ++bj) { const f32x4 v0 = acc[ai][bj][m][0], v1 = acc[ai][bj][m][1];
                    u32x4 w; w.x = cvt_pk_bf16(v0[0], v0[1]); w.y = cvt_pk_bf16(v0[2], v0[3]); w.z = cvt_pk_bf16(v1[0], v1[1]); w.w = cvt_pk_bf16(v1[2], v1[3]);
                    if (col0 + bj * HALF + 8 <= nvalid) *(u32x4*)(rowp + bj * HALF) = w; } }
    }
};
template <int MODE> struct EpiGate {
    static constexpr bool PERM = true, AFTER_DRAIN = false, MID = false;
    const bf16_t* G; bf16_t* O; int ldc;
    __device__ __forceinline__ void operator()(const f32x4 (&acc)[2][2][4][2], const Unit& u, int wr, int wc, int fr, int fq) const {
        const int row0 = u.pm * BM + wr * 64 + fr; const int col0 = u.pn * BM + wc * 32 + 8 * fq;
#pragma unroll
        for (int ai = 0; ai < 2; ++ai)
#pragma unroll
            for (int m = 0; m < 4; ++m) { const size_t off = (size_t)(row0 + ai * HALF + m * 16) * ldc + col0;
#pragma unroll
                for (int bj = 0; bj < 2; ++bj) { const f32x4 v0 = acc[ai][bj][m][0], v1 = acc[ai][bj][m][1];
                    const u32x4 g = *(const u32x4*)(G + off + bj * HALF);
                    float r0 = sigm(bfl(g.x)) * v0[0], r1 = sigm(bfh(g.x)) * v0[1], r2 = sigm(bfl(g.y)) * v0[2], r3 = sigm(bfh(g.y)) * v0[3];
                    float r4 = sigm(bfl(g.z)) * v1[0], r5 = sigm(bfh(g.z)) * v1[1], r6 = sigm(bfl(g.w)) * v1[2], r7 = sigm(bfh(g.w)) * v1[3];
                    if (MODE == 1) { const u32x4 p = *(const u32x4*)(O + off + bj * HALF);
                        r0 += bfl(p.x); r1 += bfh(p.x); r2 += bfl(p.y); r3 += bfh(p.y); r4 += bfl(p.z); r5 += bfh(p.z); r6 += bfl(p.w); r7 += bfh(p.w); }
                    u32x4 w; w.x = cvt_pk_bf16(r0, r1); w.y = cvt_pk_bf16(r2, r3); w.z = cvt_pk_bf16(r4, r5); w.w = cvt_pk_bf16(r6, r7);
                    *(u32x4*)(O + off + bj * HALF) = w; } }
    }
};
struct EpiMerge {
    static constexpr bool PERM = true, AFTER_DRAIN = false, MID = true;
    const bf16_t* GA; const bf16_t* GB; bf16_t* O; int ldc;
    template <bool DIV> __device__ __forceinline__ void scale_pass(f32x4 (&acc)[2][2][4][2], const bf16_t* G, const Unit& u, int wr, int wc, int fr, int fq) const {
        const int row0 = u.pm * BM + wr * 64 + fr; const int col0 = u.pn * BM + wc * 32 + 8 * fq;
#pragma unroll
        for (int ai = 0; ai < 2; ++ai)
#pragma unroll
            for (int m = 0; m < 4; ++m) { const size_t off = (size_t)(row0 + ai * HALF + m * 16) * ldc + col0;
#pragma unroll
                for (int bj = 0; bj < 2; ++bj) { const u32x4 g = *(const u32x4*)(G + off + bj * HALF);
                    f32x4 r0, r1;
                    r0[0] = 1.f + __expf(-bfl(g.x)); r0[1] = 1.f + __expf(-bfh(g.x)); r0[2] = 1.f + __expf(-bfl(g.y)); r0[3] = 1.f + __expf(-bfh(g.y));
                    r1[0] = 1.f + __expf(-bfl(g.z)); r1[1] = 1.f + __expf(-bfh(g.z)); r1[2] = 1.f + __expf(-bfl(g.w)); r1[3] = 1.f + __expf(-bfh(g.w));
                    if (DIV) {
#pragma unroll
                        for (int i = 0; i < 4; ++i) { r0[i] = __builtin_amdgcn_rcpf(r0[i]); r1[i] = __builtin_amdgcn_rcpf(r1[i]); } }
                    acc[ai][bj][m][0] = acc[ai][bj][m][0] * r0; acc[ai][bj][m][1] = acc[ai][bj][m][1] * r1;
                    asm volatile("" ::: "memory"); } }
    }
    __device__ __forceinline__ void mid(f32x4 (&acc)[2][2][4][2], const Unit& u, int wr, int wc, int fr, int fq) const {
        scale_pass<false>(acc, GB, u, wr, wc, fr, fq); scale_pass<true>(acc, GA, u, wr, wc, fr, fq);
    }
    __device__ __forceinline__ void operator()(const f32x4 (&acc)[2][2][4][2], const Unit& u, int wr, int wc, int fr, int fq) const {
        const int row0 = u.pm * BM + wr * 64 + fr; const int col0 = u.pn * BM + wc * 32 + 8 * fq;
#pragma unroll
        for (int ai = 0; ai < 2; ++ai)
#pragma unroll
            for (int m = 0; m < 4; ++m) { const size_t off = (size_t)(row0 + ai * HALF + m * 16) * ldc + col0;
#pragma unroll
                for (int bj = 0; bj < 2; ++bj) { const f32x4 v0 = acc[ai][bj][m][0], v1 = acc[ai][bj][m][1];
                    const u32x4 g = *(const u32x4*)(GB + off + bj * HALF);
                    u32x4 w; w.x = cvt_pk_bf16(sigm(bfl(g.x)) * v0[0], sigm(bfh(g.x)) * v0[1]); w.y = cvt_pk_bf16(sigm(bfl(g.y)) * v0[2], sigm(bfh(g.y)) * v0[3]);
                    w.z = cvt_pk_bf16(sigm(bfl(g.z)) * v1[0], sigm(bfh(g.z)) * v1[1]); w.w = cvt_pk_bf16(sigm(bfl(g.w)) * v1[2], sigm(bfh(g.w)) * v1[3]);
                    *(u32x4*)(O + off + bj * HALF) = w; } }
    }
};
struct EpiRes {
    static constexpr bool PERM = false, AFTER_DRAIN = false, MID = false;
    const float* base; float* out; int ldc;
    __device__ __forceinline__ void operator()(const f32x4 (&acc)[2][2][4][2], const Unit& u, int wr, int wc, int fr, int fq) const {
        const int row0 = u.pm * BM + wr * 64 + fr; const int col0 = u.pn * BM + wc * 32 + 4 * fq;
#pragma unroll
        for (int ai = 0; ai < 2; ++ai)
#pragma unroll
            for (int m = 0; m < 4; ++m) { const size_t off = (size_t)(row0 + ai * HALF + m * 16) * ldc + col0;
#pragma unroll
                for (int bj = 0; bj < 2; ++bj)
#pragma unroll
                    for (int n = 0; n < 2; ++n) { const f32x4 b = *(const f32x4*)(base + off + bj * HALF + n * 16); *(f32x4*)(out + off + bj * HALF + n * 16) = b + acc[ai][bj][m][n]; } }
    }
};

struct EpiResBf16 {
    static constexpr bool PERM = false, AFTER_DRAIN = false, MID = false;
    const float* base; bf16_t* out; int ldc;
    __device__ __forceinline__ void operator()(const f32x4 (&acc)[2][2][4][2], const Unit& u, int wr, int wc, int fr, int fq) const {
        const int row0 = u.pm * BM + wr * 64 + fr; const int col0 = u.pn * BM + wc * 32 + 4 * fq;
#pragma unroll
        for (int ai = 0; ai < 2; ++ai)
#pragma unroll
            for (int m = 0; m < 4; ++m) { const size_t off = (size_t)(row0 + ai * HALF + m * 16) * ldc + col0;
#pragma unroll
                for (int bj = 0; bj < 2; ++bj)
#pragma unroll
                    for (int n = 0; n < 2; ++n) { const f32x4 x = *(const f32x4*)(base + off + bj * HALF + n * 16) + acc[ai][bj][m][n];
                        u32x2 w; w.x = cvt_pk_bf16(x[0], x[1]); w.y = cvt_pk_bf16(x[2], x[3]); *(u32x2*)(out + off + bj * HALF + n * 16) = w; } }
    }
};
struct EpiResNorm {
    static constexpr bool PERM = false, AFTER_DRAIN = false, MID = false;
    const float* base; float* out; bf16_t* H; const float* g; float* SS; int ldc;
    __device__ __forceinline__ void operator()(const f32x4 (&acc)[2][2][4][2], const Unit& u, int wr, int wc, int fr, int fq) const {
        const int row0 = u.pm * BM + wr * 64 + fr; const int col0 = u.pn * BM + wc * 32 + 4 * fq;
#pragma unroll
        for (int ai = 0; ai < 2; ++ai)
#pragma unroll
            for (int m = 0; m < 4; ++m) { const int row = row0 + ai * HALF + m * 16; const size_t off = (size_t)row * ldc + col0; float ss = 0.f;
#pragma unroll
                for (int bj = 0; bj < 2; ++bj)
#pragma unroll
                    for (int n = 0; n < 2; ++n) { const f32x4 x1 = *(const f32x4*)(base + off + bj * HALF + n * 16) + acc[ai][bj][m][n]; *(f32x4*)(out + off + bj * HALF + n * 16) = x1;
                        ss += (x1[0] * x1[0] + x1[1] * x1[1]) + (x1[2] * x1[2] + x1[3] * x1[3]);
                        const f32x4 hh = x1 * *(const f32x4*)(g + col0 + bj * HALF + n * 16);
                        u32x2 w; w.x = cvt_pk_bf16(hh[0], hh[1]); w.y = cvt_pk_bf16(hh[2], hh[3]); *(u32x2*)(H + off + bj * HALF + n * 16) = w; }
                ss += __shfl_xor(ss, 16); ss += __shfl_xor(ss, 32);
                if (fq == 0) (void)__hip_atomic_fetch_add(SS + row, ss, __ATOMIC_RELAXED, __HIP_MEMORY_SCOPE_AGENT); }
    }
};
__device__ __forceinline__ f32x4 dpp_shr1(f32x4 v) { f32x4 r;
#pragma unroll
    for (int i = 0; i < 4; ++i) { const float t = v[i]; r[i] = __int_as_float(__builtin_amdgcn_update_dpp(0, __float_as_int(t), 0x111, 0xF, 0xF, true)); }
    return r; }
__device__ __forceinline__ f32x4 dpp_shl1(f32x4 v) { f32x4 r;
#pragma unroll
    for (int i = 0; i < 4; ++i) { const float t = v[i]; r[i] = __int_as_float(__builtin_amdgcn_update_dpp(0, __float_as_int(t), 0x101, 0xF, 0xF, true)); }
    return r; }
__device__ __forceinline__ f32x4 dpp_mirror(f32x4 v) { f32x4 r;
#pragma unroll
    for (int i = 0; i < 4; ++i) { const float t = v[i]; r[i] = __int_as_float(__builtin_amdgcn_update_dpp(0, __float_as_int(t), 0x140, 0xF, 0xF, true)); }
    return r; }
struct EpiConv {
    static constexpr bool PERM = true, AFTER_DRAIN = false, MID = false;
    bf16_t* ACT; float* SB; const float* cw; const float* cb; PG8_LAS float* xe; bf16_t* Udbg; const float* SS;
    __device__ __forceinline__ void operator()(const f32x4 (&acc)[2][2][4][2], const Unit& u, int wr, int wc, int fr, int fq) const {
        constexpr int FF = 2752, FFP = 2816, NSRC = 5504, NU = 5632;
        if (SS) {
            f32x4 (&sa)[2][2][4][2] = const_cast<f32x4 (&)[2][2][4][2]>(acc);
#pragma unroll
            for (int ai = 0; ai < 2; ++ai)
#pragma unroll
                for (int m = 0; m < 4; ++m) { const float q = __hip_atomic_load(SS + u.pm * BM + ai * HALF + wr * 64 + m * 16 + fr, __ATOMIC_RELAXED, __HIP_MEMORY_SCOPE_AGENT);
                    const float rs = 1.0f / sqrtf(q * (1.0f / 1024.0f) + 1e-6f);
#pragma unroll
                    for (int bj = 0; bj < 2; ++bj)
#pragma unroll
                        for (int n = 0; n < 2; ++n) sa[ai][bj][m][n] = sa[ai][bj][m][n] * rs; } }
#pragma unroll
        for (int ai = 0; ai < 2; ++ai) { const int slab = 2 * ai + wr;
#pragma unroll
            for (int bj = 0; bj < 2; ++bj)
#pragma unroll
                for (int n = 0; n < 2; ++n) {
                    if (fr == 0) *(PG8_LAS f32x4*)(xe + ((slab * 2 + 0) * 4 + wc) * 64 + bj * 32 + fq * 8 + n * 4) = acc[ai][bj][0][n];
                    if (fr == 15) *(PG8_LAS f32x4*)(xe + ((slab * 2 + 1) * 4 + wc) * 64 + bj * 32 + fq * 8 + n * 4) = acc[ai][bj][3][n]; } }
        if (Udbg && u.pm < 128) { const int row0 = u.pm * BM + wr * 64 + fr, col0 = u.pn * BM + wc * 32 + 8 * fq;
#pragma unroll
            for (int ai = 0; ai < 2; ++ai)
#pragma unroll
                for (int m = 0; m < 4; ++m)
#pragma unroll
                    for (int bj = 0; bj < 2; ++bj) { const f32x4 v0 = acc[ai][bj][m][0], v1 = acc[ai][bj][m][1]; u32x4 w; w.x = cvt_pk_bf16(v0[0], v0[1]); w.y = cvt_pk_bf16(v0[2], v0[3]); w.z = cvt_pk_bf16(v1[0], v1[1]); w.w = cvt_pk_bf16(v1[2], v1[3]);
                        *(u32x4*)(Udbg + (size_t)(row0 + ai * HALF + m * 16) * NU + col0 + bj * HALF) = w; } }
        { const int colb = u.pn * BM + wc * 32 + 8 * fq;
          if (wr == 0 && fr < 2) {
#pragma unroll
              for (int bj = 0; bj < 2; ++bj)
#pragma unroll
                  for (int n = 0; n < 2; ++n) *(f32x4*)(SB + (size_t)(u.pm * 4 + fr) * NU + colb + bj * HALF + 4 * n) = acc[0][bj][0][n]; }
          if (wr == 1 && fr >= 14) {
#pragma unroll
              for (int bj = 0; bj < 2; ++bj)
#pragma unroll
                  for (int n = 0; n < 2; ++n) *(f32x4*)(SB + (size_t)(u.pm * 4 + 2 + (fr - 14)) * NU + colb + bj * HALF + 4 * n) = acc[1][bj][3][n]; } }
        asm volatile("s_waitcnt lgkmcnt(0)" ::: "memory"); __builtin_amdgcn_s_barrier(); asm volatile("" ::: "memory");
        const int j0 = u.pn * 128 + wc * 32 + fq * 8;
        const f32x4 z4 = (f32x4){0.f, 0.f, 0.f, 0.f};
#pragma unroll
        for (int n = 0; n < 2; ++n) { const int jn = j0 + 4 * n; const bool valid = jn < FF;
            f32x4 wg0 = z4, wg1 = z4, wg2 = z4, wv0 = z4, wv1 = z4, wv2 = z4, bg = z4, bv = z4;
            if (valid) { wg0 = *(const f32x4*)(cw + jn); wg1 = *(const f32x4*)(cw + NSRC + jn); wg2 = *(const f32x4*)(cw + 2 * NSRC + jn);
                         wv0 = *(const f32x4*)(cw + FF + jn); wv1 = *(const f32x4*)(cw + NSRC + FF + jn); wv2 = *(const f32x4*)(cw + 2 * NSRC + FF + jn);
                         bg = *(const f32x4*)(cb + jn); bv = *(const f32x4*)(cb + FF + jn); }
#pragma unroll
            for (int ai = 0; ai < 2; ++ai) { const int slab = 2 * ai + wr;
                f32x4 topg = z4, topv = z4, botg = z4, botv = z4;
                if (slab > 0) { topg = *(const PG8_LAS f32x4*)(xe + (((slab - 1) * 2 + 1) * 4 + wc) * 64 + fq * 8 + n * 4); topv = *(const PG8_LAS f32x4*)(xe + (((slab - 1) * 2 + 1) * 4 + wc) * 64 + 32 + fq * 8 + n * 4); }
                if (slab < 3) { botg = *(const PG8_LAS f32x4*)(xe + (((slab + 1) * 2 + 0) * 4 + wc) * 64 + fq * 8 + n * 4); botv = *(const PG8_LAS f32x4*)(xe + (((slab + 1) * 2 + 0) * 4 + wc) * 64 + 32 + fq * 8 + n * 4); }
#pragma unroll
                for (int m = 0; m < 4; ++m) { const f32x4 eg = acc[ai][0][m][n], ev = acc[ai][1][m][n];
                    f32x4 upg = dpp_shr1(eg), upv = dpp_shr1(ev), dng = dpp_shl1(eg), dnv = dpp_shl1(ev);
                    const f32x4 ag = (m > 0) ? dpp_mirror(acc[ai][0][m > 0 ? m - 1 : 0][n]) : topg, av = (m > 0) ? dpp_mirror(acc[ai][1][m > 0 ? m - 1 : 0][n]) : topv;
                    const f32x4 cg2 = (m < 3) ? dpp_mirror(acc[ai][0][m < 3 ? m + 1 : 3][n]) : botg, cv2 = (m < 3) ? dpp_mirror(acc[ai][1][m < 3 ? m + 1 : 3][n]) : botv;
                    if (fr == 0) { upg = ag; upv = av; }
                    if (fr == 15) { dng = cg2; dnv = cv2; }
                    const f32x4 g = wg0 * upg + wg1 * eg + wg2 * dng + bg, v = wv0 * upv + wv1 * ev + wv2 * dnv + bv;
                    f32x4 o;
#pragma unroll
                    for (int i = 0; i < 4; ++i) o[i] = valid ? g[i] * sigm(g[i]) * v[i] : 0.f;
                    const int rt = ai * HALF + wr * 64 + m * 16 + fr;
                    if (rt != 0 && rt != 255) { u32x2 w; w.x = cvt_pk_bf16(o[0], o[1]); w.y = cvt_pk_bf16(o[2], o[3]); *(u32x2*)(ACT + (size_t)(u.pm * BM + rt) * FFP + jn) = w; } } }
        }
    }
};
}

constexpr int NB = 32, T = 2048, D = 1024, M = NB * T, MH = M / 2;
constexpr int NMIX = 3360, NMIXP = 3584, NGATE = 2048;
constexpr int DFF = 2752, DFFP = 2816, NUP = 5632, NUPSRC = 5504, NPROJ = 5408;
constexpr int C_GQ = 0, C_GK = 256, C_GV = 512, C_GOG = 1024, C_GAF = 1536, C_GAB = 1552, C_R0 = 1568;
constexpr size_t MiB = 1u << 20;
constexpr size_t WS_WMIX = 1 * MiB, WS_WGATE = 8 * MiB, WS_WGP = 12 * MiB, WS_WRP = 13 * MiB, WS_WOUT = 14 * MiB, WS_WUP = 16 * MiB, WS_WDN = 27 * MiB;
constexpr size_t WS_LW2F = 33 * MiB, WS_LW2B = WS_LW2F + 65536, WS_LA2 = WS_LW2B + 65536, WS_LG2 = WS_LA2 + 65536;
constexpr size_t WS_HB = 36 * MiB, WS_PM = 164 * MiB, WS_GO = 584 * MiB, WS_O = 712 * MiB, WS_E = 840 * MiB, WS_BON = 968 * MiB, WS_END = 970 * MiB;
constexpr size_t WS_H2 = 256 * MiB;
constexpr size_t WS_U = WS_PM, WS_SB = WS_PM, WS_ACT = 516 * MiB, WS_X2 = 36 * MiB;
static_assert(WS_WDN + (size_t)D * DFFP * 2 <= WS_LW2F && WS_LG2 + 131072 <= WS_HB, "weights map");
static_assert(WS_PM + (size_t)M * NMIX * 2 <= WS_GO && WS_U + (size_t)MH * NUP * 2 <= WS_ACT && WS_ACT + (size_t)M * DFFP * 2 <= 1024 * MiB, "ws map");
constexpr int LDS_BYTES = 147456;

#define LAS __attribute__((address_space(3)))
#define DI __device__ __forceinline__
typedef unsigned short bf16;
typedef float f32x4 __attribute__((ext_vector_type(4)));
typedef float f32x2 __attribute__((ext_vector_type(2)));
typedef short bf16x8 __attribute__((ext_vector_type(8)));
typedef unsigned u32x4 __attribute__((ext_vector_type(4)));
typedef unsigned u32x2 __attribute__((ext_vector_type(2)));
typedef _Float16 h16x2 __attribute__((ext_vector_type(2)));
#define LDS_WAIT() asm volatile("s_waitcnt lgkmcnt(0)" ::: "memory")
#define LDS_BARRIER() do { asm volatile("s_waitcnt lgkmcnt(0)" ::: "memory"); __builtin_amdgcn_s_barrier(); asm volatile("" ::: "memory"); } while (0)
#define MFMA16(a, b, c) __builtin_amdgcn_mfma_f32_16x16x32_bf16((a), (b), (c), 0, 0, 0)
#define MFMA_GUARD(v) asm volatile("s_nop 7\n\ts_nop 7" : "+v"(v))

struct Params {
    const float* in[31]; float* out; unsigned char* ws;
};
enum { I_X = 0, I_N1G, I_WIN, I_GWA2F, I_GBAF, I_GWA2B, I_GBAB, I_GNG, I_GPROJ, I_MUP, I_MUN, I_W0F, I_W2F, I_W0B, I_W2B, I_A0, I_A2, I_G2, I_KK, I_KA, I_RK, I_LNW, I_LNB, I_RPROJ,
       I_WOUT, I_N2G, I_FUP, I_FCW, I_FCB, I_FDN, I_NFG };

DI float bfl(unsigned w) { return __uint_as_float(w << 16); }
DI float bfh(unsigned w) { return __uint_as_float(w & 0xffff0000u); }
DI unsigned f2bf(float f) { unsigned u = __float_as_uint(f); return (u + 0x7fffu + ((u >> 16) & 1u)) >> 16; }
typedef __bf16 bf16x2_t __attribute__((ext_vector_type(2)));
DI unsigned pk2(float lo, float hi) { const f32x2 v = {lo, hi}; const bf16x2_t b = __builtin_convertvector(v, bf16x2_t); return __builtin_bit_cast(unsigned, b); }
DI float sigm(float x) { return __builtin_amdgcn_rcpf(1.0f + __expf(-x)); }
DI unsigned pkh2(float lo, float hi) { h16x2 v; v.x = (_Float16)lo; v.y = (_Float16)hi; return __builtin_bit_cast(unsigned, v); }
DI float hlo(unsigned w) { h16x2 v = __builtin_bit_cast(h16x2, w); return (float)v.x; }
DI float hhi(unsigned w) { h16x2 v = __builtin_bit_cast(h16x2, w); return (float)v.y; }
DI float wave_sum(float v) {
#pragma unroll
    for (int o = 1; o < 64; o <<= 1) v += __shfl_xor(v, o);
    return v;
}
DI float quad_sum(float x) {
    x += __builtin_bit_cast(float, __builtin_amdgcn_update_dpp(0, __builtin_bit_cast(int, x), 0xB1, 0xF, 0xF, true));
    x += __builtin_bit_cast(float, __builtin_amdgcn_update_dpp(0, __builtin_bit_cast(int, x), 0x4E, 0xF, 0xF, true));
    return x;
}
DI float oct_sum(float x) {
    x = quad_sum(x);
    x += __builtin_bit_cast(float, __builtin_amdgcn_update_dpp(0, __builtin_bit_cast(int, x), 0x141, 0xF, 0xF, true));
    return x;
}
struct F8 { f32x4 a, b; };
DI F8 unpack8(u32x4 w) { F8 r; r.a = (f32x4){bfl(w.x), bfh(w.x), bfl(w.y), bfh(w.y)}; r.b = (f32x4){bfl(w.z), bfh(w.z), bfl(w.w), bfh(w.w)}; return r; }
DI u32x4 pack8(f32x4 a, f32x4 b) { u32x4 w; w.x = pk2(a[0], a[1]); w.y = pk2(a[2], a[3]); w.z = pk2(b[0], b[1]); w.w = pk2(b[2], b[3]); return w; }
DI f32x4 unpack4(u32x2 w) { return (f32x4){bfl(w.x), bfh(w.x), bfl(w.y), bfh(w.y)}; }
DI u32x2 pack4(f32x4 a) { u32x2 w; w.x = pk2(a[0], a[1]); w.y = pk2(a[2], a[3]); return w; }

DI void tr_item(const float* W, int ldw, int k0, int c0, bf16* WT, int ldt, int n0, LAS float* scr, int lane) {
    const int c = lane & 7;
    if (c0 < 0) {
#pragma unroll
        for (int j = 0; j < 4; ++j) { const int n = (lane >> 3) + 8 * j; *(u32x4*)(WT + (size_t)(n0 + n) * ldt + k0 + 8 * c) = (u32x4){0u, 0u, 0u, 0u}; }
        return;
    }
#pragma unroll 8
    for (int i = 0; i < 32; ++i) { const int kk = 2 * i + (lane >> 5); scr[kk * 33 + (lane & 31)] = W[(size_t)(k0 + kk) * ldw + c0 + (lane & 31)]; }
    LDS_WAIT();
#pragma unroll
    for (int j = 0; j < 4; ++j) { const int n = (lane >> 3) + 8 * j; const LAS float* s = scr + (8 * c) * 33 + n;
        u32x4 o; o.x = pk2(s[0 * 33], s[1 * 33]); o.y = pk2(s[2 * 33], s[3 * 33]); o.z = pk2(s[4 * 33], s[5 * 33]); o.w = pk2(s[6 * 33], s[7 * 33]);
        *(u32x4*)(WT + (size_t)(n0 + n) * ldt + k0 + 8 * c) = o; }
    LDS_WAIT();
}
DI void rms_row_bf16(const float* xrow, const float* g, bf16* orow, int lane) {
    const f32x4* xr = (const f32x4*)xrow + lane;
    f32x4 v[4]; float s = 0.f;
#pragma unroll
    for (int j = 0; j < 4; ++j) { v[j] = xr[64 * j]; s += (v[j].x * v[j].x + v[j].y * v[j].y) + (v[j].z * v[j].z + v[j].w * v[j].w); }
    const float rstd = 1.0f / sqrtf(wave_sum(s) * (1.f / D) + 1e-6f);
    u32x2* o8 = (u32x2*)orow + lane;
#pragma unroll
    for (int j = 0; j < 4; ++j) { const f32x4 gg = ((const f32x4*)g)[lane + 64 * j]; o8[64 * j] = pack4(v[j] * rstd * gg); }
}
DI void rms_rows2_f32(const unsigned char* src, float* dst, int m0, int m1, const float* g, int lane) {
    const f32x4* xa = (const f32x4*)(src + (size_t)m0 * D * 4) + lane; const f32x4* xb = (const f32x4*)(src + (size_t)m1 * D * 4) + lane;
    f32x4 va[4], vb[4]; float sa = 0.f, sb = 0.f;
#pragma unroll
    for (int j = 0; j < 4; ++j) { va[j] = xa[64 * j]; vb[j] = xb[64 * j]; }
#pragma unroll
    for (int j = 0; j < 4; ++j) { sa += (va[j].x * va[j].x + va[j].y * va[j].y) + (va[j].z * va[j].z + va[j].w * va[j].w); sb += (vb[j].x * vb[j].x + vb[j].y * vb[j].y) + (vb[j].z * vb[j].z + vb[j].w * vb[j].w); }
#pragma unroll
    for (int o = 1; o < 64; o <<= 1) { sa += __shfl_xor(sa, o); sb += __shfl_xor(sb, o); }
    const float ra = 1.0f / sqrtf(sa * (1.f / D) + 1e-6f), rb = 1.0f / sqrtf(sb * (1.f / D) + 1e-6f);
    f32x4* oa = (f32x4*)(dst + (size_t)m0 * D) + lane; f32x4* ob = (f32x4*)(dst + (size_t)m1 * D) + lane;
#pragma unroll
    for (int j = 0; j < 4; ++j) { const f32x4 gg = ((const f32x4*)g)[lane + 64 * j]; oa[64 * j] = va[j] * ra * gg; ob[64 * j] = vb[j] * rb * gg; }
}
DI void rms_rows2_bf16(const float* src, const float* g, bf16* dst, int m0, int m1, int lane) {
    const f32x4* xa = (const f32x4*)(src + (size_t)m0 * D) + lane; const f32x4* xb = (const f32x4*)(src + (size_t)m1 * D) + lane;
    f32x4 va[4], vb[4]; float sa = 0.f, sb = 0.f;
#pragma unroll
    for (int j = 0; j < 4; ++j) { va[j] = xa[64 * j]; vb[j] = xb[64 * j]; }
#pragma unroll
    for (int j = 0; j < 4; ++j) { sa += (va[j].x * va[j].x + va[j].y * va[j].y) + (va[j].z * va[j].z + va[j].w * va[j].w); sb += (vb[j].x * vb[j].x + vb[j].y * vb[j].y) + (vb[j].z * vb[j].z + vb[j].w * vb[j].w); }
#pragma unroll
    for (int o = 1; o < 64; o <<= 1) { sa += __shfl_xor(sa, o); sb += __shfl_xor(sb, o); }
    const float ra = 1.0f / sqrtf(sa * (1.f / D) + 1e-6f), rb = 1.0f / sqrtf(sb * (1.f / D) + 1e-6f);
    u32x2* oa = (u32x2*)(dst + (size_t)m0 * D) + lane; u32x2* ob = (u32x2*)(dst + (size_t)m1 * D) + lane;
#pragma unroll
    for (int j = 0; j < 4; ++j) { const f32x4 gg = ((const f32x4*)g)[lane + 64 * j]; oa[64 * j] = pack4(va[j] * ra * gg); ob[64 * j] = pack4(vb[j] * rb * gg); }
}

DI void p0_prologue(const Params& P, LAS unsigned char* lds) {
    const int tid = threadIdx.x, lane = tid & 63, wv = tid >> 6;
    LAS float* scr = (LAS float*)(lds + wv * 16384);
    const int gw = blockIdx.x * 8 + wv, NGW = gridDim.x * 8;
    unsigned char* ws = P.ws;
    constexpr int I0 = 16 * (NMIXP / 32), I1 = 16 * (NGATE / 32), I2 = 8 * 32, I3 = 8 * 32, I4 = 16 * 32, I5 = 16 * (NUP / 32), I6 = 44 * 32, I7 = 16, I8 = 16, I9 = 16, I10 = 32;
    constexpr int NIT = I0 + I1 + I2 + I3 + I4 + I5 + I6 + I7 + I8 + I9 + I10;
    for (int it = gw; it < NIT; it += NGW) {
        int r = it;
        if (r < I0) { const int nb = r % (NMIXP / 32), kb = r / (NMIXP / 32); tr_item(P.in[I_WIN], NPROJ, 64 * kb, 32 * nb < NMIX ? 32 * nb : -1, (bf16*)(ws + WS_WMIX), D, 32 * nb, scr, lane); continue; } r -= I0;
        if (r < I1) { const int nb = r % (NGATE / 32), kb = r / (NGATE / 32); tr_item(P.in[I_WIN], NPROJ, 64 * kb, NMIX + 32 * nb, (bf16*)(ws + WS_WGATE), D, 32 * nb, scr, lane); continue; } r -= I1;
        if (r < I2) { const int nb = r % 32, kb = r / 32; tr_item(P.in[I_GPROJ], D, 64 * kb, 32 * nb, (bf16*)(ws + WS_WGP), 512, 32 * nb, scr, lane); continue; } r -= I2;
        if (r < I3) { const int nb = r % 32, kb = r / 32; tr_item(P.in[I_RPROJ], D, 64 * kb, 32 * nb, (bf16*)(ws + WS_WRP), 512, 32 * nb, scr, lane); continue; } r -= I3;
        if (r < I4) { const int nb = r % 32, kb = r / 32; tr_item(P.in[I_WOUT], D, 64 * kb, 32 * nb, (bf16*)(ws + WS_WOUT), D, 32 * nb, scr, lane); continue; } r -= I4;
        if (r < I5) { const int nb = r % (NUP / 32), kb = r / (NUP / 32); const int n = 32 * nb, j = n >> 8, i = n & 255, ff = 128 * j + (i & 127);
            tr_item(P.in[I_FUP], NUPSRC, 64 * kb, ff < DFF ? (i < 128 ? ff : DFF + ff) : -1, (bf16*)(ws + WS_WUP), D, n, scr, lane); continue; } r -= I5;
        if (r < I6) { const int nb = r % 32, kb = r / 32; tr_item(P.in[I_FDN], D, 64 * kb, kb < 43 ? 32 * nb : -1, (bf16*)(ws + WS_WDN), DFFP, 32 * nb, scr, lane); continue; } r -= I6;
        if (r < I7) { tr_item(P.in[I_W2F], 512, 0, 32 * r, (bf16*)(ws + WS_LW2F), 64, 32 * r, scr, lane); continue; } r -= I7;
        if (r < I8) { tr_item(P.in[I_W2B], 512, 0, 32 * r, (bf16*)(ws + WS_LW2B), 64, 32 * r, scr, lane); continue; } r -= I8;
        if (r < I9) { tr_item(P.in[I_A2], 512, 0, 32 * r, (bf16*)(ws + WS_LA2), 64, 32 * r, scr, lane); continue; } r -= I9;
        { const int nb = r % 16, kb = r / 16; tr_item(P.in[I_G2], 512, 64 * kb, 32 * nb, (bf16*)(ws + WS_LG2), 128, 32 * nb, scr, lane); }
    }
    bf16* HB = (bf16*)(ws + WS_HB);
    for (int m = gw; m < M; m += 2 * NGW) rms_rows2_bf16(P.in[I_X], P.in[I_N1G], HB, m, m + NGW, lane);
}
#define XB_TMO      128
#define XB_XCNT(j)  (256  + 64 * (j))
#define XB_XSUB(j)  (1280 + 64 * (j))
#define XB_XGEN(j)  (2304 + 64 * (j))
#define XB_TOP      3328
#define XB_TOPGEN   3392
#define XCD_BAR_WORDS 3456
#define XB_SPIN_CAP (1u << 18)

__device__ __forceinline__ unsigned xb_ld(unsigned* p)              { return __hip_atomic_load(p, __ATOMIC_RELAXED, __HIP_MEMORY_SCOPE_AGENT); }
__device__ __forceinline__ unsigned xb_add(unsigned* p, unsigned v) { return __hip_atomic_fetch_add(p, v, __ATOMIC_RELAXED, __HIP_MEMORY_SCOPE_AGENT); }
__device__ __forceinline__ unsigned xb_xcc_id() { return (unsigned)__builtin_amdgcn_s_getreg((3 << 11) | 20) & 0xFu; }
#define XB_SPIN(cond, bar) do { unsigned _sp = 0; while (cond) { __builtin_amdgcn_s_sleep(1); \
    if ((++_sp & 255u) == 0u) { if (xb_ld(&(bar)[XB_TMO])) break; if (_sp > XB_SPIN_CAP) { atomicAdd(&(bar)[XB_TMO], 1u); break; } } } } while (0)

struct XcdBarrier {
    unsigned* bar; unsigned x;
    volatile LAS unsigned* st;
};

__device__ __forceinline__ XcdBarrier xcd_barrier_post(unsigned* bar, volatile LAS unsigned* st) {
    XcdBarrier b; b.bar = bar; b.x = xb_xcc_id(); b.st = st;
    if (threadIdx.x == 0) (void)xb_add(&bar[XB_XCNT(b.x)], 1u);
    return b;
}
__device__ __forceinline__ void xcd_barrier_complete(unsigned* bar, unsigned x, unsigned& nloc, unsigned& nx) {
    const unsigned G = gridDim.x * gridDim.y * gridDim.z;
    unsigned sum, cnt, mine, sp = 0u;
    for (;;) {
        sum = 0u; cnt = 0u; mine = 0u;
#pragma unroll
        for (unsigned j = 0; j < 16; ++j) { const unsigned c = xb_ld(&bar[XB_XCNT(j)]); sum += c; cnt += (c > 0u) ? 1u : 0u; mine = (j == x) ? c : mine; }
        if (sum == G) break;
        __builtin_amdgcn_s_sleep(1);
        if ((++sp & 255u) == 0u) { if (xb_ld(&bar[XB_TMO])) break; if (sp > XB_SPIN_CAP) { atomicAdd(&bar[XB_TMO], 1u); break; } }
    }
    nloc = mine > 0u ? mine : 1u; nx = cnt > 0u ? cnt : 1u;
}

__device__ __forceinline__ void xcd_barrier(const XcdBarrier& b) {
    asm volatile("s_waitcnt vmcnt(0)" ::: "memory");
    __syncthreads();
    if (threadIdx.x == 0) {
        unsigned* bar = b.bar;
        __builtin_amdgcn_s_waitcnt(0);
        unsigned nloc = b.st[0], nx = b.st[1];
        if (nloc == 0u) { xcd_barrier_complete(bar, b.x, nloc, nx); b.st[0] = nloc; b.st[1] = nx; }
        const unsigned old = xb_add(&bar[XB_XSUB(b.x)], 1u);
        const unsigned gen = old / nloc;
        if (old + 1u == (gen + 1u) * nloc) {
            __builtin_amdgcn_fence(__ATOMIC_RELEASE, "agent");
            asm volatile("s_waitcnt vmcnt(0)" ::: "memory");
            const unsigned og = xb_add(&bar[XB_TOP], 1u);
            const unsigned tg = og / nx;
            if (og + 1u == (tg + 1u) * nx) xb_add(&bar[XB_TOPGEN], 1u);
            else XB_SPIN(xb_ld(&bar[XB_TOPGEN]) == tg, bar);
            __builtin_amdgcn_fence(__ATOMIC_ACQUIRE, "agent");
            xb_add(&bar[XB_XGEN(b.x)], 1u);
            asm volatile("s_waitcnt vmcnt(0)" ::: "memory");
        } else {
            XB_SPIN(xb_ld(&bar[XB_XGEN(b.x)]) == gen, bar);
            __builtin_amdgcn_fence(__ATOMIC_ACQUIRE, "agent");
            asm volatile("s_waitcnt vmcnt(0)" ::: "memory");
        }
    }
    __syncthreads();
}


DI void gla_unit(const Params& P, LAS unsigned char* lds, int unit) {
    const int tid = threadIdx.x, lane = tid & 63, wv = __builtin_amdgcn_readfirstlane(tid >> 6), fr = lane & 15, q4 = lane >> 4;
    const int dir = unit & 1, h = (unit >> 1) & 3, b = unit >> 3;
    LAS bf16* QI = (LAS bf16*)lds; LAS bf16* KI = QI + 64 * 72; LAS bf16* QE = KI + 64 * 72; LAS bf16* KDT = QE + 64 * 72; LAS bf16* AS = KDT + 64 * 72;
    LAS bf16* VT = AS + 64 * 72; LAS bf16* ST = VT + 128 * 72;
    LAS float* BL = (LAS float*)(ST + 128 * 72); LAS float* AF = BL + 64 * 64; LAS float* GT = AF + 64 * 16;
    const bf16* PM = (const bf16*)(P.ws + WS_PM);
    bf16* GO = (bf16*)(P.ws + WS_GO) + (size_t)dir * M * 512;
    const float* wa2 = dir ? P.in[I_GWA2B] : P.in[I_GWA2F];
    const float* ba = dir ? P.in[I_GBAB] : P.in[I_GBAF];
    const int kq = tid & 63, cgp = tid >> 6;
    float wcol[16];
#pragma unroll
    for (int r = 0; r < 16; ++r) wcol[r] = wa2[r * 256 + 64 * h + kq];
    const float bak = ba[64 * h + kq];
    f32x4 Sacc[4];
#pragma unroll
    for (int i = 0; i < 4; ++i) Sacc[i] = (f32x4){0.f, 0.f, 0.f, 0.f};
    for (int i = tid; i < 128 * 72 / 2; i += 512) ((LAS unsigned*)ST)[i] = 0u;
    const size_t rowbase = (size_t)b * T;
    const int afcol = dir ? C_GAB : C_GAF;
    u32x4 paf = (u32x4){0u, 0u, 0u, 0u}, pq, pk, pva, pvb;
#define GLA_PREFETCH(nn) do { const int chunk_ = dir ? 31 - (nn) : (nn); const size_t tk0_ = rowbase + chunk_ * 64; \
        if (tid < 128) paf = *(const u32x4*)(PM + (tk0_ + (dir ? 63 - (tid >> 1) : (tid >> 1))) * NMIX + afcol + 8 * (tid & 1)); \
        const bf16* rp_ = PM + (tk0_ + (dir ? 63 - (tid >> 3) : (tid >> 3))) * NMIX; \
        pq = *(const u32x4*)(rp_ + C_GQ + 64 * h + 8 * (tid & 7)); pk = *(const u32x4*)(rp_ + C_GK + 64 * h + 8 * (tid & 7)); \
        pva = *(const u32x4*)(rp_ + C_GV + 128 * h + 16 * (tid & 7)); pvb = *(const u32x4*)(rp_ + C_GV + 128 * h + 16 * (tid & 7) + 8); } while (0)
    GLA_PREFETCH(0);
    for (int n = 0; n < 32; ++n) {
        const int chunk = dir ? 31 - n : n;
        const size_t tok0 = rowbase + chunk * 64;
#define GTOK(c) (tok0 + (dir ? 63 - (c) : (c)))
        if (tid < 128) { const int c = tid >> 1, hf = tid & 1; const F8 f = unpack8(paf);
            *(LAS f32x4*)(AF + c * 16 + 8 * hf) = f.a; *(LAS f32x4*)(AF + c * 16 + 8 * hf + 4) = f.b; }
        LDS_BARRIER();
        float pre[8]; float run = 0.f;
#pragma unroll
        for (int j = 0; j < 8; ++j) { const int c = 8 * cgp + j; float z = bak;
#pragma unroll
            for (int r4 = 0; r4 < 4; ++r4) { const f32x4 a = *(LAS f32x4*)(AF + c * 16 + 4 * r4); z += a[0] * wcol[4 * r4] + a[1] * wcol[4 * r4 + 1] + a[2] * wcol[4 * r4 + 2] + a[3] * wcol[4 * r4 + 3]; }
            const float la = -(fmaxf(-z, 0.f) + __logf(1.f + __expf(-fabsf(z)))) * (1.f / 16.f); run += la; pre[j] = run; }
        GT[cgp * 64 + kq] = run;
        LDS_BARRIER();
        float off = 0.f;
#pragma unroll
        for (int g = 0; g < 8; ++g) off += (g < cgp) ? GT[g * 64 + kq] : 0.f;
#pragma unroll
        for (int j = 0; j < 8; ++j) BL[(8 * cgp + j) * 64 + kq] = off + pre[j];
        LDS_BARRIER();
        {   const int c = tid >> 3, k0 = 8 * (tid & 7);
            const F8 q = unpack8(pq), k = unpack8(pk);
            const u32x4 va = pva, vb = pvb;
            f32x4 qi[2], ki[2], qe[2], kd[2];
#pragma unroll
            for (int hh = 0; hh < 2; ++hh) { const f32x4 bl = *(LAS f32x4*)(BL + c * 64 + k0 + 4 * hh), br = *(LAS f32x4*)(BL + 32 * 64 + k0 + 4 * hh), bt = *(LAS f32x4*)(BL + 63 * 64 + k0 + 4 * hh);
                const f32x4 qq = (hh ? q.b : q.a) * 0.125f, kk = hh ? k.b : k.a;
#pragma unroll
                for (int j = 0; j < 4; ++j) { qi[hh][j] = qq[j] * __expf(bl[j] - br[j]); ki[hh][j] = kk[j] * __expf(br[j] - bl[j]); qe[hh][j] = qq[j] * __expf(bl[j]); kd[hh][j] = kk[j] * __expf(bt[j] - bl[j]); } }
            *(LAS u32x4*)(QI + c * 72 + k0) = pack8(qi[0], qi[1]); *(LAS u32x4*)(KI + c * 72 + k0) = pack8(ki[0], ki[1]); *(LAS u32x4*)(QE + c * 72 + k0) = pack8(qe[0], qe[1]);
#pragma unroll
            for (int j = 0; j < 4; ++j) { KDT[(k0 + j) * 72 + c] = (bf16)f2bf(kd[0][j]); KDT[(k0 + 4 + j) * 72 + c] = (bf16)f2bf(kd[1][j]); }
            const int v0 = 16 * (tid & 7);
            VT[(v0 + 0) * 72 + c] = (bf16)(va.x & 0xffffu); VT[(v0 + 1) * 72 + c] = (bf16)(va.x >> 16); VT[(v0 + 2) * 72 + c] = (bf16)(va.y & 0xffffu); VT[(v0 + 3) * 72 + c] = (bf16)(va.y >> 16);
            VT[(v0 + 4) * 72 + c] = (bf16)(va.z & 0xffffu); VT[(v0 + 5) * 72 + c] = (bf16)(va.z >> 16); VT[(v0 + 6) * 72 + c] = (bf16)(va.w & 0xffffu); VT[(v0 + 7) * 72 + c] = (bf16)(va.w >> 16);
            VT[(v0 + 8) * 72 + c] = (bf16)(vb.x & 0xffffu); VT[(v0 + 9) * 72 + c] = (bf16)(vb.x >> 16); VT[(v0 + 10) * 72 + c] = (bf16)(vb.y & 0xffffu); VT[(v0 + 11) * 72 + c] = (bf16)(vb.y >> 16);
            VT[(v0 + 12) * 72 + c] = (bf16)(vb.z & 0xffffu); VT[(v0 + 13) * 72 + c] = (bf16)(vb.z >> 16); VT[(v0 + 14) * 72 + c] = (bf16)(vb.w & 0xffffu); VT[(v0 + 15) * 72 + c] = (bf16)(vb.w >> 16);
        }
        if (n + 1 < 32) GLA_PREFETCH(n + 1);
        LDS_BARRIER();
        {   const int ct = wv >> 1;
#pragma unroll
            for (int tt = 0; tt < 2; ++tt) { const int st = 2 * (wv & 1) + tt;
                f32x4 acc = (f32x4){0.f, 0.f, 0.f, 0.f};
#pragma unroll
                for (int ks = 0; ks < 2; ++ks) { const bf16x8 a = *(LAS bf16x8*)(KI + (16 * st + fr) * 72 + 32 * ks + 8 * q4), bb = *(LAS bf16x8*)(QI + (16 * ct + fr) * 72 + 32 * ks + 8 * q4); acc = MFMA16(a, bb, acc); }
                MFMA_GUARD(acc);
                const int cg0 = 16 * ct + fr, sg0 = 16 * st + 4 * q4;
#pragma unroll
                for (int j = 0; j < 4; ++j) acc[j] = (cg0 >= sg0 + j) ? acc[j] : 0.f;
                *(LAS u32x2*)(AS + (16 * ct + fr) * 72 + 16 * st + 4 * q4) = pack4(acc); }
        }
        LDS_BARRIER();
        {   bf16x8 av[2], as_[2];
#pragma unroll
            for (int ks = 0; ks < 2; ++ks) { av[ks] = *(LAS bf16x8*)(VT + (16 * wv + fr) * 72 + 32 * ks + 8 * q4); as_[ks] = *(LAS bf16x8*)(ST + (16 * wv + fr) * 72 + 32 * ks + 8 * q4); }
#pragma unroll
            for (int ct = 0; ct < 4; ++ct) { f32x4 o = (f32x4){0.f, 0.f, 0.f, 0.f};
#pragma unroll
                for (int ks = 0; ks < 2; ++ks) { const bf16x8 bb = *(LAS bf16x8*)(AS + (16 * ct + fr) * 72 + 32 * ks + 8 * q4); o = MFMA16(av[ks], bb, o); }
#pragma unroll
                for (int ks = 0; ks < 2; ++ks) { const bf16x8 bb = *(LAS bf16x8*)(QE + (16 * ct + fr) * 72 + 32 * ks + 8 * q4); o = MFMA16(as_[ks], bb, o); }
                MFMA_GUARD(o);
                *(u32x2*)(GO + GTOK(16 * ct + fr) * 512 + 128 * h + 16 * wv + 4 * q4) = pack4(o); }
#pragma unroll
            for (int kt = 0; kt < 4; ++kt) { const f32x4 bt = *(LAS f32x4*)(BL + 63 * 64 + 16 * kt + 4 * q4);
                f32x4 s = Sacc[kt]; s[0] *= __expf(bt[0]); s[1] *= __expf(bt[1]); s[2] *= __expf(bt[2]); s[3] *= __expf(bt[3]);
#pragma unroll
                for (int ks = 0; ks < 2; ++ks) { const bf16x8 a = *(LAS bf16x8*)(KDT + (16 * kt + fr) * 72 + 32 * ks + 8 * q4); s = MFMA16(a, av[ks], s); }
                MFMA_GUARD(s); Sacc[kt] = s; }
        }
        LDS_BARRIER();
#pragma unroll
        for (int kt = 0; kt < 4; ++kt) *(LAS u32x2*)(ST + (16 * wv + fr) * 72 + 16 * kt + 4 * q4) = pack4(Sacc[kt]);
#undef GTOK
    }
#undef GLA_PREFETCH
    LDS_BARRIER();
}
DI void gla_post(const Params& P) {
    const int tid = threadIdx.x, lane = tid & 63, wv = tid >> 6;
    const bf16* PM = (const bf16*)(P.ws + WS_PM); const bf16* GO = (const bf16*)(P.ws + WS_GO); bf16* O = (bf16*)(P.ws + WS_O);
    const F8 ng = {*(const f32x4*)(P.in[I_GNG] + 8 * lane), *(const f32x4*)(P.in[I_GNG] + 8 * lane + 4)};
    for (int m = blockIdx.x * 8 + wv; m < M; m += gridDim.x * 8) {
        const F8 a = unpack8(*(const u32x4*)(GO + (size_t)m * 512 + 8 * lane)), bq = unpack8(*(const u32x4*)(GO + (size_t)(M + m) * 512 + 8 * lane));
        const F8 og = unpack8(*(const u32x4*)(PM + (size_t)m * NMIX + C_GOG + 8 * lane));
        const f32x4 o0 = a.a + bq.a, o1 = a.b + bq.b;
        float ss = (o0[0] * o0[0] + o0[1] * o0[1]) + (o0[2] * o0[2] + o0[3] * o0[3]) + (o1[0] * o1[0] + o1[1] * o1[1]) + (o1[2] * o1[2] + o1[3] * o1[3]);
        ss += __shfl_xor(ss, 1); ss += __shfl_xor(ss, 2); ss += __shfl_xor(ss, 4); ss += __shfl_xor(ss, 8);
        const float rs = 1.0f / sqrtf(ss * (1.f / 128.f) + 1e-5f);
        f32x4 r0, r1;
#pragma unroll
        for (int j = 0; j < 4; ++j) { r0[j] = o0[j] * rs * ng.a[j] * (og.a[j] * sigm(og.a[j])); r1[j] = o1[j] * rs * ng.b[j] * (og.b[j] * sigm(og.b[j])); }
        *(u32x4*)(O + (size_t)m * 512 + 8 * lane) = pack8(r0, r1);
    }
}

template <int K> DI void lora_mma(f32x4 (&acc)[4][4], const bf16* Wt, LAS bf16* X, int ldx, int fr, int q4) {
#pragma unroll
    for (int a = 0; a < 4; ++a)
#pragma unroll
        for (int c = 0; c < 4; ++c) acc[a][c] = (f32x4){0.f, 0.f, 0.f, 0.f};
#pragma unroll
    for (int ks = 0; ks < K / 32; ++ks) { bf16x8 af[4];
#pragma unroll
        for (int nt = 0; nt < 4; ++nt) af[nt] = *(const bf16x8*)(Wt + (size_t)(32 * (nt >> 1) + 8 * (fr >> 2) + 4 * (nt & 1) + (fr & 3)) * K + 32 * ks + 8 * q4);
#pragma unroll
        for (int mt = 0; mt < 4; ++mt) { const bf16x8 bb = *(LAS bf16x8*)(X + (16 * mt + fr) * ldx + 32 * ks + 8 * q4);
#pragma unroll
            for (int nt = 0; nt < 4; ++nt) acc[nt][mt] = MFMA16(af[nt], bb, acc[nt][mt]); } }
    __builtin_amdgcn_sched_barrier(0); asm volatile("s_nop 7\n\ts_nop 7" ::: "memory"); __builtin_amdgcn_sched_barrier(0);
}
DI f32x4 shift4(const bf16* rp, bool hp, bool hn, const float* mup, const float* mun) {
    const f32x4 c = unpack4(*(const u32x2*)rp);
    const f32x4 pp = hp ? unpack4(*(const u32x2*)(rp - NMIX)) : (f32x4){0.f, 0.f, 0.f, 0.f};
    const f32x4 pn = hn ? unpack4(*(const u32x2*)(rp + NMIX)) : (f32x4){0.f, 0.f, 0.f, 0.f};
    return c + *(const f32x4*)mup * (pp - c) + *(const f32x4*)mun * (pn - c);
}
DI F8 shift8(const bf16* rp, bool hp, bool hn, const float* mup, const float* mun) {
    const F8 c = unpack8(*(const u32x4*)rp);
    F8 pp, pn; const f32x4 z = (f32x4){0.f, 0.f, 0.f, 0.f};
    if (hp) pp = unpack8(*(const u32x4*)(rp - NMIX)); else { pp.a = z; pp.b = z; }
    if (hn) pn = unpack8(*(const u32x4*)(rp + NMIX)); else { pn.a = z; pn.b = z; }
    F8 r; r.a = c.a + *(const f32x4*)mup * (pp.a - c.a) + *(const f32x4*)mun * (pn.a - c.a);
    r.b = c.b + *(const f32x4*)(mup + 4) * (pp.b - c.b) + *(const f32x4*)(mun + 4) * (pn.b - c.b); return r;
}
DI void r1_tile(const Params& P, LAS unsigned char* lds, int tile) {
    const int tid = threadIdx.x, lane = tid & 63, hd = __builtin_amdgcn_readfirstlane(tid >> 6), fr = lane & 15, q4 = lane >> 4;
    LAS bf16* XW = (LAS bf16*)lds; LAS bf16* XA = XW + 64 * 72; LAS bf16* XG = XA + 64 * 72;
    const bf16* PM = (const bf16*)(P.ws + WS_PM);
    const float* mup = P.in[I_MUP]; const float* mun = P.in[I_MUN];
    const int t0 = tile * 64;
    {   const int row = tid >> 3, g8 = tid & 7; const int tok = t0 + row, tpos = tok & (T - 1);
        const bool hp = tpos > 0, hn = tpos < T - 1;
        const bf16* rp = PM + (size_t)tok * NMIX + C_R0 + 1536 + 32 * g8;
#pragma unroll
        for (int v4 = 0; v4 < 4; ++v4) { F8 s = shift8(rp + 8 * v4, hp, hn, mup + 1536 + 32 * g8 + 8 * v4, mun + 1536 + 32 * g8 + 8 * v4);
            if (g8 < 2) {
#pragma unroll
                for (int j = 0; j < 4; ++j) { s.a[j] = 1.f - 2.f * __builtin_amdgcn_rcpf(__expf(2.f * s.a[j]) + 1.f); s.b[j] = 1.f - 2.f * __builtin_amdgcn_rcpf(__expf(2.f * s.b[j]) + 1.f); }
                *(LAS u32x4*)(XW + row * 72 + 32 * g8 + 8 * v4) = pack8(s.a, s.b);
            } else if (g8 < 4) { *(LAS u32x4*)(XA + row * 72 + 32 * (g8 - 2) + 8 * v4) = pack8(s.a, s.b);
            } else {
#pragma unroll
                for (int j = 0; j < 4; ++j) { s.a[j] = sigm(s.a[j]); s.b[j] = sigm(s.b[j]); }
                *(LAS u32x4*)(XG + row * 136 + 32 * (g8 - 4) + 8 * v4) = pack8(s.a, s.b); } }
    }
    __syncthreads();
    unsigned char* dout = (unsigned char*)P.out;
    bf16* KP = (bf16*)dout; bf16* KKn = KP + (size_t)M * 512; bf16* BB = KKn + (size_t)M * 512; bf16* GG = BB + (size_t)M * 512;
    unsigned short* EF = (unsigned short*)(P.ws + WS_E); unsigned short* EB = EF + (size_t)M * 512;
    float* BON = (float*)(P.ws + WS_BON);
    const int ch8 = 64 * hd + 8 * q4;
    f32x4 acc[4][4];
    lora_mma<64>(acc, (const bf16*)(P.ws + WS_LA2) + (size_t)(64 * hd) * 64, XA, 72, fr, q4);
#pragma unroll
    for (int np = 0; np < 2; ++np) { const f32x4 a0a = *(const f32x4*)(P.in[I_A0] + ch8 + 32 * np), a0b = *(const f32x4*)(P.in[I_A0] + ch8 + 32 * np + 4);
#pragma unroll
        for (int mt = 0; mt < 4; ++mt)
#pragma unroll
            for (int j = 0; j < 4; ++j) { acc[2 * np][mt][j] = sigm(acc[2 * np][mt][j] + a0a[j]); acc[2 * np + 1][mt][j] = sigm(acc[2 * np + 1][mt][j] + a0b[j]); } }
#pragma unroll
    for (int mt = 0; mt < 4; ++mt) { const int tok = t0 + 16 * mt + fr, tpos = tok & (T - 1); const bool hp = tpos > 0, hn = tpos < T - 1;
        const bf16* rp = PM + (size_t)tok * NMIX + C_R0 + ch8;
        F8 ks[2]; float ss = 0.f;
#pragma unroll
        for (int np = 0; np < 2; ++np) { ks[np] = shift8(rp + 512 + 32 * np, hp, hn, mup + 512 + ch8 + 32 * np, mun + 512 + ch8 + 32 * np);
            const f32x4 k0 = ks[np].a * *(const f32x4*)(P.in[I_KK] + ch8 + 32 * np), k1 = ks[np].b * *(const f32x4*)(P.in[I_KK] + ch8 + 32 * np + 4);
            ss += ((k0[0] * k0[0] + k0[1] * k0[1]) + (k0[2] * k0[2] + k0[3] * k0[3])) + ((k1[0] * k1[0] + k1[1] * k1[1]) + (k1[2] * k1[2] + k1[3] * k1[3])); }
        ss += __shfl_xor(ss, 16); ss += __shfl_xor(ss, 32);
        const float inv = 1.0f / fmaxf(sqrtf(ss), 1e-12f);
        float bon = 0.f;
#pragma unroll
        for (int np = 0; np < 2; ++np) { const f32x4 aa = acc[2 * np][mt], ab = acc[2 * np + 1][mt];
            const f32x4 kka = *(const f32x4*)(P.in[I_KK] + ch8 + 32 * np), kkb = *(const f32x4*)(P.in[I_KK] + ch8 + 32 * np + 4);
            const f32x4 kaa = *(const f32x4*)(P.in[I_KA] + ch8 + 32 * np), kab = *(const f32x4*)(P.in[I_KA] + ch8 + 32 * np + 4);
            const f32x4 kn0 = ks[np].a * kka * inv, kn1 = ks[np].b * kkb * inv;
            const f32x4 kp0 = ks[np].a * (1.0f + (aa - 1.0f) * kaa), kp1 = ks[np].b * (1.0f + (ab - 1.0f) * kab);
            const f32x4 bb0 = kn0 * aa, bb1 = kn1 * ab;
            const F8 rs = shift8(rp + 32 * np, hp, hn, mup + ch8 + 32 * np, mun + ch8 + 32 * np);
            const f32x4 rk0 = *(const f32x4*)(P.in[I_RK] + ch8 + 32 * np), rk1 = *(const f32x4*)(P.in[I_RK] + ch8 + 32 * np + 4);
            bon += ((rs.a[0] * kp0[0] * rk0[0] + rs.a[1] * kp0[1] * rk0[1]) + (rs.a[2] * kp0[2] * rk0[2] + rs.a[3] * kp0[3] * rk0[3]))
                 + ((rs.b[0] * kp1[0] * rk1[0] + rs.b[1] * kp1[1] * rk1[1]) + (rs.b[2] * kp1[2] * rk1[2] + rs.b[3] * kp1[3] * rk1[3]));
            const size_t o = (size_t)tok * 512 + ch8 + 32 * np;
            *(u32x4*)(KP + o) = pack8(kp0, kp1); *(u32x4*)(KKn + o) = pack8(kn0, kn1); *(u32x4*)(BB + o) = pack8(bb0, bb1); }
        bon += __shfl_xor(bon, 16); bon += __shfl_xor(bon, 32);
        if (q4 == 0) BON[(size_t)tok * 8 + hd] = bon; }
#pragma unroll
    for (int d = 0; d < 2; ++d) {
        lora_mma<64>(acc, (const bf16*)(P.ws + (d ? WS_LW2B : WS_LW2F)) + (size_t)(64 * hd) * 64, XW, 72, fr, q4);
        unsigned short* E = d ? EB : EF; const float* w0 = d ? P.in[I_W0B] : P.in[I_W0F];
#pragma unroll
        for (int np = 0; np < 2; ++np) { const f32x4 w0a = *(const f32x4*)(w0 + ch8 + 32 * np), w0b = *(const f32x4*)(w0 + ch8 + 32 * np + 4);
#pragma unroll
            for (int mt = 0; mt < 4; ++mt) { const f32x4 a = acc[2 * np][mt], c = acc[2 * np + 1][mt]; u32x4 w;
                w.x = pkh2(0.60653066f * sigm(a[0] + w0a[0]), 0.60653066f * sigm(a[1] + w0a[1])); w.y = pkh2(0.60653066f * sigm(a[2] + w0a[2]), 0.60653066f * sigm(a[3] + w0a[3]));
                w.z = pkh2(0.60653066f * sigm(c[0] + w0b[0]), 0.60653066f * sigm(c[1] + w0b[1])); w.w = pkh2(0.60653066f * sigm(c[2] + w0b[2]), 0.60653066f * sigm(c[3] + w0b[3]));
                *(u32x4*)(E + (size_t)(t0 + 16 * mt + fr) * 512 + ch8 + 32 * np) = w; } }
    }
    lora_mma<128>(acc, (const bf16*)(P.ws + WS_LG2) + (size_t)(64 * hd) * 128, XG, 136, fr, q4);
#pragma unroll
    for (int np = 0; np < 2; ++np)
#pragma unroll
        for (int mt = 0; mt < 4; ++mt) *(u32x4*)(GG + (size_t)(t0 + 16 * mt + fr) * 512 + ch8 + 32 * np) = pack8(acc[2 * np][mt], acc[2 * np + 1][mt]);
    __syncthreads();
}

constexpr int TC = 16;
#define OPI(buf, d, arr) (OP + ((((buf) * 2 + (d)) * 6 + (arr)) * (TC * 64)))
DI void scan_load(const Params& P, LAS float* OP, int buf, int ci, int b, int hd, int ltid) {
    const int d = ltid >> 7, i = (ltid >> 3) & 15, c8 = ltid & 7;
    const int step = TC * ci + i, tpos = d ? T - 1 - step : step; const size_t tok = (size_t)b * T + tpos;
    const int ch0 = 64 * hd + 8 * c8;
    const bf16* PM = (const bf16*)(P.ws + WS_PM);
    const bf16* KP = (const bf16*)P.out; const bf16* KKn = KP + (size_t)M * 512; const bf16* BB = KKn + (size_t)M * 512;
    const unsigned short* E = (const unsigned short*)(P.ws + WS_E) + (size_t)d * M * 512;
    const F8 kp = unpack8(*(const u32x4*)(KP + tok * 512 + ch0)), kk = unpack8(*(const u32x4*)(KKn + tok * 512 + ch0)), bb = unpack8(*(const u32x4*)(BB + tok * 512 + ch0));
    const u32x4 ew = *(const u32x4*)(E + tok * 512 + ch0);
    const bool hp = tpos > 0, hn = tpos < T - 1;
    const bf16* rp = PM + tok * NMIX + C_R0 + ch0;
    const F8 r = shift8(rp, hp, hn, P.in[I_MUP] + ch0, P.in[I_MUN] + ch0), v = shift8(rp + 1024, hp, hn, P.in[I_MUP] + 1024 + ch0, P.in[I_MUN] + 1024 + ch0);
    const int o = i * 64 + 8 * c8;
    *(LAS f32x4*)(OPI(buf, d, 0) + o) = -kk.a; *(LAS f32x4*)(OPI(buf, d, 0) + o + 4) = -kk.b;
    f32x4 w0, w1; w0[0] = __expf(-hlo(ew.x)); w0[1] = __expf(-hhi(ew.x)); w0[2] = __expf(-hlo(ew.y)); w0[3] = __expf(-hhi(ew.y));
    w1[0] = __expf(-hlo(ew.z)); w1[1] = __expf(-hhi(ew.z)); w1[2] = __expf(-hlo(ew.w)); w1[3] = __expf(-hhi(ew.w));
    *(LAS f32x4*)(OPI(buf, d, 1) + o) = w0; *(LAS f32x4*)(OPI(buf, d, 1) + o + 4) = w1;
    *(LAS f32x4*)(OPI(buf, d, 2) + o) = bb.a; *(LAS f32x4*)(OPI(buf, d, 2) + o + 4) = bb.b;
    *(LAS f32x4*)(OPI(buf, d, 3) + o) = kp.a; *(LAS f32x4*)(OPI(buf, d, 3) + o + 4) = kp.b;
    *(LAS f32x4*)(OPI(buf, d, 4) + o) = r.a; *(LAS f32x4*)(OPI(buf, d, 4) + o + 4) = r.b;
    *(LAS f32x4*)(OPI(buf, d, 5) + o) = v.a; *(LAS f32x4*)(OPI(buf, d, 5) + o + 4) = v.b;
}
DI void scan_flush(const Params& P, LAS float* YB, int buf, int ci, int b, int hd, int ltid) {
    const int d = ltid >> 7, i = (ltid >> 3) & 15, c8 = ltid & 7;
    const int step = TC * ci + i, tpos = d ? T - 1 - step : step; const size_t tok = (size_t)b * T + tpos;
    bf16* Y = (bf16*)(P.ws + WS_GO) + (size_t)d * M * 512;
    const LAS float* y = YB + (buf * 2 + d) * (TC * 64) + i * 64 + 8 * c8;
    *(u32x4*)(Y + tok * 512 + 64 * hd + 8 * c8) = pack8(*(const LAS f32x4*)y, *(const LAS f32x4*)(y + 4));
}
struct ScanOps { f32x2 nk[4], w[4], bb[4], kx[4], rx[4]; f32x4 vv; };
DI void scan_ops_load(ScanOps& o, const LAS float* base, const LAS float* vb, int i) {
#pragma unroll
    for (int hh = 0; hh < 2; ++hh) { const f32x4 t0 = *(const LAS f32x4*)(base + 0 * TC * 64 + i * 64 + 4 * hh), t1 = *(const LAS f32x4*)(base + 1 * TC * 64 + i * 64 + 4 * hh), t2 = *(const LAS f32x4*)(base + 2 * TC * 64 + i * 64 + 4 * hh),
                                                   t3 = *(const LAS f32x4*)(base + 3 * TC * 64 + i * 64 + 4 * hh), t4 = *(const LAS f32x4*)(base + 4 * TC * 64 + i * 64 + 4 * hh);
        o.nk[2 * hh] = (f32x2){t0[0], t0[1]}; o.nk[2 * hh + 1] = (f32x2){t0[2], t0[3]}; o.w[2 * hh] = (f32x2){t1[0], t1[1]}; o.w[2 * hh + 1] = (f32x2){t1[2], t1[3]};
        o.bb[2 * hh] = (f32x2){t2[0], t2[1]}; o.bb[2 * hh + 1] = (f32x2){t2[2], t2[3]}; o.kx[2 * hh] = (f32x2){t3[0], t3[1]}; o.kx[2 * hh + 1] = (f32x2){t3[2], t3[3]};
        o.rx[2 * hh] = (f32x2){t4[0], t4[1]}; o.rx[2 * hh + 1] = (f32x2){t4[2], t4[3]}; }
    o.vv = *(const LAS f32x4*)(vb + i * 64);
}
DI void scan_step(f32x2 (&S)[4][4], const ScanOps& o, LAS float* yb, int i, int c8) {
    float sa[4];
#pragma unroll
    for (int j = 0; j < 4; ++j) { f32x2 a = S[j][0] * o.nk[0]; a = S[j][1] * o.nk[1] + a; a = S[j][2] * o.nk[2] + a; a = S[j][3] * o.nk[3] + a; sa[j] = oct_sum(a.x + a.y); }
    f32x4 yo;
#pragma unroll
    for (int j = 0; j < 4; ++j) { const f32x2 sav = (f32x2){sa[j], sa[j]}, vjv = (f32x2){o.vv[j], o.vv[j]};
#pragma unroll
        for (int p = 0; p < 4; ++p) S[j][p] = S[j][p] * o.w[p] + (sav * o.bb[p] + vjv * o.kx[p]);
        f32x2 y = S[j][0] * o.rx[0]; y = S[j][1] * o.rx[1] + y; y = S[j][2] * o.rx[2] + y; y = S[j][3] * o.rx[3] + y; yo[j] = oct_sum(y.x + y.y); }
    if (c8 == 0) *(LAS f32x4*)(yb + i * 64) = yo;
}
DI void scan_unit(const Params& P, LAS unsigned char* lds, int bh) {
    const int tid = threadIdx.x, lane = tid & 63, wv = __builtin_amdgcn_readfirstlane(tid >> 6);
    const int b = bh >> 3, hd = bh & 7;
    LAS float* OP = (LAS float*)lds; LAS float* YB = OP + 2 * 2 * 6 * TC * 64;
    constexpr int NCH = T / TC;
    const bool loader = wv >= 4; const int ltid = tid - 256;
    const int d = wv >> 1, c8 = lane & 7, rbase = 32 * (wv & 1) + 4 * (lane >> 3);
    f32x2 S[4][4];
#pragma unroll
    for (int j = 0; j < 4; ++j)
#pragma unroll
        for (int p = 0; p < 4; ++p) S[j][p] = (f32x2){0.f, 0.f};
    if (loader) scan_load(P, OP, 0, 0, b, hd, ltid);
    __syncthreads();
    for (int ci = 0; ci < NCH; ++ci) {
        const int buf = ci & 1;
        if (loader) {
            if (ci + 1 < NCH) scan_load(P, OP, buf ^ 1, ci + 1, b, hd, ltid);
            if (ci > 0) scan_flush(P, YB, buf ^ 1, ci - 1, b, hd, ltid);
        } else {
            const LAS float* base = OPI(buf, d, 0) + 8 * c8;
            const LAS float* vb = OPI(buf, d, 5) + rbase;
            LAS float* yb = YB + (buf * 2 + d) * (TC * 64) + rbase;
            ScanOps cur, nxt; scan_ops_load(cur, base, vb, 0);
#pragma unroll 1
            for (int i = 0; i < TC; i += 2) {
                scan_ops_load(nxt, base, vb, i + 1);
                scan_step(S, cur, yb, i, c8);
                if (i + 2 < TC) scan_ops_load(cur, base, vb, i + 2);
                scan_step(S, nxt, yb, i + 1, c8);
            }
        }
        __syncthreads();
    }
    if (loader) scan_flush(P, YB, (NCH - 1) & 1, NCH - 1, b, hd, ltid);
    __syncthreads();
}
DI void r3_post(const Params& P) {
    const int tid = threadIdx.x, lane = tid & 63, wv = tid >> 6;
    const bf16* PM = (const bf16*)(P.ws + WS_PM); const bf16* Y = (const bf16*)(P.ws + WS_GO); bf16* O = (bf16*)(P.ws + WS_O);
    const bf16* GG = (const bf16*)P.out + (size_t)3 * M * 512; const float* BON = (const float*)(P.ws + WS_BON);
    const F8 lw = {*(const f32x4*)(P.in[I_LNW] + 8 * lane), *(const f32x4*)(P.in[I_LNW] + 8 * lane + 4)}, lb = {*(const f32x4*)(P.in[I_LNB] + 8 * lane), *(const f32x4*)(P.in[I_LNB] + 8 * lane + 4)};
    for (int m = blockIdx.x * 8 + wv; m < M; m += gridDim.x * 8) {
        const int tpos = m & (T - 1);
        const F8 a = unpack8(*(const u32x4*)(Y + (size_t)m * 512 + 8 * lane)), bq = unpack8(*(const u32x4*)(Y + (size_t)(M + m) * 512 + 8 * lane));
        const F8 g = unpack8(*(const u32x4*)(GG + (size_t)m * 512 + 8 * lane));
        const F8 v = shift8(PM + (size_t)m * NMIX + C_R0 + 1024 + 8 * lane, tpos > 0, tpos < T - 1, P.in[I_MUP] + 1024 + 8 * lane, P.in[I_MUN] + 1024 + 8 * lane);
        const float bon = BON[(size_t)m * 8 + (lane >> 3)];
        const f32x4 y0 = a.a + bq.a, y1 = a.b + bq.b;
        float s = (y0[0] + y0[1]) + (y0[2] + y0[3]) + (y1[0] + y1[1]) + (y1[2] + y1[3]);
        s += __shfl_xor(s, 1); s += __shfl_xor(s, 2); s += __shfl_xor(s, 4);
        const float mu = s * (1.f / 64.f);
        const f32x4 d0 = y0 - mu, d1 = y1 - mu;
        float q = (d0[0] * d0[0] + d0[1] * d0[1]) + (d0[2] * d0[2] + d0[3] * d0[3]) + (d1[0] * d1[0] + d1[1] * d1[1]) + (d1[2] * d1[2] + d1[3] * d1[3]);
        q += __shfl_xor(q, 1); q += __shfl_xor(q, 2); q += __shfl_xor(q, 4);
        const float rs = 1.0f / sqrtf(q * (1.f / 64.f) + 64.f * 1e-5f);
        const f32x4 o0 = (d0 * rs * lw.a + lb.a + bon * v.a) * g.a, o1 = (d1 * rs * lw.b + lb.b + bon * v.b) * g.b;
        *(u32x4*)(O + (size_t)(M + m) * 512 + 8 * lane) = pack8(o0, o1);
    }
}

DI void conv_phase(const Params& P, int half, int sel = 0) {
    const bf16* U = (const bf16*)(P.ws + WS_U); bf16* ACT = (bf16*)(P.ws + WS_ACT);
    const float* cw = P.in[I_FCW]; const float* cb = P.in[I_FCB];
    constexpr int NCG = DFFP / 8;
    const int nitems = (MH / 8) * NCG;
    for (int it = blockIdx.x * 512 + threadIdx.x; it < nitems; it += gridDim.x * 512) {
        const int run = it / NCG, cgp = it - run * NCG, j0 = 8 * cgp;
        const int tl0 = run * 8, tg0 = half * MH + tl0, tpos0 = tg0 & (T - 1);
        bf16* ap = ACT + (size_t)tg0 * DFFP + j0;
        if (j0 >= DFF) {
#pragma unroll
            for (int rr = 0; rr < 8; ++rr) *(u32x4*)(ap + (size_t)rr * DFFP) = (u32x4){0u, 0u, 0u, 0u};
            continue; }
        const int ucol = 256 * (j0 >> 7) + (j0 & 127);
        F8 wg[3], wvv[3];
#pragma unroll
        for (int t = 0; t < 3; ++t) { wg[t].a = *(const f32x4*)(cw + t * NUPSRC + j0); wg[t].b = *(const f32x4*)(cw + t * NUPSRC + j0 + 4); wvv[t].a = *(const f32x4*)(cw + t * NUPSRC + DFF + j0); wvv[t].b = *(const f32x4*)(cw + t * NUPSRC + DFF + j0 + 4); }
        const F8 bg = {*(const f32x4*)(cb + j0), *(const f32x4*)(cb + j0 + 4)}, bv = {*(const f32x4*)(cb + DFF + j0), *(const f32x4*)(cb + DFF + j0 + 4)};
        const bf16* up = U + (size_t)tl0 * NUP + ucol;
        const f32x4 z = (f32x4){0.f, 0.f, 0.f, 0.f};
        F8 pg, pv, cg_, cv, ng, nv;
        if (tpos0 > 0) { pg = unpack8(*(const u32x4*)(up - NUP)); pv = unpack8(*(const u32x4*)(up - NUP + 128)); } else { pg.a = z; pg.b = z; pv.a = z; pv.b = z; }
        cg_ = unpack8(*(const u32x4*)up); cv = unpack8(*(const u32x4*)(up + 128));
#pragma unroll
        for (int rr = 0; rr < 8; ++rr) {
            if (tpos0 + rr + 1 < T) { ng = unpack8(*(const u32x4*)(up + (size_t)(rr + 1) * NUP)); nv = unpack8(*(const u32x4*)(up + (size_t)(rr + 1) * NUP + 128)); } else { ng.a = z; ng.b = z; nv.a = z; nv.b = z; }
            const f32x4 g0 = wg[0].a * pg.a + wg[1].a * cg_.a + wg[2].a * ng.a + bg.a, g1 = wg[0].b * pg.b + wg[1].b * cg_.b + wg[2].b * ng.b + bg.b;
            const f32x4 x0 = wvv[0].a * pv.a + wvv[1].a * cv.a + wvv[2].a * nv.a + bv.a, x1 = wvv[0].b * pv.b + wvv[1].b * cv.b + wvv[2].b * nv.b + bv.b;
            f32x4 o0, o1;
#pragma unroll
            for (int j = 0; j < 4; ++j) { o0[j] = g0[j] * sigm(g0[j]) * x0[j]; o1[j] = g1[j] * sigm(g1[j]) * x1[j]; }
            { const int rt_ = (tl0 + rr) & 255; const bool edge = (rt_ == 0 || rt_ == 255);
              if (sel == 0 || (sel == 1 && edge) || (sel == 2 && !edge)) *(u32x4*)(ap + (size_t)rr * DFFP) = pack8(o0, o1); }
            pg = cg_; pv = cv; cg_ = ng; cv = nv;
        }
    }
}
#ifndef DBG_UDUMP
#define DBG_UDUMP 0
#endif
DI void conv_fix(const Params& P) {
    const float* SB = (const float*)(P.ws + (DBG_UDUMP ? 868 * MiB : WS_SB)); bf16* ACT = (bf16*)(P.ws + WS_ACT);
    const float* cw = P.in[I_FCW]; const float* cb = P.in[I_FCB];
    constexpr int NG = DFFP / 4;
    const int nitems = 256 * 2 * NG;
    for (int it = blockIdx.x * 512 + threadIdx.x; it < nitems; it += gridDim.x * 512) {
        const int jg = it % NG, rw = it / NG, which = rw & 1, pm = rw >> 1, j = 4 * jg;
        bf16* ap = ACT + (size_t)(pm * 256 + (which ? 255 : 0)) * DFFP + j;
        if (j >= DFF) { *(u32x2*)ap = (u32x2){0u, 0u}; continue; }
        const int col = 256 * (j >> 7) + (j & 127);
        const f32x4 z = (f32x4){0.f, 0.f, 0.f, 0.f};
        const float* cur = SB + (size_t)(pm * 4 + (which ? 3 : 0)) * NUP + col;
        const float* prv = which ? SB + (size_t)(pm * 4 + 2) * NUP + col : ((pm & 7) ? SB + (size_t)((pm - 1) * 4 + 3) * NUP + col : nullptr);
        const float* nxt = which ? (((pm & 7) != 7) ? SB + (size_t)((pm + 1) * 4 + 0) * NUP + col : nullptr) : SB + (size_t)(pm * 4 + 1) * NUP + col;
        const f32x4 cgv = *(const f32x4*)cur, cvv = *(const f32x4*)(cur + 128);
        const f32x4 pg = prv ? *(const f32x4*)prv : z, pv = prv ? *(const f32x4*)(prv + 128) : z;
        const f32x4 ng = nxt ? *(const f32x4*)nxt : z, nv = nxt ? *(const f32x4*)(nxt + 128) : z;
        const f32x4 g = *(const f32x4*)(cw + j) * pg + *(const f32x4*)(cw + NUPSRC + j) * cgv + *(const f32x4*)(cw + 2 * NUPSRC + j) * ng + *(const f32x4*)(cb + j);
        const f32x4 v = *(const f32x4*)(cw + DFF + j) * pv + *(const f32x4*)(cw + NUPSRC + DFF + j) * cvv + *(const f32x4*)(cw + 2 * NUPSRC + DFF + j) * nv + *(const f32x4*)(cb + DFF + j);
        f32x4 o;
#pragma unroll
        for (int i = 0; i < 4; ++i) o[i] = g[i] * sigm(g[i]) * v[i];
        *(u32x2*)ap = pack4(o);
    }
}
#ifndef DBG_SKIPMASK
#define DBG_SKIPMASK 0
#endif
#ifndef FUSE_NORM2
#define FUSE_NORM2 1
#endif
#ifndef FUSE_CONV
#define FUSE_CONV 1
#endif
#ifndef SEAM_ACQ
#define SEAM_ACQ 0
#endif
#ifndef USE_CG_SYNC
#define USE_CG_SYNC 0
#endif
#ifndef N_PHASE_LAUNCH
#define N_PHASE_LAUNCH 0
#endif
constexpr int NPHASES = 16;
__global__ void __launch_bounds__(512, 2) fwd_kernel(Params P, int ph_lo, int ph_hi) {
    extern __shared__ __attribute__((aligned(16))) unsigned char lds_raw[];
    LAS unsigned char* lds = (LAS unsigned char*)lds_raw;
    const int tid = threadIdx.x, wv = tid >> 6, lane = tid & 63;
    unsigned char* ws = P.ws;
    bf16* HB = (bf16*)(ws + WS_HB);
    const int G = gridDim.x, bx = blockIdx.x;
#if N_PHASE_LAUNCH
#define SEAM() do {} while (0)
#define SEAM0() do {} while (0)
#else
    cg::grid_group grid = cg::this_grid();
    volatile LAS unsigned* xst = (volatile LAS unsigned*)(lds + 131072 + 64);
    if (tid < 2) xst[tid] = 0u;
    __syncthreads();
    const XcdBarrier xbar = xcd_barrier_post((unsigned*)ws, xst);
#define SEAM0() grid.sync()
#if USE_CG_SYNC
#define SEAM() grid.sync()
#else
#if SEAM_ACQ
#define SEAM() do { xcd_barrier(xbar); __builtin_amdgcn_fence(__ATOMIC_ACQUIRE, "agent"); } while (0)
#else
#define SEAM() xcd_barrier(xbar)
#endif
#endif
#endif
#define IN(k) (ph_lo <= (k) && (k) < ph_hi)
#define GEMM_CALL(EPI, A_, B_, M_, N_, K_, E_) do { pg8::Gemm g{(const pg8::bf16_t*)(A_), (const pg8::bf16_t*)(B_), (M_), (N_), (K_)}; pg8::StaticOrder S; S.init((M_), (N_), G, bx); \
        pg8::gemm_phase<EPI, pg8::StaticOrder, PG8_ALIGN, PG8_SP2>(lds, g, S, (E_)); } while (0)
#define GEMM_CALL4(EPI, A_, B_, M_, N_, K_, E_) do { pg8::Gemm g{(const pg8::bf16_t*)(A_), (const pg8::bf16_t*)(B_), (M_), (N_), (K_)}; pg8::StaticOrder S; S.init((M_), (N_), G, bx); \
        pg8::gemm_phase<EPI, pg8::StaticOrder, PG8_ALIGN, false>(lds, g, S, (E_)); } while (0)
    if (IN(0)) { p0_prologue(P, lds); SEAM0(); }
    if (IN(1)) { pg8::EpiStore E{(pg8::bf16_t*)(ws + WS_PM), NMIX, NMIX, 0, nullptr}; GEMM_CALL(pg8::EpiStore, HB, ws + WS_WMIX, M, NMIXP, D, E);
#ifdef PROBE_G1A2
                 __syncthreads(); GEMM_CALL(pg8::EpiStore, HB, ws + WS_WMIX, M, NMIXP, D, E);
#endif
                 SEAM(); }
    if (IN(2)) { for (int u = bx; u < 256; u += G) gla_unit(P, lds, u);
#ifdef PROBE_GLA2
                 for (int u = bx; u < 256; u += G) gla_unit(P, lds, u);
#endif
                 SEAM(); }
    if (IN(3)) { gla_post(P); for (int t = bx; t < M / 64; t += G) r1_tile(P, lds, t);
#ifdef PROBE_R12
                 for (int t = bx; t < M / 64; t += G) r1_tile(P, lds, t);
#endif
                 SEAM(); }
    if (IN(5)) { for (int u = bx; u < 256; u += G) scan_unit(P, lds, u);
#ifdef PROBE_SCAN2
                 for (int u = bx; u < 256; u += G) scan_unit(P, lds, u);
#endif
                 SEAM(); }
    if (IN(6)) { r3_post(P); __syncthreads();
                 pg8::EpiStore E{(pg8::bf16_t*)(ws + WS_E), D, D, D, (pg8::bf16_t*)P.out}; GEMM_CALL(pg8::EpiStore, HB, ws + WS_WGATE, M, NGATE, D, E); SEAM(); }
    if (IN(7)) { { pg8::EpiGate<0> E{(const pg8::bf16_t*)(ws + WS_E), (pg8::bf16_t*)HB, D}; GEMM_CALL4(pg8::EpiGate<0>, ws + WS_O, ws + WS_WGP, M, D, 512, E); }
                 __syncthreads();
                 { pg8::EpiGate<1> E{(const pg8::bf16_t*)P.out, (pg8::bf16_t*)HB, D}; GEMM_CALL4(pg8::EpiGate<1>, ws + WS_O + (size_t)M * 512 * 2, ws + WS_WRP, M, D, 512, E); }
                 SEAM(); }
#if FUSE_NORM2
    if (IN(8)) { pg8::EpiResNorm E{P.in[I_X], P.out, (pg8::bf16_t*)(ws + WS_H2), P.in[I_N2G], (float*)(ws + 65536), D}; GEMM_CALL(pg8::EpiResNorm, HB, ws + WS_WOUT, M, D, D, E); SEAM(); }
#else
    if (IN(8)) { pg8::EpiRes E{P.in[I_X], P.out, D}; GEMM_CALL(pg8::EpiRes, HB, ws + WS_WOUT, M, D, D, E); SEAM(); }
#endif
#if !FUSE_NORM2
    if (IN(9)) { for (int m = bx * 8 + wv; m < M; m += G * 16) rms_rows2_bf16(P.out, P.in[I_N2G], HB, m, m + G * 8, lane); SEAM(); }
#endif
#if FUSE_CONV
    if (IN(10)) { pg8::EpiConv E{(pg8::bf16_t*)(ws + WS_ACT), (float*)(ws + (DBG_UDUMP ? 868 * MiB : WS_SB)), P.in[I_FCW], P.in[I_FCB], (PG8_LAS float*)(lds + 131072 + 256), DBG_UDUMP ? (pg8::bf16_t*)(ws + WS_U) : nullptr, FUSE_NORM2 ? (const float*)(ws + 65536) : nullptr};
                  GEMM_CALL(pg8::EpiConv, FUSE_NORM2 ? (bf16*)(ws + WS_H2) : HB, ws + WS_WUP, M, NUP, D, E); SEAM(); }
    if (IN(11)) { conv_fix(P); SEAM(); }
#if DBG_UDUMP
    if (IN(12)) { conv_phase(P, 0, 2); SEAM(); }
#endif
#ifdef DBG_SEL
#pragma unroll 1
    for (int half = 0; half < 2; ++half) {
        if (IN(12)) { pg8::EpiStore E{(pg8::bf16_t*)(ws + WS_U), NUP, NUP, 0, nullptr}; GEMM_CALL(pg8::EpiStore, HB + (size_t)half * MH * D, ws + WS_WUP, MH, NUP, D, E); SEAM(); }
        if (IN(12)) { conv_phase(P, half, DBG_SEL); SEAM(); }
    }
#endif
#else
#pragma unroll 1
    for (int half = 0; half < 2; ++half) {
        if (IN(10 + 2 * half)) { pg8::EpiStore E{(pg8::bf16_t*)(ws + WS_U), NUP, NUP, 0, nullptr}; GEMM_CALL(pg8::EpiStore, HB + (size_t)half * MH * D, ws + WS_WUP, MH, NUP, D, E); SEAM(); }
        if (IN(11 + 2 * half)) { conv_phase(P, half); SEAM(); }
    }
#endif
    if (IN(14)) { pg8::EpiRes E{P.out, (float*)(ws + WS_X2), D}; GEMM_CALL(pg8::EpiRes, ws + WS_ACT, ws + WS_WDN, M, D, DFFP, E); SEAM(); }
    if (IN(15)) { for (int m = bx * 8 + wv; m < M; m += G * 16) rms_rows2_f32(ws + WS_X2, P.out, m, m + G * 8, P.in[I_NFG], lane); }
#ifdef DBG_DUMP
    if (IN(20)) { const bf16* src = (const bf16*)(ws + DBG_SRC); for (size_t i = (size_t)bx * 512 + tid; i < (size_t)M * D; i += (size_t)G * 512) P.out[i] = bfl(src[i]); }
#endif
}

extern "C" void kernel_launch(void* const* d_in, const int* in_sizes, int n_in, void* d_out, int out_size, void* d_ws, size_t ws_size, hipStream_t stream) {
    static int grid = 0;
    if (grid == 0) {
        if (n_in != 31 || in_sizes[0] != M * D || out_size != M * D || ws_size < 1024 * MiB) { fprintf(stderr, "kernel_launch: unexpected shapes (n_in %d, in0 %d, out %d, ws %zu)\n", n_in, n_in > 0 ? in_sizes[0] : -1, out_size, ws_size); grid = -1; return; }
        int dev = 0, cus = 0, per_cu = 0;
        if (hipGetDevice(&dev) != hipSuccess || hipDeviceGetAttribute(&cus, hipDeviceAttributeMultiprocessorCount, dev) != hipSuccess) { grid = -1; return; }
        if (hipFuncSetAttribute((const void*)fwd_kernel, hipFuncAttributeMaxDynamicSharedMemorySize, LDS_BYTES) != hipSuccess) { fprintf(stderr, "kernel_launch: hipFuncSetAttribute failed\n"); grid = -1; return; }
        if (hipOccupancyMaxActiveBlocksPerMultiprocessor(&per_cu, (const void*)fwd_kernel, 512, LDS_BYTES) != hipSuccess || per_cu < 1) { fprintf(stderr, "kernel_launch: occupancy query says %d\n", per_cu); per_cu = 1; }
        (void)hipGetLastError();
        grid = cus * 1;
    }
    if (grid < 0) return;
    Params p{};
    for (int i = 0; i < 31; ++i) p.in[i] = (const float*)d_in[i];
    p.out = (float*)d_out; p.ws = (unsigned char*)d_ws;
#if N_PHASE_LAUNCH
#ifdef DBG_DUMP
    for (int ph = 0; ph <= DBG_DUMP; ++ph) { if (DBG_SKIPMASK & (1 << ph)) continue; hipLaunchKernelGGL(fwd_kernel, dim3(grid), dim3(512), LDS_BYTES, stream, p, ph, ph + 1); }
    if (DBG_DUMP < 14) hipLaunchKernelGGL(fwd_kernel, dim3(grid), dim3(512), LDS_BYTES, stream, p, 20, 21);
#else
    for (int ph = 0; ph < NPHASES; ++ph) { hipLaunchKernelGGL(fwd_kernel, dim3(grid), dim3(512), LDS_BYTES, stream, p, ph, ph + 1); }
#endif
#else
    if (hipMemsetAsync(d_ws, 0, 65536 + 262144, stream) != hipSuccess) { fprintf(stderr, "kernel_launch: memset failed\n"); return; }
    int lo = 0, hi = NPHASES;
    void* args[] = {&p, &lo, &hi};
    hipError_t e = hipLaunchCooperativeKernel((const void*)fwd_kernel, dim3(grid), dim3(512), args, LDS_BYTES, stream);
    if (e != hipSuccess) fprintf(stderr, "kernel_launch: cooperative launch failed: %s (grid %d)\n", hipGetErrorString(e), grid);
#endif
}
```

```cpp
#include <hip/hip_runtime.h>
#include <hip/hip_cooperative_groups.h>
#include <cstdio>
#include <cstdint>
namespace cg = cooperative_groups;
#define N_PHASE_LAUNCH 0
#define FUSE_NORM2 0
namespace pg8 {
#define PG8_LAS __attribute__((address_space(3)))
typedef unsigned short bf16_t;
typedef short bf16x8 __attribute__((ext_vector_type(8)));
typedef float f32x4 __attribute__((ext_vector_type(4)));
typedef unsigned u32x4 __attribute__((ext_vector_type(4)));
constexpr int BM = 256, BK = 64, HALF = 128, HTB = HALF * BK * 2  , STAGE_BYTES = 8 * HTB, NXCD = 8, WGM = 8;

__host__ __device__ __forceinline__ int lds_byte(int r, int c) { const int st = (r >> 4) * 2 + (c >> 5), rr = r & 15, cc = c & 31, ob = rr * 64 + cc * 2; return st * 1024 + (ob ^ (((ob >> 9) & 1) << 5)); }
__host__ __device__ __forceinline__ void stage_rc(int b, int& R, int& C) { const int st = b / 1024, sb = b % 1024, swz = sb ^ (((sb >> 9) & 1) << 5); R = (st >> 1) * 16 + swz / 64; C = (st & 1) * 32 + (swz % 64) / 2; }
__host__ __device__ __forceinline__ int perm32(int rho) { const int n = rho >> 4, i = rho & 15; return 8 * (i >> 2) + 4 * n + (i & 3); }

struct Unit { int pm, pn; };
struct Gemm { const bf16_t* A; const bf16_t* Bt; int M, N, K; };

struct StaticOrder {
    int nM, nN, nwg, G, c;
    __host__ __device__ void init(int M, int N, int G_, int c_) { nM = M / BM; nN = N / BM; nwg = nM * nN; G = G_; c = c_; }
    __host__ __device__ bool next(int i, Unit& u) const {
        const long L = (long)i * G + c; if (L >= nwg) return false;
        int wgid = (int)L; { const int q = nwg / NXCD, r = nwg % NXCD, xcd = wgid % NXCD, off = wgid / NXCD; wgid = (xcd < r ? xcd * (q + 1) : r * (q + 1) + (xcd - r) * q) + off; }
        const int nig = WGM * nN, gid = wgid / nig, fm = gid * WGM, gsz = (nM - fm) < WGM ? (nM - fm) : WGM;
        u.pm = fm + ((wgid % nig) % gsz); u.pn = (wgid % nig) / gsz; return true;
    }
    __device__ __forceinline__ void a_ready(const Unit&) const {}
    __device__ __forceinline__ void done(const Unit&) const {}
};

__device__ __forceinline__ unsigned cvt_pk_bf16(float lo, float hi) { unsigned r; asm volatile("v_cvt_pk_bf16_f32 %0, %1, %2" : "=v"(r) : "v"(lo), "v"(hi)); return r; }

template <class Epi, class Sched, bool ALIGN_EPI = false, bool SP2 = false>
__device__ __forceinline__ void gemm_phase(PG8_LAS unsigned char* lds, const Gemm g, const Sched& S, const Epi& E) {
    const int tid = threadIdx.x, wid = __builtin_amdgcn_readfirstlane(tid >> 6), lane = tid & 63, wr = wid >> 2, wc = wid & 3, fr = lane & 15, fq = lane >> 4;
    const int K = g.K, nt = K / BK;
    unsigned voffA[2], voffB[2];
#pragma unroll
    for (int i = 0; i < 2; ++i) { int R, C; stage_rc(tid * 16 + i * 8192, R, C); const int Rb = Epi::PERM ? ((R & ~31) + perm32(R & 31)) : R;
        voffA[i] = (unsigned)(R * K + C) * 2u; voffB[i] = (unsigned)(Rb * K + C) * 2u; }
    const size_t kstep = (size_t)(BK * 2);
    const size_t hstep = (size_t)HALF * K * 2;
    const size_t tstep = 2 * hstep;
    const unsigned ldsw = (unsigned)wid * 1024u;
    const int aoff = lds_byte(wr * 64 + fr, fq * 8), boff = lds_byte(wc * 32 + fr, fq * 8);
#define PG8_SA(b, h) (((b) * 2 + (h)) * HTB)
#define PG8_SB(b, h) ((4 + (b) * 2 + (h)) * HTB)
#define PG8_STAGE(bufoff, gbase, voff) do { _Pragma("unroll") for (int _i = 0; _i < 2; ++_i) \
        __builtin_amdgcn_global_load_lds((const unsigned*)((const char*)(gbase) + (voff)[_i]), (PG8_LAS unsigned*)(lds + (bufoff) + ldsw + _i * 8192), 16, 0, 0); } while (0)
#define PG8_LDA(dst, b, h) do { _Pragma("unroll") for (int m = 0; m < 4; ++m) _Pragma("unroll") for (int k = 0; k < 2; ++k) dst[m][k] = *(const PG8_LAS bf16x8*)(lds + PG8_SA(b, h) + aoff + m * 2048 + k * 1024); } while (0)
#define PG8_LDB(dst, b, h) do { _Pragma("unroll") for (int n = 0; n < 2; ++n) _Pragma("unroll") for (int k = 0; k < 2; ++k) dst[n][k] = *(const PG8_LAS bf16x8*)(lds + PG8_SB(b, h) + boff + n * 2048 + k * 1024); } while (0)
#define PG8_MMA(ai, bj, At, Bt) do { __builtin_amdgcn_s_setprio(1); _Pragma("unroll") for (int m = 0; m < 4; ++m) _Pragma("unroll") for (int n = 0; n < 2; ++n) _Pragma("unroll") for (int k = 0; k < 2; ++k) \
        acc[ai][bj][m][n] = __builtin_amdgcn_mfma_f32_16x16x32_bf16(Bt[n][k], At[m][k], acc[ai][bj][m][n], 0, 0, 0); __builtin_amdgcn_s_setprio(0); } while (0)
#define PG8_WAIT_V(n) asm volatile("s_waitcnt vmcnt(" #n ")" ::: "memory")
#define PG8_WAIT_L(n) asm volatile("s_waitcnt lgkmcnt(" #n ")" ::: "memory")
#define PG8_BAR __builtin_amdgcn_s_barrier()
#define PG8_SCHED __builtin_amdgcn_sched_barrier(0)
    Unit cur, nxt; int ui = 0;
    if (!S.next(0, cur)) return;
    f32x4 acc[2][2][4][2];
#pragma unroll
    for (int a = 0; a < 2; ++a)
#pragma unroll
        for (int b = 0; b < 2; ++b)
#pragma unroll
            for (int m = 0; m < 4; ++m)
#pragma unroll
                for (int n = 0; n < 2; ++n) acc[a][b][m][n] = (f32x4){0.f, 0.f, 0.f, 0.f};
    bf16x8 At[4][2], B0[2][2], B1[2][2];
    const char* cA = (const char*)g.A + (size_t)cur.pm * tstep; const char* cB = (const char*)g.Bt + (size_t)cur.pn * tstep;
    S.a_ready(cur);
    if constexpr (SP2) {
        PG8_STAGE(PG8_SB(0, 0), cB, voffB); PG8_STAGE(PG8_SB(0, 1), cB + hstep, voffB); PG8_STAGE(PG8_SA(0, 0), cA, voffA); PG8_STAGE(PG8_SA(0, 1), cA + hstep, voffA);
        if (wr == 1) PG8_BAR;
        PG8_WAIT_V(2); PG8_BAR;
        PG8_STAGE(PG8_SB(1, 0), cB + kstep, voffB); PG8_STAGE(PG8_SA(1, 0), cA + kstep, voffA); PG8_STAGE(PG8_SB(1, 1), cB + hstep + kstep, voffB);
        PG8_WAIT_V(6); PG8_BAR;
    } else {
        PG8_STAGE(PG8_SB(0, 0), cB, voffB); PG8_STAGE(PG8_SA(0, 0), cA, voffA); PG8_STAGE(PG8_SB(0, 1), cB + hstep, voffB); PG8_STAGE(PG8_SA(0, 1), cA + hstep, voffA);
        if (wr == 1) PG8_BAR;
        PG8_WAIT_V(4); PG8_BAR;
        PG8_STAGE(PG8_SB(1, 0), cB + kstep, voffB); PG8_STAGE(PG8_SA(1, 0), cA + kstep, voffA); PG8_STAGE(PG8_SB(1, 1), cB + hstep + kstep, voffB);
        PG8_WAIT_V(6); PG8_BAR;
    }
    for (;;) {
        const bool has_next = S.next(ui + 1, nxt);
        const char* nA = has_next ? (const char*)g.A + (size_t)nxt.pm * tstep : cA; const char* nB = has_next ? (const char*)g.Bt + (size_t)nxt.pn * tstep : cB;
        for (int t = 0; t < nt; t += 2) {
            if constexpr (Epi::MID) { if (t == (nt >> 1)) {
                __builtin_amdgcn_sched_barrier(0); asm volatile("s_nop 7\n\ts_nop 7" ::: "memory"); __builtin_amdgcn_sched_barrier(0);
                E.mid(acc, cur, wr, wc, fr, fq);
                __builtin_amdgcn_sched_barrier(0); asm volatile("s_nop 7" ::: "memory"); __builtin_amdgcn_sched_barrier(0); } }
            const bool last = (t == nt - 2);
            const char* a1 = cA + (size_t)(t + 1) * kstep;
            const char* a2 = last ? nA : cA + (size_t)(t + 2) * kstep; const char* b2 = last ? nB : cB + (size_t)(t + 2) * kstep;
            const char* a3 = a2 + kstep; const char* b3 = b2 + kstep;
            if (last && has_next) S.a_ready(nxt);
            if constexpr (SP2) {
            PG8_LDB(B0, 0, 0); PG8_LDB(B1, 0, 1); PG8_SCHED; PG8_LDA(At, 0, 0); PG8_STAGE(PG8_SA(1, 1), a1 + hstep, voffA);
            PG8_WAIT_V(8); PG8_WAIT_L(0); PG8_BAR; PG8_MMA(0, 0, At, B0); PG8_MMA(0, 1, At, B1); PG8_BAR; PG8_SCHED;
            PG8_LDA(At, 0, 1); PG8_STAGE(PG8_SB(0, 0), b2, voffB); PG8_STAGE(PG8_SB(0, 1), b2 + hstep, voffB); PG8_STAGE(PG8_SA(0, 0), a2, voffA);
            PG8_WAIT_V(8); PG8_WAIT_L(0); PG8_BAR; PG8_MMA(1, 0, At, B0); PG8_MMA(1, 1, At, B1); PG8_BAR; PG8_SCHED;
            PG8_LDB(B0, 1, 0); PG8_LDB(B1, 1, 1); PG8_SCHED; PG8_LDA(At, 1, 0); PG8_STAGE(PG8_SA(0, 1), a2 + hstep, voffA);
            PG8_WAIT_V(8); PG8_WAIT_L(0); PG8_BAR; PG8_MMA(0, 0, At, B0); PG8_MMA(0, 1, At, B1); PG8_BAR; PG8_SCHED;
            PG8_LDA(At, 1, 1); PG8_STAGE(PG8_SB(1, 0), b3, voffB); PG8_STAGE(PG8_SB(1, 1), b3 + hstep, voffB); PG8_STAGE(PG8_SA(1, 0), a3, voffA);
            PG8_WAIT_V(8); PG8_WAIT_L(0); PG8_BAR; PG8_MMA(1, 0, At, B0); PG8_MMA(1, 1, At, B1); PG8_BAR; PG8_SCHED;
            } else {
            PG8_LDB(B0, 0, 0); PG8_SCHED; PG8_LDA(At, 0, 0); PG8_STAGE(PG8_SA(1, 1), a1 + hstep, voffA);
            PG8_WAIT_L(8); PG8_BAR; PG8_WAIT_L(0); PG8_MMA(0, 0, At, B0); PG8_BAR; PG8_SCHED;
            PG8_LDB(B1, 0, 1); PG8_STAGE(PG8_SB(0, 0), b2, voffB);
            PG8_BAR; PG8_WAIT_L(0); PG8_MMA(0, 1, At, B1); PG8_BAR;
            PG8_LDA(At, 0, 1); PG8_STAGE(PG8_SA(0, 0), a2, voffA);
            PG8_BAR; PG8_WAIT_L(0); PG8_MMA(1, 0, At, B0); PG8_BAR; PG8_SCHED;
            PG8_STAGE(PG8_SB(0, 1), b2 + hstep, voffB);
            PG8_WAIT_V(6); PG8_BAR; PG8_MMA(1, 1, At, B1); PG8_BAR;
            PG8_LDB(B0, 1, 0); PG8_SCHED; PG8_LDA(At, 1, 0); PG8_STAGE(PG8_SA(0, 1), a2 + hstep, voffA);
            PG8_WAIT_L(8); PG8_BAR; PG8_WAIT_L(0); PG8_MMA(0, 0, At, B0); PG8_BAR; PG8_SCHED;
            PG8_LDB(B1, 1, 1); PG8_STAGE(PG8_SB(1, 0), b3, voffB);
            PG8_BAR; PG8_WAIT_L(0); PG8_MMA(0, 1, At, B1); PG8_BAR;
            PG8_LDA(At, 1, 1); PG8_STAGE(PG8_SA(1, 0), a3, voffA);
            PG8_BAR; PG8_WAIT_L(0); PG8_MMA(1, 0, At, B0); PG8_BAR; PG8_SCHED;
            PG8_STAGE(PG8_SB(1, 1), b3 + hstep, voffB);
            PG8_WAIT_V(6); PG8_BAR; PG8_MMA(1, 1, At, B1); PG8_BAR;
            }
        }
        if constexpr (ALIGN_EPI) { if (wr == 0) PG8_BAR; }
        __builtin_amdgcn_sched_barrier(0); asm volatile("s_nop 7\n\ts_nop 7" ::: "memory"); __builtin_amdgcn_sched_barrier(0);
        if constexpr (!Epi::AFTER_DRAIN) { E(acc, cur, wr, wc, fr, fq); S.done(cur); }
        if (!has_next) break;
#pragma unroll
        for (int a = 0; a < 2; ++a)
#pragma unroll
            for (int b = 0; b < 2; ++b)
#pragma unroll
                for (int m = 0; m < 4; ++m)
#pragma unroll
                    for (int n = 0; n < 2; ++n) acc[a][b][m][n] = (f32x4){0.f, 0.f, 0.f, 0.f};
        cur = nxt; cA = nA; cB = nB; ++ui;
        if constexpr (ALIGN_EPI) { if (wr == 1) PG8_BAR; }
    }
    PG8_WAIT_V(0);
    if constexpr (!ALIGN_EPI) { if (wr == 0) PG8_BAR; }
    PG8_BAR;
    if constexpr (Epi::AFTER_DRAIN) { E.fused(acc, cur, wr, wc, fr, fq, lds, wid, lane); S.done(cur); }
#undef PG8_SA
#undef PG8_SB
#undef PG8_STAGE
#undef PG8_LDA
#undef PG8_LDB
#undef PG8_MMA
#undef PG8_WAIT_V
#undef PG8_WAIT_L
#undef PG8_BAR
#undef PG8_SCHED
}
}

#ifndef PG8_SP2
#define PG8_SP2 true
#endif
#ifndef PG8_ALIGN
#define PG8_ALIGN true
#endif
namespace pg8 {
typedef unsigned u32x2 __attribute__((ext_vector_type(2)));
__device__ __forceinline__ float bfl(unsigned w) { return __uint_as_float(w << 16); }
__device__ __forceinline__ float bfh(unsigned w) { return __uint_as_float(w & 0xffff0000u); }
__device__ __forceinline__ float sigm(float x) { return __builtin_amdgcn_rcpf(1.0f + __expf(-x)); }
struct EpiStore {
    static constexpr bool PERM = true, AFTER_DRAIN = false, MID = false;
    bf16_t* O; int ldc; int nvalid; int split_cols; bf16_t* O2;
    __device__ __forceinline__ void operator()(const f32x4 (&acc)[2][2][4][2], const Unit& u, int wr, int wc, int fr, int fq) const {
        const int row0 = u.pm * BM + wr * 64 + fr; int colt = u.pn * BM; bf16_t* base = O;
        if (split_cols && colt >= split_cols) { base = O2; colt -= split_cols; }
        const int col0 = colt + wc * 32 + 8 * fq;
#pragma unroll
        for (int ai = 0; ai < 2; ++ai)
#pragma unroll
            for (int m = 0; m < 4; ++m) { bf16_t* rowp = base + (size_t)(row0 + ai * HALF + m * 16) * ldc + col0;
#pragma unroll
                for (int bj = 0; bj < 2; ++bj) { const f32x4 v0 = acc[ai][bj][m][0], v1 = acc[ai][bj][m][1];
                    u32x4 w; w.x = cvt_pk_bf16(v0[0], v0[1]); w.y = cvt_pk_bf16(v0[2], v0[3]); w.z = cvt_pk_bf16(v1[0], v1[1]); w.w = cvt_pk_bf16(v1[2], v1[3]);
                    if (col0 + bj * HALF + 8 <= nvalid) *(u32x4*)(rowp + bj * HALF) = w; } }
    }
};
template <int MODE> struct EpiGate {
    static constexpr bool PERM = true, AFTER_DRAIN = false, MID = false;
    const bf16_t* G; bf16_t* O; int ldc;
    __device__ __forceinline__ void operator()(const f32x4 (&acc)[2][2][4][2], const Unit& u, int wr, int wc, int fr, int fq) const {
        const int row0 = u.pm * BM + wr * 64 + fr; const int col0 = u.pn * BM + wc * 32 + 8 * fq;
#pragma unroll
        for (int ai = 0; ai < 2; ++ai)
#pragma unroll
            for (int m = 0; m < 4; ++m) { const size_t off = (size_t)(row0 + ai * HALF + m * 16) * ldc + col0;
#pragma unroll
                for (int bj = 0; bj < 2; ++bj) { const f32x4 v0 = acc[ai][bj][m][0], v1 = acc[ai][bj][m][1];
                    const u32x4 g = *(const u32x4*)(G + off + bj * HALF);
                    float r0 = sigm(bfl(g.x)) * v0[0], r1 = sigm(bfh(g.x)) * v0[1], r2 = sigm(bfl(g.y)) * v0[2], r3 = sigm(bfh(g.y)) * v0[3];
                    float r4 = sigm(bfl(g.z)) * v1[0], r5 = sigm(bfh(g.z)) * v1[1], r6 = sigm(bfl(g.w)) * v1[2], r7 = sigm(bfh(g.w)) * v1[3];
                    if (MODE == 1) { const u32x4 p = *(const u32x4*)(O + off + bj * HALF);
                        r0 += bfl(p.x); r1 += bfh(p.x); r2 += bfl(p.y); r3 += bfh(p.y); r4 += bfl(p.z); r5 += bfh(p.z); r6 += bfl(p.w); r7 += bfh(p.w); }
                    u32x4 w; w.x = cvt_pk_bf16(r0, r1); w.y = cvt_pk_bf16(r2, r3); w.z = cvt_pk_bf16(r4, r5); w.w = cvt_pk_bf16(r6, r7);
                    *(u32x4*)(O + off + bj * HALF) = w; } }
    }
};
struct EpiMerge {
    static constexpr bool PERM = true, AFTER_DRAIN = false, MID = true;
    const bf16_t* GA; const bf16_t* GB; bf16_t* O; int ldc;
    template <bool DIV> __device__ __forceinline__ void scale_pass(f32x4 (&acc)[2][2][4][2], const bf16_t* G, const Unit& u, int wr, int wc, int fr, int fq) const {
        const int row0 = u.pm * BM + wr * 64 + fr; const int col0 = u.pn * BM + wc * 32 + 8 * fq;
#pragma unroll
        for (int ai = 0; ai < 2; ++ai)
#pragma unroll
            for (int m = 0; m < 4; ++m) { const size_t off = (size_t)(row0 + ai * HALF + m * 16) * ldc + col0;
#pragma unroll
                for (int bj = 0; bj < 2; ++bj) { const u32x4 g = *(const u32x4*)(G + off + bj * HALF);
                    f32x4 r0, r1;
                    r0[0] = 1.f + __expf(-bfl(g.x)); r0[1] = 1.f + __expf(-bfh(g.x)); r0[2] = 1.f + __expf(-bfl(g.y)); r0[3] = 1.f + __expf(-bfh(g.y));
                    r1[0] = 1.f + __expf(-bfl(g.z)); r1[1] = 1.f + __expf(-bfh(g.z)); r1[2] = 1.f + __expf(-bfl(g.w)); r1[3] = 1.f + __expf(-bfh(g.w));
                    if (DIV) {
#pragma unroll
                        for (int i = 0; i < 4; ++i) { r0[i] = __builtin_amdgcn_rcpf(r0[i]); r1[i] = __builtin_amdgcn_rcpf(r1[i]); } }
                    acc[ai][bj][m][0] = acc[ai][bj][m][0] * r0; acc[ai][bj][m][1] = acc[ai][bj][m][1] * r1;
                    asm volatile("" ::: "memory"); } }
    }
    __device__ __forceinline__ void mid(f32x4 (&acc)[2][2][4][2], const Unit& u, int wr, int wc, int fr, int fq) const {
        scale_pass<false>(acc, GB, u, wr, wc, fr, fq); scale_pass<true>(acc, GA, u, wr, wc, fr, fq);
    }
    __device__ __forceinline__ void operator()(const f32x4 (&acc)[2][2][4][2], const Unit& u, int wr, int wc, int fr, int fq) const {
        const int row0 = u.pm * BM + wr * 64 + fr; const int col0 = u.pn * BM + wc * 32 + 8 * fq;
#pragma unroll
        for (int ai = 0; ai < 2; ++ai)
#pragma unroll
            for (int m = 0; m < 4; ++m) { const size_t off = (size_t)(row0 + ai * HALF + m * 16) * ldc + col0;
#pragma unroll
                for (int bj = 0; bj < 2; ++bj) { const f32x4 v0 = acc[ai][bj][m][0], v1 = acc[ai][bj][m][1];
                    const u32x4 g = *(const u32x4*)(GB + off + bj * HALF);
                    u32x4 w; w.x = cvt_pk_bf16(sigm(bfl(g.x)) * v0[0], sigm(bfh(g.x)) * v0[1]); w.y = cvt_pk_bf16(sigm(bfl(g.y)) * v0[2], sigm(bfh(g.y)) * v0[3]);
                    w.z = cvt_pk_bf16(sigm(bfl(g.z)) * v1[0], sigm(bfh(g.z)) * v1[1]); w.w = cvt_pk_bf16(sigm(bfl(g.w)) * v1[2], sigm(bfh(g.w)) * v1[3]);
                    *(u32x4*)(O + off + bj * HALF) = w; } }
    }
};
struct EpiRes {
    static constexpr bool PERM = false, AFTER_DRAIN = false, MID = false;
    const float* base; float* out; int ldc;
    __device__ __forceinline__ void operator()(const f32x4 (&acc)[2][2][4][2], const Unit& u, int wr, int wc, int fr, int fq) const {
        const int row0 = u.pm * BM + wr * 64 + fr; const int col0 = u.pn * BM + wc * 32 + 4 * fq;
#pragma unroll
        for (int ai = 0; ai < 2; ++ai)
#pragma unroll
            for (int m = 0; m < 4; ++m) { const size_t off = (size_t)(row0 + ai * HALF + m * 16) * ldc + col0;
#pragma unroll
                for (int bj = 0; bj < 2; ++bj)
#pragma unroll
                    for (int n = 0; n < 2; ++n) { const f32x4 b = *(const f32x4*)(base + off + bj * HALF + n * 16); *(f32x4*)(out + off + bj * HALF + n * 16) = b + acc[ai][bj][m][n]; } }
    }
};

struct EpiResBf16 {
    static constexpr bool PERM = false, AFTER_DRAIN = false, MID = false;
    const float* base; bf16_t* out; int ldc;
    __device__ __forceinline__ void operator()(const f32x4 (&acc)[2][2][4][2], const Unit& u, int wr, int wc, int fr, int fq) const {
        const int row0 = u.pm * BM + wr * 64 + fr; const int col0 = u.pn * BM + wc * 32 + 4 * fq;
#pragma unroll
        for (int ai = 0; ai < 2; ++ai)
#pragma unroll
            for (int m = 0; m < 4; ++m) { const size_t off = (size_t)(row0 + ai * HALF + m * 16) * ldc + col0;
#pragma unroll
                for (int bj = 0; bj < 2; ++bj)
#pragma unroll
                    for (int n = 0; n < 2; ++n) { const f32x4 x = *(const f32x4*)(base + off + bj * HALF + n * 16) + acc[ai][bj][m][n];
                        u32x2 w; w.x = cvt_pk_bf16(x[0], x[1]); w.y = cvt_pk_bf16(x[2], x[3]); *(u32x2*)(out + off + bj * HALF + n * 16) = w; } }
    }
};
struct EpiResNorm {
    static constexpr bool PERM = false, AFTER_DRAIN = false, MID = false;
    const float* base; float* out; bf16_t* H; const float* g; float* SS; int ldc;
    __device__ __forceinline__ void operator()(const f32x4 (&acc)[2][2][4][2], const Unit& u, int wr, int wc, int fr, int fq) const {
        const int row0 = u.pm * BM + wr * 64 + fr; const int col0 = u.pn * BM + wc * 32 + 4 * fq;
#pragma unroll
        for (int ai = 0; ai < 2; ++ai)
#pragma unroll
            for (int m = 0; m < 4; ++m) { const int row = row0 + ai * HALF + m * 16; const size_t off = (size_t)row * ldc + col0; float ss = 0.f;
#pragma unroll
                for (int bj = 0; bj < 2; ++bj)
#pragma unroll
                    for (int n = 0; n < 2; ++n) { const f32x4 x1 = *(const f32x4*)(base + off + bj * HALF + n * 16) + acc[ai][bj][m][n]; *(f32x4*)(out + off + bj * HALF + n * 16) = x1;
                        ss += (x1[0] * x1[0] + x1[1] * x1[1]) + (x1[2] * x1[2] + x1[3] * x1[3]);
                        const f32x4 hh = x1 * *(const f32x4*)(g + col0 + bj * HALF + n * 16);
                        u32x2 w; w.x = cvt_pk_bf16(hh[0], hh[1]); w.y = cvt_pk_bf16(hh[2], hh[3]); *(u32x2*)(H + off + bj * HALF + n * 16) = w; }
                ss += __shfl_xor(ss, 16); ss += __shfl_xor(ss, 32);
                if (fq == 0) (void)__hip_atomic_fetch_add(SS + row, ss, __ATOMIC_RELAXED, __HIP_MEMORY_SCOPE_AGENT); }
    }
};
__device__ __forceinline__ f32x4 dpp_shr1(f32x4 v) { f32x4 r;
#pragma unroll
    for (int i = 0; i < 4; ++i) { const float t = v[i]; r[i] = __int_as_float(__builtin_amdgcn_update_dpp(0, __float_as_int(t), 0x111, 0xF, 0xF, true)); }
    return r; }
__device__ __forceinline__ f32x4 dpp_shl1(f32x4 v) { f32x4 r;
#pragma unroll
    for (int i = 0; i < 4; ++i) { const float t = v[i]; r[i] = __int_as_float(__builtin_amdgcn_update_dpp(0, __float_as_int(t), 0x101, 0xF, 0xF, true)); }
    return r; }
__device__ __forceinline__ f32x4 dpp_mirror(f32x4 v) { f32x4 r;
#pragma unroll
    for (int i = 0; i < 4; ++i) { const float t = v[i]; r[i] = __int_as_float(__builtin_amdgcn_update_dpp(0, __float_as_int(t), 0x140, 0xF, 0xF, true)); }
    return r; }
struct EpiConv {
    static constexpr bool PERM = true, AFTER_DRAIN = false, MID = false;
    bf16_t* ACT; float* SB; const float* cw; const float* cb; PG8_LAS float* xe; bf16_t* Udbg; const float* SS;
    __device__ __forceinline__ void operator()(const f32x4 (&acc)[2][2][4][2], const Unit& u, int wr, int wc, int fr, int fq) const {
        constexpr int FF = 2752, FFP = 2816, NSRC = 5504, NU = 5632;
        if (SS) {
            f32x4 (&sa)[2][2][4][2] = const_cast<f32x4 (&)[2][2][4][2]>(acc);
#pragma unroll
            for (int ai = 0; ai < 2; ++ai)
#pragma unroll
                for (int m = 0; m < 4; ++m) { const float q = __hip_atomic_load(SS + u.pm * BM + ai * HALF + wr * 64 + m * 16 + fr, __ATOMIC_RELAXED, __HIP_MEMORY_SCOPE_AGENT);
                    const float rs = 1.0f / sqrtf(q * (1.0f / 1024.0f) + 1e-6f);
#pragma unroll
                    for (int bj = 0; bj < 2; ++bj)
#pragma unroll
                        for (int n = 0; n < 2; ++n) sa[ai][bj][m][n] = sa[ai][bj][m][n] * rs; } }
#pragma unroll
        for (int ai = 0; ai < 2; ++ai) { const int slab = 2 * ai + wr;
#pragma unroll
            for (int bj = 0; bj < 2; ++bj)
#pragma unroll
                for (int n = 0; n < 2; ++n) {
                    if (fr == 0) *(PG8_LAS f32x4*)(xe + ((slab * 2 + 0) * 4 + wc) * 64 + bj * 32 + fq * 8 + n * 4) = acc[ai][bj][0][n];
                    if (fr == 15) *(PG8_LAS f32x4*)(xe + ((slab * 2 + 1) * 4 + wc) * 64 + bj * 32 + fq * 8 + n * 4) = acc[ai][bj][3][n]; } }
        if (Udbg && u.pm < 128) { const int row0 = u.pm * BM + wr * 64 + fr, col0 = u.pn * BM + wc * 32 + 8 * fq;
#pragma unroll
            for (int ai = 0; ai < 2; ++ai)
#pragma unroll
                for (int m = 0; m < 4; ++m)
#pragma unroll
                    for (int bj = 0; bj < 2; ++bj) { const f32x4 v0 = acc[ai][bj][m][0], v1 = acc[ai][bj][m][1]; u32x4 w; w.x = cvt_pk_bf16(v0[0], v0[1]); w.y = cvt_pk_bf16(v0[2], v0[3]); w.z = cvt_pk_bf16(v1[0], v1[1]); w.w = cvt_pk_bf16(v1[2], v1[3]);
                        *(u32x4*)(Udbg + (size_t)(row0 + ai * HALF + m * 16) * NU + col0 + bj * HALF) = w; } }
        { const int colb = u.pn * BM + wc * 32 + 8 * fq;
          if (wr == 0 && fr < 2) {
#pragma unroll
              for (int bj = 0; bj < 2; ++bj)
#pragma unroll
                  for (int n = 0; n < 2; ++n) *(f32x4*)(SB + (size_t)(u.pm * 4 + fr) * NU + colb + bj * HALF + 4 * n) = acc[0][bj][0][n]; }
          if (wr == 1 && fr >= 14) {
#pragma unroll
              for (int bj = 0; bj < 2; ++bj)
#pragma unroll
                  for (int n = 0; n < 2; ++n) *(f32x4*)(SB + (size_t)(u.pm * 4 + 2 + (fr - 14)) * NU + colb + bj * HALF + 4 * n) = acc[1][bj][3][n]; } }
        asm volatile("s_waitcnt lgkmcnt(0)" ::: "memory"); __builtin_amdgcn_s_barrier(); asm volatile("" ::: "memory");
        const int j0 = u.pn * 128 + wc * 32 + fq * 8;
        const f32x4 z4 = (f32x4){0.f, 0.f, 0.f, 0.f};
#pragma unroll
        for (int n = 0; n < 2; ++n) { const int jn = j0 + 4 * n; const bool valid = jn < FF;
            f32x4 wg0 = z4, wg1 = z4, wg2 = z4, wv0 = z4, wv1 = z4, wv2 = z4, bg = z4, bv = z4;
            if (valid) { wg0 = *(const f32x4*)(cw + jn); wg1 = *(const f32x4*)(cw + NSRC + jn); wg2 = *(const f32x4*)(cw + 2 * NSRC + jn);
                         wv0 = *(const f32x4*)(cw + FF + jn); wv1 = *(const f32x4*)(cw + NSRC + FF + jn); wv2 = *(const f32x4*)(cw + 2 * NSRC + FF + jn);
                         bg = *(const f32x4*)(cb + jn); bv = *(const f32x4*)(cb + FF + jn); }
#pragma unroll
            for (int ai = 0; ai < 2; ++ai) { const int slab = 2 * ai + wr;
                f32x4 topg = z4, topv = z4, botg = z4, botv = z4;
                if (slab > 0) { topg = *(const PG8_LAS f32x4*)(xe + (((slab - 1) * 2 + 1) * 4 + wc) * 64 + fq * 8 + n * 4); topv = *(const PG8_LAS f32x4*)(xe + (((slab - 1) * 2 + 1) * 4 + wc) * 64 + 32 + fq * 8 + n * 4); }
                if (slab < 3) { botg = *(const PG8_LAS f32x4*)(xe + (((slab + 1) * 2 + 0) * 4 + wc) * 64 + fq * 8 + n * 4); botv = *(const PG8_LAS f32x4*)(xe + (((slab + 1) * 2 + 0) * 4 + wc) * 64 + 32 + fq * 8 + n * 4); }
#pragma unroll
                for (int m = 0; m < 4; ++m) { const f32x4 eg = acc[ai][0][m][n], ev = acc[ai][1][m][n];
                    f32x4 upg = dpp_shr1(eg), upv = dpp_shr1(ev), dng = dpp_shl1(eg), dnv = dpp_shl1(ev);
                    const f32x4 ag = (m > 0) ? dpp_mirror(acc[ai][0][m > 0 ? m - 1 : 0][n]) : topg, av = (m > 0) ? dpp_mirror(acc[ai][1][m > 0 ? m - 1 : 0][n]) : topv;
                    const f32x4 cg2 = (m < 3) ? dpp_mirror(acc[ai][0][m < 3 ? m + 1 : 3][n]) : botg, cv2 = (m < 3) ? dpp_mirror(acc[ai][1][m < 3 ? m + 1 : 3][n]) : botv;
                    if (fr == 0) { upg = ag; upv = av; }
                    if (fr == 15) { dng = cg2; dnv = cv2; }
                    const f32x4 g = wg0 * upg + wg1 * eg + wg2 * dng + bg, v = wv0 * upv + wv1 * ev + wv2 * dnv + bv;
                    f32x4 o;
#pragma unroll
                    for (int i = 0; i < 4; ++i) o[i] = valid ? g[i] * sigm(g[i]) * v[i] : 0.f;
                    const int rt = ai * HALF + wr * 64 + m * 16 + fr;
                    if (rt != 0 && rt != 255) { u32x2 w; w.x = cvt_pk_bf16(o[0], o[1]); w.y = cvt_pk_bf16(o[2], o[3]); *(u32x2*)(ACT + (size_t)(u.pm * BM + rt) * FFP + jn) = w; } } }
        }
    }
};
}

constexpr int NB = 32, T = 2048, D = 1024, M = NB * T, MH = M / 2;
constexpr int NMIX = 3360, NMIXP = 3584, NGATE = 2048;
constexpr int DFF = 2752, DFFP = 2816, NUP = 5632, NUPSRC = 5504, NPROJ = 5408;
constexpr int C_GQ = 0, C_GK = 256, C_GV = 512, C_GOG = 1024, C_GAF = 1536, C_GAB = 1552, C_R0 = 1568;
constexpr size_t MiB = 1u << 20;
constexpr size_t WS_WMIX = 1 * MiB, WS_WGATE = 8 * MiB, WS_WGP = 12 * MiB, WS_WRP = 13 * MiB, WS_WOUT = 14 * MiB, WS_WUP = 16 * MiB, WS_WDN = 27 * MiB;
constexpr size_t WS_LW2F = 33 * MiB, WS_LW2B = WS_LW2F + 65536, WS_LA2 = WS_LW2B + 65536, WS_LG2 = WS_LA2 + 65536;
constexpr size_t WS_HB = 36 * MiB, WS_PM = 164 * MiB, WS_GO = 584 * MiB, WS_O = 712 * MiB, WS_E = 840 * MiB, WS_BON = 968 * MiB, WS_END = 970 * MiB;
constexpr size_t WS_H2 = 256 * MiB;
constexpr size_t WS_U = WS_PM, WS_SB = WS_PM, WS_ACT = 516 * MiB, WS_X2 = 36 * MiB;
static_assert(WS_WDN + (size_t)D * DFFP * 2 <= WS_LW2F && WS_LG2 + 131072 <= WS_HB, "weights map");
static_assert(WS_PM + (size_t)M * NMIX * 2 <= WS_GO && WS_U + (size_t)MH * NUP * 2 <= WS_ACT && WS_ACT + (size_t)M * DFFP * 2 <= 1024 * MiB, "ws map");
constexpr int LDS_BYTES = 147456;

#define LAS __attribute__((address_space(3)))
#define DI __device__ __forceinline__
typedef unsigned short bf16;
typedef float f32x4 __attribute__((ext_vector_type(4)));
typedef float f32x2 __attribute__((ext_vector_type(2)));
typedef short bf16x8 __attribute__((ext_vector_type(8)));
typedef unsigned u32x4 __attribute__((ext_vector_type(4)));
typedef unsigned u32x2 __attribute__((ext_vector_type(2)));
typedef _Float16 h16x2 __attribute__((ext_vector_type(2)));
#define LDS_WAIT() asm volatile("s_waitcnt lgkmcnt(0)" ::: "memory")
#define LDS_BARRIER() do { asm volatile("s_waitcnt lgkmcnt(0)" ::: "memory"); __builtin_amdgcn_s_barrier(); asm volatile("" ::: "memory"); } while (0)
#define MFMA16(a, b, c) __builtin_amdgcn_mfma_f32_16x16x32_bf16((a), (b), (c), 0, 0, 0)
#define MFMA_GUARD(v) asm volatile("s_nop 7\n\ts_nop 7" : "+v"(v))

struct Params {
    const float* in[31]; float* out; unsigned char* ws;
};
enum { I_X = 0, I_N1G, I_WIN, I_GWA2F, I_GBAF, I_GWA2B, I_GBAB, I_GNG, I_GPROJ, I_MUP, I_MUN, I_W0F, I_W2F, I_W0B, I_W2B, I_A0, I_A2, I_G2, I_KK, I_KA, I_RK, I_LNW, I_LNB, I_RPROJ,
       I_WOUT, I_N2G, I_FUP, I_FCW, I_FCB, I_FDN, I_NFG };

DI float bfl(unsigned w) { return __uint_as_float(w << 16); }
DI float bfh(unsigned w) { return __uint_as_float(w & 0xffff0000u); }
DI unsigned f2bf(float f) { unsigned u = __float_as_uint(f); return (u + 0x7fffu + ((u >> 16) & 1u)) >> 16; }
typedef __bf16 bf16x2_t __attribute__((ext_vector_type(2)));
DI unsigned pk2(float lo, float hi) { const f32x2 v = {lo, hi}; const bf16x2_t b = __builtin_convertvector(v, bf16x2_t); return __builtin_bit_cast(unsigned, b); }
DI float sigm(float x) { return __builtin_amdgcn_rcpf(1.0f + __expf(-x)); }
DI unsigned pkh2(float lo, float hi) { h16x2 v; v.x = (_Float16)lo; v.y = (_Float16)hi; return __builtin_bit_cast(unsigned, v); }
DI float hlo(unsigned w) { h16x2 v = __builtin_bit_cast(h16x2, w); return (float)v.x; }
DI float hhi(unsigned w) { h16x2 v = __builtin_bit_cast(h16x2, w); return (float)v.y; }
DI float wave_sum(float v) {
#pragma unroll
    for (int o = 1; o < 64; o <<= 1) v += __shfl_xor(v, o);
    return v;
}
DI float quad_sum(float x) {
    x += __builtin_bit_cast(float, __builtin_amdgcn_update_dpp(0, __builtin_bit_cast(int, x), 0xB1, 0xF, 0xF, true));
    x += __builtin_bit_cast(float, __builtin_amdgcn_update_dpp(0, __builtin_bit_cast(int, x), 0x4E, 0xF, 0xF, true));
    return x;
}
DI float oct_sum(float x) {
    x = quad_sum(x);
    x += __builtin_bit_cast(float, __builtin_amdgcn_update_dpp(0, __builtin_bit_cast(int, x), 0x141, 0xF, 0xF, true));
    return x;
}
struct F8 { f32x4 a, b; };
DI F8 unpack8(u32x4 w) { F8 r; r.a = (f32x4){bfl(w.x), bfh(w.x), bfl(w.y), bfh(w.y)}; r.b = (f32x4){bfl(w.z), bfh(w.z), bfl(w.w), bfh(w.w)}; return r; }
DI u32x4 pack8(f32x4 a, f32x4 b) { u32x4 w; w.x = pk2(a[0], a[1]); w.y = pk2(a[2], a[3]); w.z = pk2(b[0], b[1]); w.w = pk2(b[2], b[3]); return w; }
DI f32x4 unpack4(u32x2 w) { return (f32x4){bfl(w.x), bfh(w.x), bfl(w.y), bfh(w.y)}; }
DI u32x2 pack4(f32x4 a) { u32x2 w; w.x = pk2(a[0], a[1]); w.y = pk2(a[2], a[3]); return w; }

DI void tr_item(const float* W, int ldw, int k0, int c0, bf16* WT, int ldt, int n0, LAS float* scr, int lane) {
    const int c = lane & 7;
    if (c0 < 0) {
#pragma unroll
        for (int j = 0; j < 4; ++j) { const int n = (lane >> 3) + 8 * j; *(u32x4*)(WT + (size_t)(n0 + n) * ldt + k0 + 8 * c) = (u32x4){0u, 0u, 0u, 0u}; }
        return;
    }
#pragma unroll 8
    for (int i = 0; i < 32; ++i) { const int kk = 2 * i + (lane >> 5); scr[kk * 33 + (lane & 31)] = W[(size_t)(k0 + kk) * ldw + c0 + (lane & 31)]; }
    LDS_WAIT();
#pragma unroll
    for (int j = 0; j < 4; ++j) { const int n = (lane >> 3) + 8 * j; const LAS float* s = scr + (8 * c) * 33 + n;
        u32x4 o; o.x = pk2(s[0 * 33], s[1 * 33]); o.y = pk2(s[2 * 33], s[3 * 33]); o.z = pk2(s[4 * 33], s[5 * 33]); o.w = pk2(s[6 * 33], s[7 * 33]);
        *(u32x4*)(WT + (size_t)(n0 + n) * ldt + k0 + 8 * c) = o; }
    LDS_WAIT();
}
DI void rms_row_bf16(const float* xrow, const float* g, bf16* orow, int lane) {
    const f32x4* xr = (const f32x4*)xrow + lane;
    f32x4 v[4]; float s = 0.f;
#pragma unroll
    for (int j = 0; j < 4; ++j) { v[j] = xr[64 * j]; s += (v[j].x * v[j].x + v[j].y * v[j].y) + (v[j].z * v[j].z + v[j].w * v[j].w); }
    const float rstd = 1.0f / sqrtf(wave_sum(s) * (1.f / D) + 1e-6f);
    u32x2* o8 = (u32x2*)orow + lane;
#pragma unroll
    for (int j = 0; j < 4; ++j) { const f32x4 gg = ((const f32x4*)g)[lane + 64 * j]; o8[64 * j] = pack4(v[j] * rstd * gg); }
}
DI void rms_rows2_f32(const unsigned char* src, float* dst, int m0, int m1, const float* g, int lane) {
    const f32x4* xa = (const f32x4*)(src + (size_t)m0 * D * 4) + lane; const f32x4* xb = (const f32x4*)(src + (size_t)m1 * D * 4) + lane;
    f32x4 va[4], vb[4]; float sa = 0.f, sb = 0.f;
#pragma unroll
    for (int j = 0; j < 4; ++j) { va[j] = xa[64 * j]; vb[j] = xb[64 * j]; }
#pragma unroll
    for (int j = 0; j < 4; ++j) { sa += (va[j].x * va[j].x + va[j].y * va[j].y) + (va[j].z * va[j].z + va[j].w * va[j].w); sb += (vb[j].x * vb[j].x + vb[j].y * vb[j].y) + (vb[j].z * vb[j].z + vb[j].w * vb[j].w); }
#pragma unroll
    for (int o = 1; o < 64; o <<= 1) { sa += __shfl_xor(sa, o); sb += __shfl_xor(sb, o); }
    const float ra = 1.0f / sqrtf(sa * (1.f / D) + 1e-6f), rb = 1.0f / sqrtf(sb * (1.f / D) + 1e-6f);
    f32x4* oa = (f32x4*)(dst + (size_t)m0 * D) + lane; f32x4* ob = (f32x4*)(dst + (size_t)m1 * D) + lane;
#pragma unroll
    for (int j = 0; j < 4; ++j) { const f32x4 gg = ((const f32x4*)g)[lane + 64 * j]; oa[64 * j] = va[j] * ra * gg; ob[64 * j] = vb[j] * rb * gg; }
}
DI void rms_rows2_bf16(const float* src, const float* g, bf16* dst, int m0, int m1, int lane) {
    const f32x4* xa = (const f32x4*)(src + (size_t)m0 * D) + lane; const f32x4* xb = (const f32x4*)(src + (size_t)m1 * D) + lane;
    f32x4 va[4], vb[4]; float sa = 0.f, sb = 0.f;
#pragma unroll
    for (int j = 0; j < 4; ++j) { va[j] = xa[64 * j]; vb[j] = xb[64 * j]; }
#pragma unroll
    for (int j = 0; j < 4; ++j) { sa += (va[j].x * va[j].x + va[j].y * va[j].y) + (va[j].z * va[j].z + va[j].w * va[j].w); sb += (vb[j].x * vb[j].x + vb[j].y * vb[j].y) + (vb[j].z * vb[j].z + vb[j].w * vb[j].w); }
#pragma unroll
    for (int o = 1; o < 64; o <<= 1) { sa += __shfl_xor(sa, o); sb += __shfl_xor(sb, o); }
    const float ra = 1.0f / sqrtf(sa * (1.f / D) + 1e-6f), rb = 1.0f / sqrtf(sb * (1.f / D) + 1e-6f);
    u32x2* oa = (u32x2*)(dst + (size_t)m0 * D) + lane; u32x2* ob = (u32x2*)(dst + (size_t)m1 * D) + lane;
#pragma unroll
    for (int j = 0; j < 4; ++j) { const f32x4 gg = ((const f32x4*)g)[lane + 64 * j]; oa[64 * j] = pack4(va[j] * ra * gg); ob[64 * j] = pack4(vb[j] * rb * gg); }
}

DI void p0_prologue(const Params& P, LAS unsigned char* lds) {
    const int tid = threadIdx.x, lane = tid & 63, wv = tid >> 6;
    LAS float* scr = (LAS float*)(lds + wv * 16384);
    const int gw = blockIdx.x * 8 + wv, NGW = gridDim.x * 8;
    unsigned char* ws = P.ws;
    constexpr int I0 = 16 * (NMIXP / 32), I1 = 16 * (NGATE / 32), I2 = 8 * 32, I3 = 8 * 32, I4 = 16 * 32, I5 = 16 * (NUP / 32), I6 = 44 * 32, I7 = 16, I8 = 16, I9 = 16, I10 = 32;
    constexpr int NIT = I0 + I1 + I2 + I3 + I4 + I5 + I6 + I7 + I8 + I9 + I10;
    for (int it = gw; it < NIT; it += NGW) {
        int r = it;
        if (r < I0) { const int nb = r % (NMIXP / 32), kb = r / (NMIXP / 32); tr_item(P.in[I_WIN], NPROJ, 64 * kb, 32 * nb < NMIX ? 32 * nb : -1, (bf16*)(ws + WS_WMIX), D, 32 * nb, scr, lane); continue; } r -= I0;
        if (r < I1) { const int nb = r % (NGATE / 32), kb = r / (NGATE / 32); tr_item(P.in[I_WIN], NPROJ, 64 * kb, NMIX + 32 * nb, (bf16*)(ws + WS_WGATE), D, 32 * nb, scr, lane); continue; } r -= I1;
        if (r < I2) { const int nb = r % 32, kb = r / 32; tr_item(P.in[I_GPROJ], D, 64 * kb, 32 * nb, (bf16*)(ws + WS_WGP), 512, 32 * nb, scr, lane); continue; } r -= I2;
        if (r < I3) { const int nb = r % 32, kb = r / 32; tr_item(P.in[I_RPROJ], D, 64 * kb, 32 * nb, (bf16*)(ws + WS_WRP), 512, 32 * nb, scr, lane); continue; } r -= I3;
        if (r < I4) { const int nb = r % 32, kb = r / 32; tr_item(P.in[I_WOUT], D, 64 * kb, 32 * nb, (bf16*)(ws + WS_WOUT), D, 32 * nb, scr, lane); continue; } r -= I4;
        if (r < I5) { const int nb = r % (NUP / 32), kb = r / (NUP / 32); const int n = 32 * nb, j = n >> 8, i = n & 255, ff = 128 * j + (i & 127);
            tr_item(P.in[I_FUP], NUPSRC, 64 * kb, ff < DFF ? (i < 128 ? ff : DFF + ff) : -1, (bf16*)(ws + WS_WUP), D, n, scr, lane); continue; } r -= I5;
        if (r < I6) { const int nb = r % 32, kb = r / 32; tr_item(P.in[I_FDN], D, 64 * kb, kb < 43 ? 32 * nb : -1, (bf16*)(ws + WS_WDN), DFFP, 32 * nb, scr, lane); continue; } r -= I6;
        if (r < I7) { tr_item(P.in[I_W2F], 512, 0, 32 * r, (bf16*)(ws + WS_LW2F), 64, 32 * r, scr, lane); continue; } r -= I7;
        if (r < I8) { tr_item(P.in[I_W2B], 512, 0, 32 * r, (bf16*)(ws + WS_LW2B), 64, 32 * r, scr, lane); continue; } r -= I8;
        if (r < I9) { tr_item(P.in[I_A2], 512, 0, 32 * r, (bf16*)(ws + WS_LA2), 64, 32 * r, scr, lane); continue; } r -= I9;
        { const int nb = r % 16, kb = r / 16; tr_item(P.in[I_G2], 512, 64 * kb, 32 * nb, (bf16*)(ws + WS_LG2), 128, 32 * nb, scr, lane); }
    }
    bf16* HB = (bf16*)(ws + WS_HB);
    for (int m = gw; m < M; m += 2 * NGW) rms_rows2_bf16(P.in[I_X], P.in[I_N1G], HB, m, m + NGW, lane);
}
#define XB_TMO      128
#define XB_XCNT(j)  (256  + 64 * (j))
#define XB_XSUB(j)  (1280 + 64 * (j))
#define XB_XGEN(j)  (2304 + 64 * (j))
#define XB_TOP      3328
#define XB_TOPGEN   3392
#define XCD_BAR_WORDS 3456
#define XB_SPIN_CAP (1u << 18)

__device__ __forceinline__ unsigned xb_ld(unsigned* p)              { return __hip_atomic_load(p, __ATOMIC_RELAXED, __HIP_MEMORY_SCOPE_AGENT); }
__device__ __forceinline__ unsigned xb_add(unsigned* p, unsigned v) { return __hip_atomic_fetch_add(p, v, __ATOMIC_RELAXED, __HIP_MEMORY_SCOPE_AGENT); }
__device__ __forceinline__ unsigned xb_xcc_id() { return (unsigned)__builtin_amdgcn_s_getreg((3 << 11) | 20) & 0xFu; }
#define XB_SPIN(cond, bar) do { unsigned _sp = 0; while (cond) { __builtin_amdgcn_s_sleep(1); \
    if ((++_sp & 255u) == 0u) { if (xb_ld(&(bar)[XB_TMO])) break; if (_sp > XB_SPIN_CAP) { atomicAdd(&(bar)[XB_TMO], 1u); break; } } } } while (0)

struct XcdBarrier {
    unsigned* bar; unsigned x;
    volatile LAS unsigned* st;
};

__device__ __forceinline__ XcdBarrier xcd_barrier_post(unsigned* bar, volatile LAS unsigned* st) {
    XcdBarrier b; b.bar = bar; b.x = xb_xcc_id(); b.st = st;
    if (threadIdx.x == 0) (void)xb_add(&bar[XB_XCNT(b.x)], 1u);
    return b;
}
__device__ __forceinline__ void xcd_barrier_complete(unsigned* bar, unsigned x, unsigned& nloc, unsigned& nx) {
    const unsigned G = gridDim.x * gridDim.y * gridDim.z;
    unsigned sum, cnt, mine, sp = 0u;
    for (;;) {
        sum = 0u; cnt = 0u; mine = 0u;
#pragma unroll
        for (unsigned j = 0; j < 16; ++j) { const unsigned c = xb_ld(&bar[XB_XCNT(j)]); sum += c; cnt += (c > 0u) ? 1u : 0u; mine = (j == x) ? c : mine; }
        if (sum == G) break;
        __builtin_amdgcn_s_sleep(1);
        if ((++sp & 255u) == 0u) { if (xb_ld(&bar[XB_TMO])) break; if (sp > XB_SPIN_CAP) { atomicAdd(&bar[XB_TMO], 1u); break; } }
    }
    nloc = mine > 0u ? mine : 1u; nx = cnt > 0u ? cnt : 1u;
}

__device__ __forceinline__ void xcd_barrier(const XcdBarrier& b) {
    asm volatile("s_waitcnt vmcnt(0)" ::: "memory");
    __syncthreads();
    if (threadIdx.x == 0) {
        unsigned* bar = b.bar;
        __builtin_amdgcn_s_waitcnt(0);
        unsigned nloc = b.st[0], nx = b.st[1];
        if (nloc == 0u) { xcd_barrier_complete(bar, b.x, nloc, nx); b.st[0] = nloc; b.st[1] = nx; }
        const unsigned old = xb_add(&bar[XB_XSUB(b.x)], 1u);
        const unsigned gen = old / nloc;
        if (old + 1u == (gen + 1u) * nloc) {
            __builtin_amdgcn_fence(__ATOMIC_RELEASE, "agent");
            asm volatile("s_waitcnt vmcnt(0)" ::: "memory");
            const unsigned og = xb_add(&bar[XB_TOP], 1u);
            const unsigned tg = og / nx;
            if (og + 1u == (tg + 1u) * nx) xb_add(&bar[XB_TOPGEN], 1u);
            else XB_SPIN(xb_ld(&bar[XB_TOPGEN]) == tg, bar);
            __builtin_amdgcn_fence(__ATOMIC_ACQUIRE, "agent");
            xb_add(&bar[XB_XGEN(b.x)], 1u);
            asm volatile("s_waitcnt vmcnt(0)" ::: "memory");
        } else {
            XB_SPIN(xb_ld(&bar[XB_XGEN(b.x)]) == gen, bar);
            __builtin_amdgcn_fence(__ATOMIC_ACQUIRE, "agent");
            asm volatile("s_waitcnt vmcnt(0)" ::: "memory");
        }
    }
    __syncthreads();
}


DI void gla_unit(const Params& P, LAS unsigned char* lds, int unit) {
    const int tid = threadIdx.x, lane = tid & 63, wv = __builtin_amdgcn_readfirstlane(tid >> 6), fr = lane & 15, q4 = lane >> 4;
    const int dir = unit & 1, h = (unit >> 1) & 3, b = unit >> 3;
    LAS bf16* QI = (LAS bf16*)lds; LAS bf16* KI = QI + 64 * 72; LAS bf16* QE = KI + 64 * 72; LAS bf16* KDT = QE + 64 * 72; LAS bf16* AS = KDT + 64 * 72;
    LAS bf16* VT = AS + 64 * 72; LAS bf16* ST = VT + 128 * 72;
    LAS float* BL = (LAS float*)(ST + 128 * 72); LAS float* AF = BL + 64 * 64; LAS float* GT = AF + 64 * 16;
    const bf16* PM = (const bf16*)(P.ws + WS_PM);
    bf16* GO = (bf16*)(P.ws + WS_GO) + (size_t)dir * M * 512;
    const float* wa2 = dir ? P.in[I_GWA2B] : P.in[I_GWA2F];
    const float* ba = dir ? P.in[I_GBAB] : P.in[I_GBAF];
    const int kq = tid & 63, cgp = tid >> 6;
    float wcol[16];
#pragma unroll
    for (int r = 0; r < 16; ++r) wcol[r] = wa2[r * 256 + 64 * h + kq];
    const float bak = ba[64 * h + kq];
    f32x4 Sacc[4];
#pragma unroll
    for (int i = 0; i < 4; ++i) Sacc[i] = (f32x4){0.f, 0.f, 0.f, 0.f};
    for (int i = tid; i < 128 * 72 / 2; i += 512) ((LAS unsigned*)ST)[i] = 0u;
    const size_t rowbase = (size_t)b * T;
    const int afcol = dir ? C_GAB : C_GAF;
    u32x4 paf = (u32x4){0u, 0u, 0u, 0u}, pq, pk, pva, pvb;
#define GLA_PREFETCH(nn) do { const int chunk_ = dir ? 31 - (nn) : (nn); const size_t tk0_ = rowbase + chunk_ * 64; \
        if (tid < 128) paf = *(const u32x4*)(PM + (tk0_ + (dir ? 63 - (tid >> 1) : (tid >> 1))) * NMIX + afcol + 8 * (tid & 1)); \
        const bf16* rp_ = PM + (tk0_ + (dir ? 63 - (tid >> 3) : (tid >> 3))) * NMIX; \
        pq = *(const u32x4*)(rp_ + C_GQ + 64 * h + 8 * (tid & 7)); pk = *(const u32x4*)(rp_ + C_GK + 64 * h + 8 * (tid & 7)); \
        pva = *(const u32x4*)(rp_ + C_GV + 128 * h + 16 * (tid & 7)); pvb = *(const u32x4*)(rp_ + C_GV + 128 * h + 16 * (tid & 7) + 8); } while (0)
    GLA_PREFETCH(0);
    for (int n = 0; n < 32; ++n) {
        const int chunk = dir ? 31 - n : n;
        const size_t tok0 = rowbase + chunk * 64;
#define GTOK(c) (tok0 + (dir ? 63 - (c) : (c)))
        if (tid < 128) { const int c = tid >> 1, hf = tid & 1; const F8 f = unpack8(paf);
            *(LAS f32x4*)(AF + c * 16 + 8 * hf) = f.a; *(LAS f32x4*)(AF + c * 16 + 8 * hf + 4) = f.b; }
        LDS_BARRIER();
        float pre[8]; float run = 0.f;
#pragma unroll
        for (int j = 0; j < 8; ++j) { const int c = 8 * cgp + j; float z = bak;
#pragma unroll
            for (int r4 = 0; r4 < 4; ++r4) { const f32x4 a = *(LAS f32x4*)(AF + c * 16 + 4 * r4); z += a[0] * wcol[4 * r4] + a[1] * wcol[4 * r4 + 1] + a[2] * wcol[4 * r4 + 2] + a[3] * wcol[4 * r4 + 3]; }
            const float la = -(fmaxf(-z, 0.f) + __logf(1.f + __expf(-fabsf(z)))) * (1.f / 16.f); run += la; pre[j] = run; }
        GT[cgp * 64 + kq] = run;
        LDS_BARRIER();
        float off = 0.f;
#pragma unroll
        for (int g = 0; g < 8; ++g) off += (g < cgp) ? GT[g * 64 + kq] : 0.f;
#pragma unroll
        for (int j = 0; j < 8; ++j) BL[(8 * cgp + j) * 64 + kq] = off + pre[j];
        LDS_BARRIER();
        {   const int c = tid >> 3, k0 = 8 * (tid & 7);
            const F8 q = unpack8(pq), k = unpack8(pk);
            const u32x4 va = pva, vb = pvb;
            f32x4 qi[2], ki[2], qe[2], kd[2];
#pragma unroll
            for (int hh = 0; hh < 2; ++hh) { const f32x4 bl = *(LAS f32x4*)(BL + c * 64 + k0 + 4 * hh), br = *(LAS f32x4*)(BL + 32 * 64 + k0 + 4 * hh), bt = *(LAS f32x4*)(BL + 63 * 64 + k0 + 4 * hh);
                const f32x4 qq = (hh ? q.b : q.a) * 0.125f, kk = hh ? k.b : k.a;
#pragma unroll
                for (int j = 0; j < 4; ++j) { qi[hh][j] = qq[j] * __expf(bl[j] - br[j]); ki[hh][j] = kk[j] * __expf(br[j] - bl[j]); qe[hh][j] = qq[j] * __expf(bl[j]); kd[hh][j] = kk[j] * __expf(bt[j] - bl[j]); } }
            *(LAS u32x4*)(QI + c * 72 + k0) = pack8(qi[0], qi[1]); *(LAS u32x4*)(KI + c * 72 + k0) = pack8(ki[0], ki[1]); *(LAS u32x4*)(QE + c * 72 + k0) = pack8(qe[0], qe[1]);
#pragma unroll
            for (int j = 0; j < 4; ++j) { KDT[(k0 + j) * 72 + c] = (bf16)f2bf(kd[0][j]); KDT[(k0 + 4 + j) * 72 + c] = (bf16)f2bf(kd[1][j]); }
            const int v0 = 16 * (tid & 7);
            VT[(v0 + 0) * 72 + c] = (bf16)(va.x & 0xffffu); VT[(v0 + 1) * 72 + c] = (bf16)(va.x >> 16); VT[(v0 + 2) * 72 + c] = (bf16)(va.y & 0xffffu); VT[(v0 + 3) * 72 + c] = (bf16)(va.y >> 16);
            VT[(v0 + 4) * 72 + c] = (bf16)(va.z & 0xffffu); VT[(v0 + 5) * 72 + c] = (bf16)(va.z >> 16); VT[(v0 + 6) * 72 + c] = (bf16)(va.w & 0xffffu); VT[(v0 + 7) * 72 + c] = (bf16)(va.w >> 16);
            VT[(v0 + 8) * 72 + c] = (bf16)(vb.x & 0xffffu); VT[(v0 + 9) * 72 + c] = (bf16)(vb.x >> 16); VT[(v0 + 10) * 72 + c] = (bf16)(vb.y & 0xffffu); VT[(v0 + 11) * 72 + c] = (bf16)(vb.y >> 16);
            VT[(v0 + 12) * 72 + c] = (bf16)(vb.z & 0xffffu); VT[(v0 + 13) * 72 + c] = (bf16)(vb.z >> 16); VT[(v0 + 14) * 72 + c] = (bf16)(vb.w & 0xffffu); VT[(v0 + 15) * 72 + c] = (bf16)(vb.w >> 16);
        }
        if (n + 1 < 32) GLA_PREFETCH(n + 1);
        LDS_BARRIER();
        {   const int ct = wv >> 1;
#pragma unroll
            for (int tt = 0; tt < 2; ++tt) { const int st = 2 * (wv & 1) + tt;
                f32x4 acc = (f32x4){0.f, 0.f, 0.f, 0.f};
#pragma unroll
                for (int ks = 0; ks < 2; ++ks) { const bf16x8 a = *(LAS bf16x8*)(KI + (16 * st + fr) * 72 + 32 * ks + 8 * q4), bb = *(LAS bf16x8*)(QI + (16 * ct + fr) * 72 + 32 * ks + 8 * q4); acc = MFMA16(a, bb, acc); }
                MFMA_GUARD(acc);
                const int cg0 = 16 * ct + fr, sg0 = 16 * st + 4 * q4;
#pragma unroll
                for (int j = 0; j < 4; ++j) acc[j] = (cg0 >= sg0 + j) ? acc[j] : 0.f;
                *(LAS u32x2*)(AS + (16 * ct + fr) * 72 + 16 * st + 4 * q4) = pack4(acc); }
        }
        LDS_BARRIER();
        {   bf16x8 av[2], as_[2];
#pragma unroll
            for (int ks = 0; ks < 2; ++ks) { av[ks] = *(LAS bf16x8*)(VT + (16 * wv + fr) * 72 + 32 * ks + 8 * q4); as_[ks] = *(LAS bf16x8*)(ST + (16 * wv + fr) * 72 + 32 * ks + 8 * q4); }
#pragma unroll
            for (int ct = 0; ct < 4; ++ct) { f32x4 o = (f32x4){0.f, 0.f, 0.f, 0.f};
#pragma unroll
                for (int ks = 0; ks < 2; ++ks) { const bf16x8 bb = *(LAS bf16x8*)(AS + (16 * ct + fr) * 72 + 32 * ks + 8 * q4); o = MFMA16(av[ks], bb, o); }
#pragma unroll
                for (int ks = 0; ks < 2; ++ks) { const bf16x8 bb = *(LAS bf16x8*)(QE + (16 * ct + fr) * 72 + 32 * ks + 8 * q4); o = MFMA16(as_[ks], bb, o); }
                MFMA_GUARD(o);
                *(u32x2*)(GO + GTOK(16 * ct + fr) * 512 + 128 * h + 16 * wv + 4 * q4) = pack4(o); }
#pragma unroll
            for (int kt = 0; kt < 4; ++kt) { const f32x4 bt = *(LAS f32x4*)(BL + 63 * 64 + 16 * kt + 4 * q4);
                f32x4 s = Sacc[kt]; s[0] *= __expf(bt[0]); s[1] *= __expf(bt[1]); s[2] *= __expf(bt[2]); s[3] *= __expf(bt[3]);
#pragma unroll
                for (int ks = 0; ks < 2; ++ks) { const bf16x8 a = *(LAS bf16x8*)(KDT + (16 * kt + fr) * 72 + 32 * ks + 8 * q4); s = MFMA16(a, av[ks], s); }
                MFMA_GUARD(s); Sacc[kt] = s; }
        }
        LDS_BARRIER();
#pragma unroll
        for (int kt = 0; kt < 4; ++kt) *(LAS u32x2*)(ST + (16 * wv + fr) * 72 + 16 * kt + 4 * q4) = pack4(Sacc[kt]);
#undef GTOK
    }
#undef GLA_PREFETCH
    LDS_BARRIER();
}
DI void gla_post(const Params& P) {
    const int tid = threadIdx.x, lane = tid & 63, wv = tid >> 6;
    const bf16* PM = (const bf16*)(P.ws + WS_PM); const bf16* GO = (const bf16*)(P.ws + WS_GO); bf16* O = (bf16*)(P.ws + WS_O);
    const F8 ng = {*(const f32x4*)(P.in[I_GNG] + 8 * lane), *(const f32x4*)(P.in[I_GNG] + 8 * lane + 4)};
    for (int m = blockIdx.x * 8 + wv; m < M; m += gridDim.x * 8) {
        const F8 a = unpack8(*(const u32x4*)(GO + (size_t)m * 512 + 8 * lane)), bq = unpack8(*(const u32x4*)(GO + (size_t)(M + m) * 512 + 8 * lane));
        const F8 og = unpack8(*(const u32x4*)(PM + (size_t)m * NMIX + C_GOG + 8 * lane));
        const f32x4 o0 = a.a + bq.a, o1 = a.b + bq.b;
        float ss = (o0[0] * o0[0] + o0[1] * o0[1]) + (o0[2] * o0[2] + o0[3] * o0[3]) + (o1[0] * o1[0] + o1[1] * o1[1]) + (o1[2] * o1[2] + o1[3] * o1[3]);
        ss += __shfl_xor(ss, 1); ss += __shfl_xor(ss, 2); ss += __shfl_xor(ss, 4); ss += __shfl_xor(ss, 8);
        const float rs = 1.0f / sqrtf(ss * (1.f / 128.f) + 1e-5f);
        f32x4 r0, r1;
#pragma unroll
        for (int j = 0; j < 4; ++j) { r0[j] = o0[j] * rs * ng.a[j] * (og.a[j] * sigm(og.a[j])); r1[j] = o1[j] * rs * ng.b[j] * (og.b[j] * sigm(og.b[j])); }
        *(u32x4*)(O + (size_t)m * 512 + 8 * lane) = pack8(r0, r1);
    }
}

template <int K> DI void lora_mma(f32x4 (&acc)[4][4], const bf16* Wt, LAS bf16* X, int ldx, int fr, int q4) {
#pragma unroll
    for (int a = 0; a < 4; ++a)
#pragma unroll
        for (int c = 0; c < 4; ++c) acc[a][c] = (f32x4){0.f, 0.f, 0.f, 0.f};
#pragma unroll
    for (int ks = 0; ks < K / 32; ++ks) { bf16x8 af[4];
#pragma unroll
        for (int nt = 0; nt < 4; ++nt) af[nt] = *(const bf16x8*)(Wt + (size_t)(32 * (nt >> 1) + 8 * (fr >> 2) + 4 * (nt & 1) + (fr & 3)) * K + 32 * ks + 8 * q4);
#pragma unroll
        for (int mt = 0; mt < 4; ++mt) { const bf16x8 bb = *(LAS bf16x8*)(X + (16 * mt + fr) * ldx + 32 * ks + 8 * q4);
#pragma unroll
            for (int nt = 0; nt < 4; ++nt) acc[nt][mt] = MFMA16(af[nt], bb, acc[nt][mt]); } }
    __builtin_amdgcn_sched_barrier(0); asm volatile("s_nop 7\n\ts_nop 7" ::: "memory"); __builtin_amdgcn_sched_barrier(0);
}
DI f32x4 shift4(const bf16* rp, bool hp, bool hn, const float* mup, const float* mun) {
    const f32x4 c = unpack4(*(const u32x2*)rp);
    const f32x4 pp = hp ? unpack4(*(const u32x2*)(rp - NMIX)) : (f32x4){0.f, 0.f, 0.f, 0.f};
    const f32x4 pn = hn ? unpack4(*(const u32x2*)(rp + NMIX)) : (f32x4){0.f, 0.f, 0.f, 0.f};
    return c + *(const f32x4*)mup * (pp - c) + *(const f32x4*)mun * (pn - c);
}
DI F8 shift8(const bf16* rp, bool hp, bool hn, const float* mup, const float* mun) {
    const F8 c = unpack8(*(const u32x4*)rp);
    F8 pp, pn; const f32x4 z = (f32x4){0.f, 0.f, 0.f, 0.f};
    if (hp) pp = unpack8(*(const u32x4*)(rp - NMIX)); else { pp.a = z; pp.b = z; }
    if (hn) pn = unpack8(*(const u32x4*)(rp + NMIX)); else { pn.a = z; pn.b = z; }
    F8 r; r.a = c.a + *(const f32x4*)mup * (pp.a - c.a) + *(const f32x4*)mun * (pn.a - c.a);
    r.b = c.b + *(const f32x4*)(mup + 4) * (pp.b - c.b) + *(const f32x4*)(mun + 4) * (pn.b - c.b); return r;
}
DI void r1_tile(const Params& P, LAS unsigned char* lds, int tile) {
    const int tid = threadIdx.x, lane = tid & 63, hd = __builtin_amdgcn_readfirstlane(tid >> 6), fr = lane & 15, q4 = lane >> 4;
    LAS bf16* XW = (LAS bf16*)lds; LAS bf16* XA = XW + 64 * 72; LAS bf16* XG = XA + 64 * 72;
    const bf16* PM = (const bf16*)(P.ws + WS_PM);
    const float* mup = P.in[I_MUP]; const float* mun = P.in[I_MUN];
    const int t0 = tile * 64;
    {   const int row = tid >> 3, g8 = tid & 7; const int tok = t0 + row, tpos = tok & (T - 1);
        const bool hp = tpos > 0, hn = tpos < T - 1;
        const bf16* rp = PM + (size_t)tok * NMIX + C_R0 + 1536 + 32 * g8;
#pragma unroll
        for (int v4 = 0; v4 < 4; ++v4) { F8 s = shift8(rp + 8 * v4, hp, hn, mup + 1536 + 32 * g8 + 8 * v4, mun + 1536 + 32 * g8 + 8 * v4);
            if (g8 < 2) {
#pragma unroll
                for (int j = 0; j < 4; ++j) { s.a[j] = 1.f - 2.f * __builtin_amdgcn_rcpf(__expf(2.f * s.a[j]) + 1.f); s.b[j] = 1.f - 2.f * __builtin_amdgcn_rcpf(__expf(2.f * s.b[j]) + 1.f); }
                *(LAS u32x4*)(XW + row * 72 + 32 * g8 + 8 * v4) = pack8(s.a, s.b);
            } else if (g8 < 4) { *(LAS u32x4*)(XA + row * 72 + 32 * (g8 - 2) + 8 * v4) = pack8(s.a, s.b);
            } else {
#pragma unroll
                for (int j = 0; j < 4; ++j) { s.a[j] = sigm(s.a[j]); s.b[j] = sigm(s.b[j]); }
                *(LAS u32x4*)(XG + row * 136 + 32 * (g8 - 4) + 8 * v4) = pack8(s.a, s.b); } }
    }
    __syncthreads();
    unsigned char* dout = (unsigned char*)P.out;
    bf16* KP = (bf16*)dout; bf16* KKn = KP + (size_t)M * 512; bf16* BB = KKn + (size_t)M * 512; bf16* GG = BB + (size_t)M * 512;
    unsigned short* EF = (unsigned short*)(P.ws + WS_E); unsigned short* EB = EF + (size_t)M * 512;
    float* BON = (float*)(P.ws + WS_BON);
    const int ch8 = 64 * hd + 8 * q4;
    f32x4 acc[4][4];
    lora_mma<64>(acc, (const bf16*)(P.ws + WS_LA2) + (size_t)(64 * hd) * 64, XA, 72, fr, q4);
#pragma unroll
    for (int np = 0; np < 2; ++np) { const f32x4 a0a = *(const f32x4*)(P.in[I_A0] + ch8 + 32 * np), a0b = *(const f32x4*)(P.in[I_A0] + ch8 + 32 * np + 4);
#pragma unroll
        for (int mt = 0; mt < 4; ++mt)
#pragma unroll
            for (int j = 0; j < 4; ++j) { acc[2 * np][mt][j] = sigm(acc[2 * np][mt][j] + a0a[j]); acc[2 * np + 1][mt][j] = sigm(acc[2 * np + 1][mt][j] + a0b[j]); } }
#pragma unroll
    for (int mt = 0; mt < 4; ++mt) { const int tok = t0 + 16 * mt + fr, tpos = tok & (T - 1); const bool hp = tpos > 0, hn = tpos < T - 1;
        const bf16* rp = PM + (size_t)tok * NMIX + C_R0 + ch8;
        F8 ks[2]; float ss = 0.f;
#pragma unroll
        for (int np = 0; np < 2; ++np) { ks[np] = shift8(rp + 512 + 32 * np, hp, hn, mup + 512 + ch8 + 32 * np, mun + 512 + ch8 + 32 * np);
            const f32x4 k0 = ks[np].a * *(const f32x4*)(P.in[I_KK] + ch8 + 32 * np), k1 = ks[np].b * *(const f32x4*)(P.in[I_KK] + ch8 + 32 * np + 4);
            ss += ((k0[0] * k0[0] + k0[1] * k0[1]) + (k0[2] * k0[2] + k0[3] * k0[3])) + ((k1[0] * k1[0] + k1[1] * k1[1]) + (k1[2] * k1[2] + k1[3] * k1[3])); }
        ss += __shfl_xor(ss, 16); ss += __shfl_xor(ss, 32);
        const float inv = 1.0f / fmaxf(sqrtf(ss), 1e-12f);
        float bon = 0.f;
#pragma unroll
        for (int np = 0; np < 2; ++np) { const f32x4 aa = acc[2 * np][mt], ab = acc[2 * np + 1][mt];
            const f32x4 kka = *(const f32x4*)(P.in[I_KK] + ch8 + 32 * np), kkb = *(const f32x4*)(P.in[I_KK] + ch8 + 32 * np + 4);
            const f32x4 kaa = *(const f32x4*)(P.in[I_KA] + ch8 + 32 * np), kab = *(const f32x4*)(P.in[I_KA] + ch8 + 32 * np + 4);
            const f32x4 kn0 = ks[np].a * kka * inv, kn1 = ks[np].b * kkb * inv;
            const f32x4 kp0 = ks[np].a * (1.0f + (aa - 1.0f) * kaa), kp1 = ks[np].b * (1.0f + (ab - 1.0f) * kab);
            const f32x4 bb0 = kn0 * aa, bb1 = kn1 * ab;
            const F8 rs = shift8(rp + 32 * np, hp, hn, mup + ch8 + 32 * np, mun + ch8 + 32 * np);
            const f32x4 rk0 = *(const f32x4*)(P.in[I_RK] + ch8 + 32 * np), rk1 = *(const f32x4*)(P.in[I_RK] + ch8 + 32 * np + 4);
            bon += ((rs.a[0] * kp0[0] * rk0[0] + rs.a[1] * kp0[1] * rk0[1]) + (rs.a[2] * kp0[2] * rk0[2] + rs.a[3] * kp0[3] * rk0[3]))
                 + ((rs.b[0] * kp1[0] * rk1[0] + rs.b[1] * kp1[1] * rk1[1]) + (rs.b[2] * kp1[2] * rk1[2] + rs.b[3] * kp1[3] * rk1[3]));
            const size_t o = (size_t)tok * 512 + ch8 + 32 * np;
            *(u32x4*)(KP + o) = pack8(kp0, kp1); *(u32x4*)(KKn + o) = pack8(kn0, kn1); *(u32x4*)(BB + o) = pack8(bb0, bb1); }
        bon += __shfl_xor(bon, 16); bon += __shfl_xor(bon, 32);
        if (q4 == 0) BON[(size_t)tok * 8 + hd] = bon; }
#pragma unroll
    for (int d = 0; d < 2; ++d) {
        lora_mma<64>(acc, (const bf16*)(P.ws + (d ? WS_LW2B : WS_LW2F)) + (size_t)(64 * hd) * 64, XW, 72, fr, q4);
        unsigned short* E = d ? EB : EF; const float* w0 = d ? P.in[I_W0B] : P.in[I_W0F];
#pragma unroll
        for (int np = 0; np < 2; ++np) { const f32x4 w0a = *(const f32x4*)(w0 + ch8 + 32 * np), w0b = *(const f32x4*)(w0 + ch8 + 32 * np + 4);
#pragma unroll
            for (int mt = 0; mt < 4; ++mt) { const f32x4 a = acc[2 * np][mt], c = acc[2 * np + 1][mt]; u32x4 w;
                w.x = pkh2(0.60653066f * sigm(a[0] + w0a[0]), 0.60653066f * sigm(a[1] + w0a[1])); w.y = pkh2(0.60653066f * sigm(a[2] + w0a[2]), 0.60653066f * sigm(a[3] + w0a[3]));
                w.z = pkh2(0.60653066f * sigm(c[0] + w0b[0]), 0.60653066f * sigm(c[1] + w0b[1])); w.w = pkh2(0.60653066f * sigm(c[2] + w0b[2]), 0.60653066f * sigm(c[3] + w0b[3]));
                *(u32x4*)(E + (size_t)(t0 + 16 * mt + fr) * 512 + ch8 + 32 * np) = w; } }
    }
    lora_mma<128>(acc, (const bf16*)(P.ws + WS_LG2) + (size_t)(64 * hd) * 128, XG, 136, fr, q4);
#pragma unroll
    for (int np = 0; np < 2; ++np)
#pragma unroll
        for (int mt = 0; mt < 4; ++mt) *(u32x4*)(GG + (size_t)(t0 + 16 * mt + fr) * 512 + ch8 + 32 * np) = pack8(acc[2 * np][mt], acc[2 * np + 1][mt]);
    __syncthreads();
}

constexpr int TC = 16;
#define OPI(buf, d, arr) (OP + ((((buf) * 2 + (d)) * 6 + (arr)) * (TC * 64)))
DI void scan_load(const Params& P, LAS float* OP, int buf, int ci, int b, int hd, int ltid) {
    const int d = ltid >> 7, i = (ltid >> 3) & 15, c8 = ltid & 7;
    const int step = TC * ci + i, tpos = d ? T - 1 - step : step; const size_t tok = (size_t)b * T + tpos;
    const int ch0 = 64 * hd + 8 * c8;
    const bf16* PM = (const bf16*)(P.ws + WS_PM);
    const bf16* KP = (const bf16*)P.out; const bf16* KKn = KP + (size_t)M * 512; const bf16* BB = KKn + (size_t)M * 512;
    const unsigned short* E = (const unsigned short*)(P.ws + WS_E) + (size_t)d * M * 512;
    const F8 kp = unpack8(*(const u32x4*)(KP + tok * 512 + ch0)), kk = unpack8(*(const u32x4*)(KKn + tok * 512 + ch0)), bb = unpack8(*(const u32x4*)(BB + tok * 512 + ch0));
    const u32x4 ew = *(const u32x4*)(E + tok * 512 + ch0);
    const bool hp = tpos > 0, hn = tpos < T - 1;
    const bf16* rp = PM + tok * NMIX + C_R0 + ch0;
    const F8 r = shift8(rp, hp, hn, P.in[I_MUP] + ch0, P.in[I_MUN] + ch0), v = shift8(rp + 1024, hp, hn, P.in[I_MUP] + 1024 + ch0, P.in[I_MUN] + 1024 + ch0);
    const int o = i * 64 + 8 * c8;
    *(LAS f32x4*)(OPI(buf, d, 0) + o) = -kk.a; *(LAS f32x4*)(OPI(buf, d, 0) + o + 4) = -kk.b;
    f32x4 w0, w1; w0[0] = __expf(-hlo(ew.x)); w0[1] = __expf(-hhi(ew.x)); w0[2] = __expf(-hlo(ew.y)); w0[3] = __expf(-hhi(ew.y));
    w1[0] = __expf(-hlo(ew.z)); w1[1] = __expf(-hhi(ew.z)); w1[2] = __expf(-hlo(ew.w)); w1[3] = __expf(-hhi(ew.w));
    *(LAS f32x4*)(OPI(buf, d, 1) + o) = w0; *(LAS f32x4*)(OPI(buf, d, 1) + o + 4) = w1;
    *(LAS f32x4*)(OPI(buf, d, 2) + o) = bb.a; *(LAS f32x4*)(OPI(buf, d, 2) + o + 4) = bb.b;
    *(LAS f32x4*)(OPI(buf, d, 3) + o) = kp.a; *(LAS f32x4*)(OPI(buf, d, 3) + o + 4) = kp.b;
    *(LAS f32x4*)(OPI(buf, d, 4) + o) = r.a; *(LAS f32x4*)(OPI(buf, d, 4) + o + 4) = r.b;
    *(LAS f32x4*)(OPI(buf, d, 5) + o) = v.a; *(LAS f32x4*)(OPI(buf, d, 5) + o + 4) = v.b;
}
DI void scan_flush(const Params& P, LAS float* YB, int buf, int ci, int b, int hd, int ltid) {
    const int d = ltid >> 7, i = (ltid >> 3) & 15, c8 = ltid & 7;
    const int step = TC * ci + i, tpos = d ? T - 1 - step : step; const size_t tok = (size_t)b * T + tpos;
    bf16* Y = (bf16*)(P.ws + WS_GO) + (size_t)d * M * 512;
    const LAS float* y = YB + (buf * 2 + d) * (TC * 64) + i * 64 + 8 * c8;
    *(u32x4*)(Y + tok * 512 + 64 * hd + 8 * c8) = pack8(*(const LAS f32x4*)y, *(const LAS f32x4*)(y + 4));
}
struct ScanOps { f32x2 nk[4], w[4], bb[4], kx[4], rx[4]; f32x4 vv; };
DI void scan_ops_load(ScanOps& o, const LAS float* base, const LAS float* vb, int i) {
#pragma unroll
    for (int hh = 0; hh < 2; ++hh) { const f32x4 t0 = *(const LAS f32x4*)(base + 0 * TC * 64 + i * 64 + 4 * hh), t1 = *(const LAS f32x4*)(base + 1 * TC * 64 + i * 64 + 4 * hh), t2 = *(const LAS f32x4*)(base + 2 * TC * 64 + i * 64 + 4 * hh),
                                                   t3 = *(const LAS f32x4*)(base + 3 * TC * 64 + i * 64 + 4 * hh), t4 = *(const LAS f32x4*)(base + 4 * TC * 64 + i * 64 + 4 * hh);
        o.nk[2 * hh] = (f32x2){t0[0], t0[1]}; o.nk[2 * hh + 1] = (f32x2){t0[2], t0[3]}; o.w[2 * hh] = (f32x2){t1[0], t1[1]}; o.w[2 * hh + 1] = (f32x2){t1[2], t1[3]};
        o.bb[2 * hh] = (f32x2){t2[0], t2[1]}; o.bb[2 * hh + 1] = (f32x2){t2[2], t2[3]}; o.kx[2 * hh] = (f32x2){t3[0], t3[1]}; o.kx[2 * hh + 1] = (f32x2){t3[2], t3[3]};
        o.rx[2 * hh] = (f32x2){t4[0], t4[1]}; o.rx[2 * hh + 1] = (f32x2){t4[2], t4[3]}; }
    o.vv = *(const LAS f32x4*)(vb + i * 64);
}
DI void scan_step(f32x2 (&S)[4][4], const ScanOps& o, LAS float* yb, int i, int c8) {
    float sa[4];
#pragma unroll
    for (int j = 0; j < 4; ++j) { f32x2 a = S[j][0] * o.nk[0]; a = S[j][1] * o.nk[1] + a; a = S[j][2] * o.nk[2] + a; a = S[j][3] * o.nk[3] + a; sa[j] = oct_sum(a.x + a.y); }
    f32x4 yo;
#pragma unroll
    for (int j = 0; j < 4; ++j) { const f32x2 sav = (f32x2){sa[j], sa[j]}, vjv = (f32x2){o.vv[j], o.vv[j]};
#pragma unroll
        for (int p = 0; p < 4; ++p) S[j][p] = S[j][p] * o.w[p] + (sav * o.bb[p] + vjv * o.kx[p]);
        f32x2 y = S[j][0] * o.rx[0]; y = S[j][1] * o.rx[1] + y; y = S[j][2] * o.rx[2] + y; y = S[j][3] * o.rx[3] + y; yo[j] = oct_sum(y.x + y.y); }
    if (c8 == 0) *(LAS f32x4*)(yb + i * 64) = yo;
}
DI void scan_unit(const Params& P, LAS unsigned char* lds, int bh) {
    const int tid = threadIdx.x, lane = tid & 63, wv = __builtin_amdgcn_readfirstlane(tid >> 6);
    const int b = bh >> 3, hd = bh & 7;
    LAS float* OP = (LAS float*)lds; LAS float* YB = OP + 2 * 2 * 6 * TC * 64;
    constexpr int NCH = T / TC;
    const bool loader = wv >= 4; const int ltid = tid - 256;
    const int d = wv >> 1, c8 = lane & 7, rbase = 32 * (wv & 1) + 4 * (lane >> 3);
    f32x2 S[4][4];
#pragma unroll
    for (int j = 0; j < 4; ++j)
#pragma unroll
        for (int p = 0; p < 4; ++p) S[j][p] = (f32x2){0.f, 0.f};
    if (loader) scan_load(P, OP, 0, 0, b, hd, ltid);
    __syncthreads();
    for (int ci = 0; ci < NCH; ++ci) {
        const int buf = ci & 1;
        if (loader) {
            if (ci + 1 < NCH) scan_load(P, OP, buf ^ 1, ci + 1, b, hd, ltid);
            if (ci > 0) scan_flush(P, YB, buf ^ 1, ci - 1, b, hd, ltid);
        } else {
            const LAS float* base = OPI(buf, d, 0) + 8 * c8;
            const LAS float* vb = OPI(buf, d, 5) + rbase;
            LAS float* yb = YB + (buf * 2 + d) * (TC * 64) + rbase;
            ScanOps cur, nxt; scan_ops_load(cur, base, vb, 0);
#pragma unroll 1
            for (int i = 0; i < TC; i += 2) {
                scan_ops_load(nxt, base, vb, i + 1);
                scan_step(S, cur, yb, i, c8);
                if (i + 2 < TC) scan_ops_load(cur, base, vb, i + 2);
                scan_step(S, nxt, yb, i + 1, c8);
            }
        }
        __syncthreads();
    }
    if (loader) scan_flush(P, YB, (NCH - 1) & 1, NCH - 1, b, hd, ltid);
    __syncthreads();
}
DI void r3_post(const Params& P) {
    const int tid = threadIdx.x, lane = tid & 63, wv = tid >> 6;
    const bf16* PM = (const bf16*)(P.ws + WS_PM); const bf16* Y = (const bf16*)(P.ws + WS_GO); bf16* O = (bf16*)(P.ws + WS_O);
    const bf16* GG = (const bf16*)P.out + (size_t)3 * M * 512; const float* BON = (const float*)(P.ws + WS_BON);
    const F8 lw = {*(const f32x4*)(P.in[I_LNW] + 8 * lane), *(const f32x4*)(P.in[I_LNW] + 8 * lane + 4)}, lb = {*(const f32x4*)(P.in[I_LNB] + 8 * lane), *(const f32x4*)(P.in[I_LNB] + 8 * lane + 4)};
    for (int m = blockIdx.x * 8 + wv; m < M; m += gridDim.x * 8) {
        const int tpos = m & (T - 1);
        const F8 a = unpack8(*(const u32x4*)(Y + (size_t)m * 512 + 8 * lane)), bq = unpack8(*(const u32x4*)(Y + (size_t)(M + m) * 512 + 8 * lane));
        const F8 g = unpack8(*(const u32x4*)(GG + (size_t)m * 512 + 8 * lane));
        const F8 v = shift8(PM + (size_t)m * NMIX + C_R0 + 1024 + 8 * lane, tpos > 0, tpos < T - 1, P.in[I_MUP] + 1024 + 8 * lane, P.in[I_MUN] + 1024 + 8 * lane);
        const float bon = BON[(size_t)m * 8 + (lane >> 3)];
        const f32x4 y0 = a.a + bq.a, y1 = a.b + bq.b;
        float s = (y0[0] + y0[1]) + (y0[2] + y0[3]) + (y1[0] + y1[1]) + (y1[2] + y1[3]);
        s += __shfl_xor(s, 1); s += __shfl_xor(s, 2); s += __shfl_xor(s, 4);
        const float mu = s * (1.f / 64.f);
        const f32x4 d0 = y0 - mu, d1 = y1 - mu;
        float q = (d0[0] * d0[0] + d0[1] * d0[1]) + (d0[2] * d0[2] + d0[3] * d0[3]) + (d1[0] * d1[0] + d1[1] * d1[1]) + (d1[2] * d1[2] + d1[3] * d1[3]);
        q += __shfl_xor(q, 1); q += __shfl_xor(q, 2); q += __shfl_xor(q, 4);
        const float rs = 1.0f / sqrtf(q * (1.f / 64.f) + 64.f * 1e-5f);
        const f32x4 o0 = (d0 * rs * lw.a + lb.a + bon * v.a) * g.a, o1 = (d1 * rs * lw.b + lb.b + bon * v.b) * g.b;
        *(u32x4*)(O + (size_t)(M + m) * 512 + 8 * lane) = pack8(o0, o1);
    }
}

DI void conv_phase(const Params& P, int half, int sel = 0) {
    const bf16* U = (const bf16*)(P.ws + WS_U); bf16* ACT = (bf16*)(P.ws + WS_ACT);
    const float* cw = P.in[I_FCW]; const float* cb = P.in[I_FCB];
    constexpr int NCG = DFFP / 8;
    const int nitems = (MH / 8) * NCG;
    for (int it = blockIdx.x * 512 + threadIdx.x; it < nitems; it += gridDim.x * 512) {
        const int run = it / NCG, cgp = it - run * NCG, j0 = 8 * cgp;
        const int tl0 = run * 8, tg0 = half * MH + tl0, tpos0 = tg0 & (T - 1);
        bf16* ap = ACT + (size_t)tg0 * DFFP + j0;
        if (j0 >= DFF) {
#pragma unroll
            for (int rr = 0; rr < 8; ++rr) *(u32x4*)(ap + (size_t)rr * DFFP) = (u32x4){0u, 0u, 0u, 0u};
            continue; }
        const int ucol = 256 * (j0 >> 7) + (j0 & 127);
        F8 wg[3], wvv[3];
#pragma unroll
        for (int t = 0; t < 3; ++t) { wg[t].a = *(const f32x4*)(cw + t * NUPSRC + j0); wg[t].b = *(const f32x4*)(cw + t * NUPSRC + j0 + 4); wvv[t].a = *(const f32x4*)(cw + t * NUPSRC + DFF + j0); wvv[t].b = *(const f32x4*)(cw + t * NUPSRC + DFF + j0 + 4); }
        const F8 bg = {*(const f32x4*)(cb + j0), *(const f32x4*)(cb + j0 + 4)}, bv = {*(const f32x4*)(cb + DFF + j0), *(const f32x4*)(cb + DFF + j0 + 4)};
        const bf16* up = U + (size_t)tl0 * NUP + ucol;
        const f32x4 z = (f32x4){0.f, 0.f, 0.f, 0.f};
        F8 pg, pv, cg_, cv, ng, nv;
        if (tpos0 > 0) { pg = unpack8(*(const u32x4*)(up - NUP)); pv = unpack8(*(const u32x4*)(up - NUP + 128)); } else { pg.a = z; pg.b = z; pv.a = z; pv.b = z; }
        cg_ = unpack8(*(const u32x4*)up); cv = unpack8(*(const u32x4*)(up + 128));
#pragma unroll
        for (int rr = 0; rr < 8; ++rr) {
            if (tpos0 + rr + 1 < T) { ng = unpack8(*(const u32x4*)(up + (size_t)(rr + 1) * NUP)); nv = unpack8(*(const u32x4*)(up + (size_t)(rr + 1) * NUP + 128)); } else { ng.a = z; ng.b = z; nv.a = z; nv.b = z; }
            const f32x4 g0 = wg[0].a * pg.a + wg[1].a * cg_.a + wg[2].a * ng.a + bg.a, g1 = wg[0].b * pg.b + wg[1].b * cg_.b + wg[2].b * ng.b + bg.b;
            const f32x4 x0 = wvv[0].a * pv.a + wvv[1].a * cv.a + wvv[2].a * nv.a + bv.a, x1 = wvv[0].b * pv.b + wvv[1].b * cv.b + wvv[2].b * nv.b + bv.b;
            f32x4 o0, o1;
#pragma unroll
            for (int j = 0; j < 4; ++j) { o0[j] = g0[j] * sigm(g0[j]) * x0[j]; o1[j] = g1[j] * sigm(g1[j]) * x1[j]; }
            { const int rt_ = (tl0 + rr) & 255; const bool edge = (rt_ == 0 || rt_ == 255);
              if (sel == 0 || (sel == 1 && edge) || (sel == 2 && !edge)) *(u32x4*)(ap + (size_t)rr * DFFP) = pack8(o0, o1); }
            pg = cg_; pv = cv; cg_ = ng; cv = nv;
        }
    }
}
#ifndef DBG_UDUMP
#define DBG_UDUMP 0
#endif
DI void conv_fix(const Params& P) {
    const float* SB = (const float*)(P.ws + (DBG_UDUMP ? 868 * MiB : WS_SB)); bf16* ACT = (bf16*)(P.ws + WS_ACT);
    const float* cw = P.in[I_FCW]; const float* cb = P.in[I_FCB];
    constexpr int NG = DFFP / 4;
    const int nitems = 256 * 2 * NG;
    for (int it = blockIdx.x * 512 + threadIdx.x; it < nitems; it += gridDim.x * 512) {
        const int jg = it % NG, rw = it / NG, which = rw & 1, pm = rw >> 1, j = 4 * jg;
        bf16* ap = ACT + (size_t)(pm * 256 + (which ? 255 : 0)) * DFFP + j;
        if (j >= DFF) { *(u32x2*)ap = (u32x2){0u, 0u}; continue; }
        const int col = 256 * (j >> 7) + (j & 127);
        const f32x4 z = (f32x4){0.f, 0.f, 0.f, 0.f};
        const float* cur = SB + (size_t)(pm * 4 + (which ? 3 : 0)) * NUP + col;
        const float* prv = which ? SB + (size_t)(pm * 4 + 2) * NUP + col : ((pm & 7) ? SB + (size_t)((pm - 1) * 4 + 3) * NUP + col : nullptr);
        const float* nxt = which ? (((pm & 7) != 7) ? SB + (size_t)((pm + 1) * 4 + 0) * NUP + col : nullptr) : SB + (size_t)(pm * 4 + 1) * NUP + col;
        const f32x4 cgv = *(const f32x4*)cur, cvv = *(const f32x4*)(cur + 128);
        const f32x4 pg = prv ? *(const f32x4*)prv : z, pv = prv ? *(const f32x4*)(prv + 128) : z;
        const f32x4 ng = nxt ? *(const f32x4*)nxt : z, nv = nxt ? *(const f32x4*)(nxt + 128) : z;
        const f32x4 g = *(const f32x4*)(cw + j) * pg + *(const f32x4*)(cw + NUPSRC + j) * cgv + *(const f32x4*)(cw + 2 * NUPSRC + j) * ng + *(const f32x4*)(cb + j);
        const f32x4 v = *(const f32x4*)(cw + DFF + j) * pv + *(const f32x4*)(cw + NUPSRC + DFF + j) * cvv + *(const f32x4*)(cw + 2 * NUPSRC + DFF + j) * nv + *(const f32x4*)(cb + DFF + j);
        f32x4 o;
#pragma unroll
        for (int i = 0; i < 4; ++i) o[i] = g[i] * sigm(g[i]) * v[i];
        *(u32x2*)ap = pack4(o);
    }
}
#ifndef DBG_SKIPMASK
#define DBG_SKIPMASK 0
#endif
#ifndef FUSE_NORM2
#define FUSE_NORM2 1
#endif
#ifndef FUSE_CONV
#define FUSE_CONV 1
#endif
#ifndef SEAM_ACQ
#define SEAM_ACQ 0
#endif
#ifndef USE_CG_SYNC
#define USE_CG_SYNC 0
#endif
#ifndef N_PHASE_LAUNCH
#define N_PHASE_LAUNCH 0
#endif
constexpr int NPHASES = 16;
__global__ void __launch_bounds__(512, 2) fwd_kernel(Params P, int ph_lo, int ph_hi) {
    extern __shared__ __attribute__((aligned(16))) unsigned char lds_raw[];
    LAS unsigned char* lds = (LAS unsigned char*)lds_raw;
    const int tid = threadIdx.x, wv = tid >> 6, lane = tid & 63;
    unsigned char* ws = P.ws;
    bf16* HB = (bf16*)(ws + WS_HB);
    const int G = gridDim.x, bx = blockIdx.x;
#if N_PHASE_LAUNCH
#define SEAM() do {} while (0)
#define SEAM0() do {} while (0)
#else
    cg::grid_group grid = cg::this_grid();
    volatile LAS unsigned* xst = (volatile LAS unsigned*)(lds + 131072 + 64);
    if (tid < 2) xst[tid] = 0u;
    __syncthreads();
    const XcdBarrier xbar = xcd_barrier_post((unsigned*)ws, xst);
#define SEAM0() do { if (ph_lo < 0) grid.sync(); else xcd_barrier(xbar); } while (0)
#if USE_CG_SYNC
#define SEAM() grid.sync()
#else
#if SEAM_ACQ
#define SEAM() do { xcd_barrier(xbar); __builtin_amdgcn_fence(__ATOMIC_ACQUIRE, "agent"); } while (0)
#else
#define SEAM() xcd_barrier(xbar)
#endif
#endif
#endif
#define IN(k) (ph_lo <= (k) && (k) < ph_hi)
#define GEMM_CALL(EPI, A_, B_, M_, N_, K_, E_) do { pg8::Gemm g{(const pg8::bf16_t*)(A_), (const pg8::bf16_t*)(B_), (M_), (N_), (K_)}; pg8::StaticOrder S; S.init((M_), (N_), G, bx); \
        pg8::gemm_phase<EPI, pg8::StaticOrder, PG8_ALIGN, PG8_SP2>(lds, g, S, (E_)); } while (0)
    if (IN(0)) { p0_prologue(P, lds); SEAM0(); }
    if (IN(1)) { pg8::EpiStore E{(pg8::bf16_t*)(ws + WS_PM), NMIX, NMIX, 0, nullptr}; GEMM_CALL(pg8::EpiStore, HB, ws + WS_WMIX, M, NMIXP, D, E);
#ifdef PROBE_G1A2
                 __syncthreads(); GEMM_CALL(pg8::EpiStore, HB, ws + WS_WMIX, M, NMIXP, D, E);
#endif
                 SEAM(); }
    if (IN(2)) { for (int u = bx; u < 256; u += G) gla_unit(P, lds, u);
#ifdef PROBE_GLA2
                 for (int u = bx; u < 256; u += G) gla_unit(P, lds, u);
#endif
                 SEAM(); }
    if (IN(3)) { gla_post(P); for (int t = bx; t < M / 64; t += G) r1_tile(P, lds, t);
#ifdef PROBE_R12
                 for (int t = bx; t < M / 64; t += G) r1_tile(P, lds, t);
#endif
                 SEAM(); }
    if (IN(5)) { for (int u = bx; u < 256; u += G) scan_unit(P, lds, u);
#ifdef PROBE_SCAN2
                 for (int u = bx; u < 256; u += G) scan_unit(P, lds, u);
#endif
                 SEAM(); }
    if (IN(6)) { r3_post(P); __syncthreads();
                 pg8::EpiStore E{(pg8::bf16_t*)(ws + WS_E), D, D, D, (pg8::bf16_t*)P.out}; GEMM_CALL(pg8::EpiStore, HB, ws + WS_WGATE, M, NGATE, D, E); SEAM(); }
    if (IN(7)) { { pg8::EpiGate<0> E{(const pg8::bf16_t*)(ws + WS_E), (pg8::bf16_t*)HB, D}; GEMM_CALL(pg8::EpiGate<0>, ws + WS_O, ws + WS_WGP, M, D, 512, E); }
                 __syncthreads();
                 { pg8::EpiGate<1> E{(const pg8::bf16_t*)P.out, (pg8::bf16_t*)HB, D}; GEMM_CALL(pg8::EpiGate<1>, ws + WS_O + (size_t)M * 512 * 2, ws + WS_WRP, M, D, 512, E); }
                 SEAM(); }
#if FUSE_NORM2
    if (IN(8)) { pg8::EpiResNorm E{P.in[I_X], P.out, (pg8::bf16_t*)(ws + WS_H2), P.in[I_N2G], (float*)(ws + 65536), D}; GEMM_CALL(pg8::EpiResNorm, HB, ws + WS_WOUT, M, D, D, E); SEAM(); }
#else
    if (IN(8)) { pg8::EpiRes E{P.in[I_X], P.out, D}; GEMM_CALL(pg8::EpiRes, HB, ws + WS_WOUT, M, D, D, E); SEAM(); }
#endif
#if !FUSE_NORM2
    if (IN(9)) { for (int m = bx * 8 + wv; m < M; m += G * 16) rms_rows2_bf16(P.out, P.in[I_N2G], HB, m, m + G * 8, lane); SEAM(); }
#endif
#if FUSE_CONV
    if (IN(10)) { pg8::EpiConv E{(pg8::bf16_t*)(ws + WS_ACT), (float*)(ws + (DBG_UDUMP ? 868 * MiB : WS_SB)), P.in[I_FCW], P.in[I_FCB], (PG8_LAS float*)(lds + 131072 + 256), DBG_UDUMP ? (pg8::bf16_t*)(ws + WS_U) : nullptr, FUSE_NORM2 ? (const float*)(ws + 65536) : nullptr};
                  GEMM_CALL(pg8::EpiConv, FUSE_NORM2 ? (bf16*)(ws + WS_H2) : HB, ws + WS_WUP, M, NUP, D, E); SEAM(); }
    if (IN(11)) { conv_fix(P); SEAM(); }
#if DBG_UDUMP
    if (IN(12)) { conv_phase(P, 0, 2); SEAM(); }
#endif
#ifdef DBG_SEL
#pragma unroll 1
    for (int half = 0; half < 2; ++half) {
        if (IN(12)) { pg8::EpiStore E{(pg8::bf16_t*)(ws + WS_U), NUP, NUP, 0, nullptr}; GEMM_CALL(pg8::EpiStore, HB + (size_t)half * MH * D, ws + WS_WUP, MH, NUP, D, E); SEAM(); }
        if (IN(12)) { conv_phase(P, half, DBG_SEL); SEAM(); }
    }
#endif
#else
#pragma unroll 1
    for (int half = 0; half < 2; ++half) {
        if (IN(10 + 2 * half)) { pg8::EpiStore E{(pg8::bf16_t*)(ws + WS_U), NUP, NUP, 0, nullptr}; GEMM_CALL(pg8::EpiStore, HB + (size_t)half * MH * D, ws + WS_WUP, MH, NUP, D, E); SEAM(); }
        if (IN(11 + 2 * half)) { conv_phase(P, half); SEAM(); }
    }
#endif
    if (IN(14)) { pg8::EpiRes E{P.out, (float*)(ws + WS_X2), D}; GEMM_CALL(pg8::EpiRes, ws + WS_ACT, ws + WS_WDN, M, D, DFFP, E); SEAM(); }
    if (IN(15)) { for (int m = bx * 8 + wv; m < M; m += G * 16) rms_rows2_f32(ws + WS_X2, P.out, m, m + G * 8, P.in[I_NFG], lane); }
#ifdef DBG_DUMP
    if (IN(20)) { const bf16* src = (const bf16*)(ws + DBG_SRC); for (size_t i = (size_t)bx * 512 + tid; i < (size_t)M * D; i += (size_t)G * 512) P.out[i] = bfl(src[i]); }
#endif
}

extern "C" void kernel_launch(void* const* d_in, const int* in_sizes, int n_in, void* d_out, int out_size, void* d_ws, size_t ws_size, hipStream_t stream) {
    static int grid = 0;
    if (grid == 0) {
        if (n_in != 31 || in_sizes[0] != M * D || out_size != M * D || ws_size < 1024 * MiB) { fprintf(stderr, "kernel_launch: unexpected shapes (n_in %d, in0 %d, out %d, ws %zu)\n", n_in, n_in > 0 ? in_sizes[0] : -1, out_size, ws_size); grid = -1; return; }
        int dev = 0, cus = 0, per_cu = 0;
        if (hipGetDevice(&dev) != hipSuccess || hipDeviceGetAttribute(&cus, hipDeviceAttributeMultiprocessorCount, dev) != hipSuccess) { grid = -1; return; }
        if (hipFuncSetAttribute((const void*)fwd_kernel, hipFuncAttributeMaxDynamicSharedMemorySize, LDS_BYTES) != hipSuccess) { fprintf(stderr, "kernel_launch: hipFuncSetAttribute failed\n"); grid = -1; return; }
        if (hipOccupancyMaxActiveBlocksPerMultiprocessor(&per_cu, (const void*)fwd_kernel, 512, LDS_BYTES) != hipSuccess || per_cu < 1) { fprintf(stderr, "kernel_launch: occupancy query says %d\n", per_cu); per_cu = 1; }
        (void)hipGetLastError();
        grid = cus * 1;
    }
    if (grid < 0) return;
    Params p{};
    for (int i = 0; i < 31; ++i) p.in[i] = (const float*)d_in[i];
    p.out = (float*)d_out; p.ws = (unsigned char*)d_ws;
#if N_PHASE_LAUNCH
#ifdef DBG_DUMP
    for (int ph = 0; ph <= DBG_DUMP; ++ph) { if (DBG_SKIPMASK & (1 << ph)) continue; hipLaunchKernelGGL(fwd_kernel, dim3(grid), dim3(512), LDS_BYTES, stream, p, ph, ph + 1); }
    if (DBG_DUMP < 14) hipLaunchKernelGGL(fwd_kernel, dim3(grid), dim3(512), LDS_BYTES, stream, p, 20, 21);
#else
    for (int ph = 0; ph < NPHASES; ++ph) { hipLaunchKernelGGL(fwd_kernel, dim3(grid), dim3(512), LDS_BYTES, stream, p, ph, ph + 1); }
#endif
#else
    if (hipMemsetAsync(d_ws, 0, 65536 + 262144, stream) != hipSuccess) { fprintf(stderr, "kernel_launch: memset failed\n"); return; }
    int lo = 0, hi = NPHASES;
    void* args[] = {&p, &lo, &hi};
    hipError_t e = hipLaunchCooperativeKernel((const void*)fwd_kernel, dim3(grid), dim3(512), args, LDS_BYTES, stream);
    if (e != hipSuccess) fprintf(stderr, "kernel_launch: cooperative launch failed: %s (grid %d)\n", hipGetErrorString(e), grid);
#endif
}
```

```cpp
#include <hip/hip_runtime.h>
#include <hip/hip_cooperative_groups.h>
#include <cstdio>
#include <cstdint>
namespace cg = cooperative_groups;
#define N_PHASE_LAUNCH 0
#define FUSE_NORM2 0
namespace pg8 {
#define PG8_LAS __attribute__((address_space(3)))
typedef unsigned short bf16_t;
typedef short bf16x8 __attribute__((ext_vector_type(8)));
typedef float f32x4 __attribute__((ext_vector_type(4)));
typedef unsigned u32x4 __attribute__((ext_vector_type(4)));
constexpr int BM = 256, BK = 64, HALF = 128, HTB = HALF * BK * 2  , STAGE_BYTES = 8 * HTB, NXCD = 8, WGM = 8;

__host__ __device__ __forceinline__ int lds_byte(int r, int c) { const int st = (r >> 4) * 2 + (c >> 5), rr = r & 15, cc = c & 31, ob = rr * 64 + cc * 2; return st * 1024 + (ob ^ (((ob >> 9) & 1) << 5)); }
__host__ __device__ __forceinline__ void stage_rc(int b, int& R, int& C) { const int st = b / 1024, sb = b % 1024, swz = sb ^ (((sb >> 9) & 1) << 5); R = (st >> 1) * 16 + swz / 64; C = (st & 1) * 32 + (swz % 64) / 2; }
__host__ __device__ __forceinline__ int perm32(int rho) { const int n = rho >> 4, i = rho & 15; return 8 * (i >> 2) + 4 * n + (i & 3); }

struct Unit { int pm, pn; };
struct Gemm { const bf16_t* A; const bf16_t* Bt; int M, N, K; };

struct StaticOrder {
    int nM, nN, nwg, G, c;
    __host__ __device__ void init(int M, int N, int G_, int c_) { nM = M / BM; nN = N / BM; nwg = nM * nN; G = G_; c = c_; }
    __host__ __device__ bool next(int i, Unit& u) const {
        const long L = (long)i * G + c; if (L >= nwg) return false;
        int wgid = (int)L; { const int q = nwg / NXCD, r = nwg % NXCD, xcd = wgid % NXCD, off = wgid / NXCD; wgid = (xcd < r ? xcd * (q + 1) : r * (q + 1) + (xcd - r) * q) + off; }
        const int nig = WGM * nN, gid = wgid / nig, fm = gid * WGM, gsz = (nM - fm) < WGM ? (nM - fm) : WGM;
        u.pm = fm + ((wgid % nig) % gsz); u.pn = (wgid % nig) / gsz; return true;
    }
    __device__ __forceinline__ void a_ready(const Unit&) const {}
    __device__ __forceinline__ void done(const Unit&) const {}
};

__device__ __forceinline__ unsigned cvt_pk_bf16(float lo, float hi) { unsigned r; asm volatile("v_cvt_pk_bf16_f32 %0, %1, %2" : "=v"(r) : "v"(lo), "v"(hi)); return r; }

template <class Epi, class Sched, bool ALIGN_EPI = false, bool SP2 = false>
__device__ __forceinline__ void gemm_phase(PG8_LAS unsigned char* lds, const Gemm g, const Sched& S, const Epi& E) {
    const int tid = threadIdx.x, wid = __builtin_amdgcn_readfirstlane(tid >> 6), lane = tid & 63, wr = wid >> 2, wc = wid & 3, fr = lane & 15, fq = lane >> 4;
    const int K = g.K, nt = K / BK;
    unsigned voffA[2], voffB[2];
#pragma unroll
    for (int i = 0; i < 2; ++i) { int R, C; stage_rc(tid * 16 + i * 8192, R, C); const int Rb = Epi::PERM ? ((R & ~31) + perm32(R & 31)) : R;
        voffA[i] = (unsigned)(R * K + C) * 2u; voffB[i] = (unsigned)(Rb * K + C) * 2u; }
    const size_t kstep = (size_t)(BK * 2);
    const size_t hstep = (size_t)HALF * K * 2;
    const size_t tstep = 2 * hstep;
    const unsigned ldsw = (unsigned)wid * 1024u;
    const int aoff = lds_byte(wr * 64 + fr, fq * 8), boff = lds_byte(wc * 32 + fr, fq * 8);
#define PG8_SA(b, h) (((b) * 2 + (h)) * HTB)
#define PG8_SB(b, h) ((4 + (b) * 2 + (h)) * HTB)
#define PG8_STAGE(bufoff, gbase, voff) do { _Pragma("unroll") for (int _i = 0; _i < 2; ++_i) \
        __builtin_amdgcn_global_load_lds((const unsigned*)((const char*)(gbase) + (voff)[_i]), (PG8_LAS unsigned*)(lds + (bufoff) + ldsw + _i * 8192), 16, 0, 0); } while (0)
#define PG8_LDA(dst, b, h) do { _Pragma("unroll") for (int m = 0; m < 4; ++m) _Pragma("unroll") for (int k = 0; k < 2; ++k) dst[m][k] = *(const PG8_LAS bf16x8*)(lds + PG8_SA(b, h) + aoff + m * 2048 + k * 1024); } while (0)
#define PG8_LDB(dst, b, h) do { _Pragma("unroll") for (int n = 0; n < 2; ++n) _Pragma("unroll") for (int k = 0; k < 2; ++k) dst[n][k] = *(const PG8_LAS bf16x8*)(lds + PG8_SB(b, h) + boff + n * 2048 + k * 1024); } while (0)
#define PG8_MMA(ai, bj, At, Bt) do { __builtin_amdgcn_s_setprio(1); _Pragma("unroll") for (int m = 0; m < 4; ++m) _Pragma("unroll") for (int n = 0; n < 2; ++n) _Pragma("unroll") for (int k = 0; k < 2; ++k) \
        acc[ai][bj][m][n] = __builtin_amdgcn_mfma_f32_16x16x32_bf16(Bt[n][k], At[m][k], acc[ai][bj][m][n], 0, 0, 0); __builtin_amdgcn_s_setprio(0); } while (0)
#define PG8_WAIT_V(n) asm volatile("s_waitcnt vmcnt(" #n ")" ::: "memory")
#define PG8_WAIT_L(n) asm volatile("s_waitcnt lgkmcnt(" #n ")" ::: "memory")
#define PG8_BAR __builtin_amdgcn_s_barrier()
#define PG8_SCHED __builtin_amdgcn_sched_barrier(0)
    Unit cur, nxt; int ui = 0;
    if (!S.next(0, cur)) return;
    f32x4 acc[2][2][4][2];
#pragma unroll
    for (int a = 0; a < 2; ++a)
#pragma unroll
        for (int b = 0; b < 2; ++b)
#pragma unroll
            for (int m = 0; m < 4; ++m)
#pragma unroll
                for (int n = 0; n < 2; ++n) acc[a][b][m][n] = (f32x4){0.f, 0.f, 0.f, 0.f};
    bf16x8 At[4][2], B0[2][2], B1[2][2];
    const char* cA = (const char*)g.A + (size_t)cur.pm * tstep; const char* cB = (const char*)g.Bt + (size_t)cur.pn * tstep;
    S.a_ready(cur);
    if constexpr (SP2) {
        PG8_STAGE(PG8_SB(0, 0), cB, voffB); PG8_STAGE(PG8_SB(0, 1), cB + hstep, voffB); PG8_STAGE(PG8_SA(0, 0), cA, voffA); PG8_STAGE(PG8_SA(0, 1), cA + hstep, voffA);
        if (wr == 1) PG8_BAR;
        PG8_WAIT_V(2); PG8_BAR;
        PG8_STAGE(PG8_SB(1, 0), cB + kstep, voffB); PG8_STAGE(PG8_SA(1, 0), cA + kstep, voffA); PG8_STAGE(PG8_SB(1, 1), cB + hstep + kstep, voffB);
        PG8_WAIT_V(6); PG8_BAR;
    } else {
        PG8_STAGE(PG8_SB(0, 0), cB, voffB); PG8_STAGE(PG8_SA(0, 0), cA, voffA); PG8_STAGE(PG8_SB(0, 1), cB + hstep, voffB); PG8_STAGE(PG8_SA(0, 1), cA + hstep, voffA);
        if (wr == 1) PG8_BAR;
        PG8_WAIT_V(4); PG8_BAR;
        PG8_STAGE(PG8_SB(1, 0), cB + kstep, voffB); PG8_STAGE(PG8_SA(1, 0), cA + kstep, voffA); PG8_STAGE(PG8_SB(1, 1), cB + hstep + kstep, voffB);
        PG8_WAIT_V(6); PG8_BAR;
    }
    for (;;) {
        const bool has_next = S.next(ui + 1, nxt);
        const char* nA = has_next ? (const char*)g.A + (size_t)nxt.pm * tstep : cA; const char* nB = has_next ? (const char*)g.Bt + (size_t)nxt.pn * tstep : cB;
        for (int t = 0; t < nt; t += 2) {
            if constexpr (Epi::MID) { if (t == (nt >> 1)) {
                __builtin_amdgcn_sched_barrier(0); asm volatile("s_nop 7\n\ts_nop 7" ::: "memory"); __builtin_amdgcn_sched_barrier(0);
                E.mid(acc, cur, wr, wc, fr, fq);
                __builtin_amdgcn_sched_barrier(0); asm volatile("s_nop 7" ::: "memory"); __builtin_amdgcn_sched_barrier(0); } }
            const bool last = (t == nt - 2);
            const char* a1 = cA + (size_t)(t + 1) * kstep;
            const char* a2 = last ? nA : cA + (size_t)(t + 2) * kstep; const char* b2 = last ? nB : cB + (size_t)(t + 2) * kstep;
            const char* a3 = a2 + kstep; const char* b3 = b2 + kstep;
            if (last && has_next) S.a_ready(nxt);
            if constexpr (SP2) {
            PG8_LDB(B0, 0, 0); PG8_LDB(B1, 0, 1); PG8_SCHED; PG8_LDA(At, 0, 0); PG8_STAGE(PG8_SA(1, 1), a1 + hstep, voffA);
            PG8_WAIT_V(8); PG8_WAIT_L(0); PG8_BAR; PG8_MMA(0, 0, At, B0); PG8_MMA(0, 1, At, B1); PG8_BAR; PG8_SCHED;
            PG8_LDA(At, 0, 1); PG8_STAGE(PG8_SB(0, 0), b2, voffB); PG8_STAGE(PG8_SB(0, 1), b2 + hstep, voffB); PG8_STAGE(PG8_SA(0, 0), a2, voffA);
            PG8_WAIT_V(8); PG8_WAIT_L(0); PG8_BAR; PG8_MMA(1, 0, At, B0); PG8_MMA(1, 1, At, B1); PG8_BAR; PG8_SCHED;
            PG8_LDB(B0, 1, 0); PG8_LDB(B1, 1, 1); PG8_SCHED; PG8_LDA(At, 1, 0); PG8_STAGE(PG8_SA(0, 1), a2 + hstep, voffA);
            PG8_WAIT_V(8); PG8_WAIT_L(0); PG8_BAR; PG8_MMA(0, 0, At, B0); PG8_MMA(0, 1, At, B1); PG8_BAR; PG8_SCHED;
            PG8_LDA(At, 1, 1); PG8_STAGE(PG8_SB(1, 0), b3, voffB); PG8_STAGE(PG8_SB(1, 1), b3 + hstep, voffB); PG8_STAGE(PG8_SA(1, 0), a3, voffA);
            PG8_WAIT_V(8); PG8_WAIT_L(0); PG8_BAR; PG8_MMA(1, 0, At, B0); PG8_MMA(1, 1, At, B1); PG8_BAR; PG8_SCHED;
            } else {
            PG8_LDB(B0, 0, 0); PG8_SCHED; PG8_LDA(At, 0, 0); PG8_STAGE(PG8_SA(1, 1), a1 + hstep, voffA);
            PG8_WAIT_L(8); PG8_BAR; PG8_WAIT_L(0); PG8_MMA(0, 0, At, B0); PG8_BAR; PG8_SCHED;
            PG8_LDB(B1, 0, 1); PG8_STAGE(PG8_SB(0, 0), b2, voffB);
            PG8_BAR; PG8_WAIT_L(0); PG8_MMA(0, 1, At, B1); PG8_BAR;
            PG8_LDA(At, 0, 1); PG8_STAGE(PG8_SA(0, 0), a2, voffA);
            PG8_BAR; PG8_WAIT_L(0); PG8_MMA(1, 0, At, B0); PG8_BAR; PG8_SCHED;
            PG8_STAGE(PG8_SB(0, 1), b2 + hstep, voffB);
            PG8_WAIT_V(6); PG8_BAR; PG8_MMA(1, 1, At, B1); PG8_BAR;
            PG8_LDB(B0, 1, 0); PG8_SCHED; PG8_LDA(At, 1, 0); PG8_STAGE(PG8_SA(0, 1), a2 + hstep, voffA);
            PG8_WAIT_L(8); PG8_BAR; PG8_WAIT_L(0); PG8_MMA(0, 0, At, B0); PG8_BAR; PG8_SCHED;
            PG8_LDB(B1, 1, 1); PG8_STAGE(PG8_SB(1, 0), b3, voffB);
            PG8_BAR; PG8_WAIT_L(0); PG8_MMA(0, 1, At, B1); PG8_BAR;
            PG8_LDA(At, 1, 1); PG8_STAGE(PG8_SA(1, 0), a3, voffA);
            PG8_BAR; PG8_WAIT_L(0); PG8_MMA(1, 0, At, B0); PG8_BAR; PG8_SCHED;
            PG8_STAGE(PG8_SB(1, 1), b3 + hstep, voffB);
            PG8_WAIT_V(6); PG8_BAR; PG8_MMA(1, 1, At, B1); PG8_BAR;
            }
        }
        if constexpr (ALIGN_EPI) { if (wr == 0) PG8_BAR; }
        __builtin_amdgcn_sched_barrier(0); asm volatile("s_nop 7\n\ts_nop 7" ::: "memory"); __builtin_amdgcn_sched_barrier(0);
        if constexpr (!Epi::AFTER_DRAIN) { E(acc, cur, wr, wc, fr, fq); S.done(cur); }
        if (!has_next) break;
#pragma unroll
        for (int a = 0; a < 2; ++a)
#pragma unroll
            for (int b = 0; b < 2; ++b)
#pragma unroll
                for (int m = 0; m < 4; ++m)
#pragma unroll
                    for (int n = 0; n < 2; ++n) acc[a][b][m][n] = (f32x4){0.f, 0.f, 0.f, 0.f};
        cur = nxt; cA = nA; cB = nB; ++ui;
        if constexpr (ALIGN_EPI) { if (wr == 1) PG8_BAR; }
    }
    PG8_WAIT_V(0);
    if constexpr (!ALIGN_EPI) { if (wr == 0) PG8_BAR; }
    PG8_BAR;
    if constexpr (Epi::AFTER_DRAIN) { E.fused(acc, cur, wr, wc, fr, fq, lds, wid, lane); S.done(cur); }
#undef PG8_SA
#undef PG8_SB
#undef PG8_STAGE
#undef PG8_LDA
#undef PG8_LDB
#undef PG8_MMA
#undef PG8_WAIT_V
#undef PG8_WAIT_L
#undef PG8_BAR
#undef PG8_SCHED
}
}

#ifndef PG8_SP2
#define PG8_SP2 true
#endif
#ifndef PG8_ALIGN
#define PG8_ALIGN true
#endif
namespace pg8 {
typedef unsigned u32x2 __attribute__((ext_vector_type(2)));
__device__ __forceinline__ float bfl(unsigned w) { return __uint_as_float(w << 16); }
__device__ __forceinline__ float bfh(unsigned w) { return __uint_as_float(w & 0xffff0000u); }
__device__ __forceinline__ float sigm(float x) { return __builtin_amdgcn_rcpf(1.0f + __expf(-x)); }
struct EpiStore {
    static constexpr bool PERM = true, AFTER_DRAIN = false, MID = false;
    bf16_t* O; int ldc; int nvalid; int split_cols; bf16_t* O2;
    __device__ __forceinline__ void operator()(const f32x4 (&acc)[2][2][4][2], const Unit& u, int wr, int wc, int fr, int fq) const {
        const int row0 = u.pm * BM + wr * 64 + fr; int colt = u.pn * BM; bf16_t* base = O;
        if (split_cols && colt >= split_cols) { base = O2; colt -= split_cols; }
        const int col0 = colt + wc * 32 + 8 * fq;
#pragma unroll
        for (int ai = 0; ai < 2; ++ai)
#pragma unroll
            for (int m = 0; m < 4; ++m) { bf16_t* rowp = base + (size_t)(row0 + ai * HALF + m * 16) * ldc + col0;
#pragma unroll
                for (int bj = 0; bj < 2; ++bj) { const f32x4 v0 = acc[ai][bj][m][0], v1 = acc[ai][bj][m][1];
                    u32x4 w; w.x = cvt_pk_bf16(v0[0], v0[1]); w.y = cvt_pk_bf16(v0[2], v0[3]); w.z = cvt_pk_bf16(v1[0], v1[1]); w.w = cvt_pk_bf16(v1[2], v1[3]);
                    if (col0 + bj * HALF + 8 <= nvalid) *(u32x4*)(rowp + bj * HALF) = w; } }
    }
};
template <int MODE> struct EpiGate {
    static constexpr bool PERM = true, AFTER_DRAIN = false, MID = false;
    const bf16_t* G; bf16_t* O; int ldc;
    __device__ __forceinline__ void operator()(const f32x4 (&acc)[2][2][4][2], const Unit& u, int wr, int wc, int fr, int fq) const {
        const int row0 = u.pm * BM + wr * 64 + fr; const int col0 = u.pn * BM + wc * 32 + 8 * fq;
#pragma unroll
        for (int ai = 0; ai < 2; ++ai)
#pragma unroll
            for (int m = 0; m < 4; ++m) { const size_t off = (size_t)(row0 + ai * HALF + m * 16) * ldc + col0;
#pragma unroll
                for (int bj = 0; bj < 2; ++bj) { const f32x4 v0 = acc[ai][bj][m][0], v1 = acc[ai][bj][m][1];
                    const u32x4 g = *(const u32x4*)(G + off + bj * HALF);
                    float r0 = sigm(bfl(g.x)) * v0[0], r1 = sigm(bfh(g.x)) * v0[1], r2 = sigm(bfl(g.y)) * v0[2], r3 = sigm(bfh(g.y)) * v0[3];
                    float r4 = sigm(bfl(g.z)) * v1[0], r5 = sigm(bfh(g.z)) * v1[1], r6 = sigm(bfl(g.w)) * v1[2], r7 = sigm(bfh(g.w)) * v1[3];
                    if (MODE == 1) { const u32x4 p = *(const u32x4*)(O + off + bj * HALF);
                        r0 += bfl(p.x); r1 += bfh(p.x); r2 += bfl(p.y); r3 += bfh(p.y); r4 += bfl(p.z); r5 += bfh(p.z); r6 += bfl(p.w); r7 += bfh(p.w); }
                    u32x4 w; w.x = cvt_pk_bf16(r0, r1); w.y = cvt_pk_bf16(r2, r3); w.z = cvt_pk_bf16(r4, r5); w.w = cvt_pk_bf16(r6, r7);
                    *(u32x4*)(O + off + bj * HALF) = w; } }
    }
};
struct EpiMerge {
    static constexpr bool PERM = true, AFTER_DRAIN = false, MID = true;
    const bf16_t* GA; const bf16_t* GB; bf16_t* O; int ldc;
    template <bool DIV> __device__ __forceinline__ void scale_pass(f32x4 (&acc)[2][2][4][2], const bf16_t* G, const Unit& u, int wr, int wc, int fr, int fq) const {
        const int row0 = u.pm * BM + wr * 64 + fr; const int col0 = u.pn * BM + wc * 32 + 8 * fq;
#pragma unroll
        for (int ai = 0; ai < 2; ++ai)
#pragma unroll
            for (int m = 0; m < 4; ++m) { const size_t off = (size_t)(row0 + ai * HALF + m * 16) * ldc + col0;
#pragma unroll
                for (int bj = 0; bj < 2; ++bj) { const u32x4 g = *(const u32x4*)(G + off + bj * HALF);
                    f32x4 r0, r1;
                    r0[0] = 1.f + __expf(-bfl(g.x)); r0[1] = 1.f + __expf(-bfh(g.x)); r0[2] = 1.f + __expf(-bfl(g.y)); r0[3] = 1.f + __expf(-bfh(g.y));
                    r1[0] = 1.f + __expf(-bfl(g.z)); r1[1] = 1.f + __expf(-bfh(g.z)); r1[2] = 1.f + __expf(-bfl(g.w)); r1[3] = 1.f + __expf(-bfh(g.w));
                    if (DIV) {
#pragma unroll
                        for (int i = 0; i < 4; ++i) { r0[i] = __builtin_amdgcn_rcpf(r0[i]); r1[i] = __builtin_amdgcn_rcpf(r1[i]); } }
                    acc[ai][bj][m][0] = acc[ai][bj][m][0] * r0; acc[ai][bj][m][1] = acc[ai][bj][m][1] * r1;
                    asm volatile("" ::: "memory"); } }
    }
    __device__ __forceinline__ void mid(f32x4 (&acc)[2][2][4][2], const Unit& u, int wr, int wc, int fr, int fq) const {
        scale_pass<false>(acc, GB, u, wr, wc, fr, fq); scale_pass<true>(acc, GA, u, wr, wc, fr, fq);
    }
    __device__ __forceinline__ void operator()(const f32x4 (&acc)[2][2][4][2], const Unit& u, int wr, int wc, int fr, int fq) const {
        const int row0 = u.pm * BM + wr * 64 + fr; const int col0 = u.pn * BM + wc * 32 + 8 * fq;
#pragma unroll
        for (int ai = 0; ai < 2; ++ai)
#pragma unroll
            for (int m = 0; m < 4; ++m) { const size_t off = (size_t)(row0 + ai * HALF + m * 16) * ldc + col0;
#pragma unroll
                for (int bj = 0; bj < 2; ++bj) { const f32x4 v0 = acc[ai][bj][m][0], v1 = acc[ai][bj][m][1];
                    const u32x4 g = *(const u32x4*)(GB + off + bj * HALF);
                    u32x4 w; w.x = cvt_pk_bf16(sigm(bfl(g.x)) * v0[0], sigm(bfh(g.x)) * v0[1]); w.y = cvt_pk_bf16(sigm(bfl(g.y)) * v0[2], sigm(bfh(g.y)) * v0[3]);
                    w.z = cvt_pk_bf16(sigm(bfl(g.z)) * v1[0], sigm(bfh(g.z)) * v1[1]); w.w = cvt_pk_bf16(sigm(bfl(g.w)) * v1[2], sigm(bfh(g.w)) * v1[3]);
                    *(u32x4*)(O + off + bj * HALF) = w; } }
    }
};
struct EpiRes {
    static constexpr bool PERM = false, AFTER_DRAIN = false, MID = false;
    const float* base; float* out; int ldc;
    __device__ __forceinline__ void operator()(const f32x4 (&acc)[2][2][4][2], const Unit& u, int wr, int wc, int fr, int fq) const {
        const int row0 = u.pm * BM + wr * 64 + fr; const int col0 = u.pn * BM + wc * 32 + 4 * fq;
#pragma unroll
        for (int ai = 0; ai < 2; ++ai)
#pragma unroll
            for (int m = 0; m < 4; ++m) { const size_t off = (size_t)(row0 + ai * HALF + m * 16) * ldc + col0;
#pragma unroll
                for (int bj = 0; bj < 2; ++bj)
#pragma unroll
                    for (int n = 0; n < 2; ++n) { const f32x4 b = *(const f32x4*)(base + off + bj * HALF + n * 16); *(f32x4*)(out + off + bj * HALF + n * 16) = b + acc[ai][bj][m][n]; } }
    }
};

struct EpiResBf16 {
    static constexpr bool PERM = false, AFTER_DRAIN = false, MID = false;
    const float* base; bf16_t* out; int ldc;
    __device__ __forceinline__ void operator()(const f32x4 (&acc)[2][2][4][2], const Unit& u, int wr, int wc, int fr, int fq) const {
        const int row0 = u.pm * BM + wr * 64 + fr; const int col0 = u.pn * BM + wc * 32 + 4 * fq;
#pragma unroll
        for (int ai = 0; ai < 2; ++ai)
#pragma unroll
            for (int m = 0; m < 4; ++m) { const size_t off = (size_t)(row0 + ai * HALF + m * 16) * ldc + col0;
#pragma unroll
                for (int bj = 0; bj < 2; ++bj)
#pragma unroll
                    for (int n = 0; n < 2; ++n) { const f32x4 x = *(const f32x4*)(base + off + bj * HALF + n * 16) + acc[ai][bj][m][n];
                        u32x2 w; w.x = cvt_pk_bf16(x[0], x[1]); w.y = cvt_pk_bf16(x[2], x[3]); *(u32x2*)(out + off + bj * HALF + n * 16) = w; } }
    }
};
struct EpiResNorm {
    static constexpr bool PERM = false, AFTER_DRAIN = false, MID = false;
    const float* base; float* out; bf16_t* H; const float* g; float* SS; int ldc;
    __device__ __forceinline__ void operator()(const f32x4 (&acc)[2][2][4][2], const Unit& u, int wr, int wc, int fr, int fq) const {
        const int row0 = u.pm * BM + wr * 64 + fr; const int col0 = u.pn * BM + wc * 32 + 4 * fq;
#pragma unroll
        for (int ai = 0; ai < 2; ++ai)
#pragma unroll
            for (int m = 0; m < 4; ++m) { const int row = row0 + ai * HALF + m * 16; const size_t off = (size_t)row * ldc + col0; float ss = 0.f;
#pragma unroll
                for (int bj = 0; bj < 2; ++bj)
#pragma unroll
                    for (int n = 0; n < 2; ++n) { const f32x4 x1 = *(const f32x4*)(base + off + bj * HALF + n * 16) + acc[ai][bj][m][n]; *(f32x4*)(out + off + bj * HALF + n * 16) = x1;
                        ss += (x1[0] * x1[0] + x1[1] * x1[1]) + (x1[2] * x1[2] + x1[3] * x1[3]);
                        const f32x4 hh = x1 * *(const f32x4*)(g + col0 + bj * HALF + n * 16);
                        u32x2 w; w.x = cvt_pk_bf16(hh[0], hh[1]); w.y = cvt_pk_bf16(hh[2], hh[3]); *(u32x2*)(H + off + bj * HALF + n * 16) = w; }
                ss += __shfl_xor(ss, 16); ss += __shfl_xor(ss, 32);
                if (fq == 0) (void)__hip_atomic_fetch_add(SS + row, ss, __ATOMIC_RELAXED, __HIP_MEMORY_SCOPE_AGENT); }
    }
};
__device__ __forceinline__ f32x4 dpp_shr1(f32x4 v) { f32x4 r;
#pragma unroll
    for (int i = 0; i < 4; ++i) { const float t = v[i]; r[i] = __int_as_float(__builtin_amdgcn_update_dpp(0, __float_as_int(t), 0x111, 0xF, 0xF, true)); }
    return r; }
__device__ __forceinline__ f32x4 dpp_shl1(f32x4 v) { f32x4 r;
#pragma unroll
    for (int i = 0; i < 4; ++i) { const float t = v[i]; r[i] = __int_as_float(__builtin_amdgcn_update_dpp(0, __float_as_int(t), 0x101, 0xF, 0xF, true)); }
    return r; }
__device__ __forceinline__ f32x4 dpp_mirror(f32x4 v) { f32x4 r;
#pragma unroll
    for (int i = 0; i < 4; ++i) { const float t = v[i]; r[i] = __int_as_float(__builtin_amdgcn_update_dpp(0, __float_as_int(t), 0x140, 0xF, 0xF, true)); }
    return r; }
struct EpiConv {
    static constexpr bool PERM = true, AFTER_DRAIN = false, MID = false;
    bf16_t* ACT; float* SB; const float* cw; const float* cb; PG8_LAS float* xe; bf16_t* Udbg; const float* SS;
    __device__ __forceinline__ void operator()(const f32x4 (&acc)[2][2][4][2], const Unit& u, int wr, int wc, int fr, int fq) const {
        constexpr int FF = 2752, FFP = 2816, NSRC = 5504, NU = 5632;
        if (SS) {
            f32x4 (&sa)[2][2][4][2] = const_cast<f32x4 (&)[2][2][4][2]>(acc);
#pragma unroll
            for (int ai = 0; ai < 2; ++ai)
#pragma unroll
                for (int m = 0; m < 4; ++m) { const float q = __hip_atomic_load(SS + u.pm * BM + ai * HALF + wr * 64 + m * 16 + fr, __ATOMIC_RELAXED, __HIP_MEMORY_SCOPE_AGENT);
                    const float rs = 1.0f / sqrtf(q * (1.0f / 1024.0f) + 1e-6f);
#pragma unroll
                    for (int bj = 0; bj < 2; ++bj)
#pragma unroll
                        for (int n = 0; n < 2; ++n) sa[ai][bj][m][n] = sa[ai][bj][m][n] * rs; } }
#pragma unroll
        for (int ai = 0; ai < 2; ++ai) { const int slab = 2 * ai + wr;
#pragma unroll
            for (int bj = 0; bj < 2; ++bj)
#pragma unroll
                for (int n = 0; n < 2; ++n) {
                    if (fr == 0) *(PG8_LAS f32x4*)(xe + ((slab * 2 + 0) * 4 + wc) * 64 + bj * 32 + fq * 8 + n * 4) = acc[ai][bj][0][n];
                    if (fr == 15) *(PG8_LAS f32x4*)(xe + ((slab * 2 + 1) * 4 + wc) * 64 + bj * 32 + fq * 8 + n * 4) = acc[ai][bj][3][n]; } }
        if (Udbg && u.pm < 128) { const int row0 = u.pm * BM + wr * 64 + fr, col0 = u.pn * BM + wc * 32 + 8 * fq;
#pragma unroll
            for (int ai = 0; ai < 2; ++ai)
#pragma unroll
                for (int m = 0; m < 4; ++m)
#pragma unroll
                    for (int bj = 0; bj < 2; ++bj) { const f32x4 v0 = acc[ai][bj][m][0], v1 = acc[ai][bj][m][1]; u32x4 w; w.x = cvt_pk_bf16(v0[0], v0[1]); w.y = cvt_pk_bf16(v0[2], v0[3]); w.z = cvt_pk_bf16(v1[0], v1[1]); w.w = cvt_pk_bf16(v1[2], v1[3]);
                        *(u32x4*)(Udbg + (size_t)(row0 + ai * HALF + m * 16) * NU + col0 + bj * HALF) = w; } }
        { const int colb = u.pn * BM + wc * 32 + 8 * fq;
          if (wr == 0 && fr < 2) {
#pragma unroll
              for (int bj = 0; bj < 2; ++bj)
#pragma unroll
                  for (int n = 0; n < 2; ++n) *(f32x4*)(SB + (size_t)(u.pm * 4 + fr) * NU + colb + bj * HALF + 4 * n) = acc[0][bj][0][n]; }
          if (wr == 1 && fr >= 14) {
#pragma unroll
              for (int bj = 0; bj < 2; ++bj)
#pragma unroll
                  for (int n = 0; n < 2; ++n) *(f32x4*)(SB + (size_t)(u.pm * 4 + 2 + (fr - 14)) * NU + colb + bj * HALF + 4 * n) = acc[1][bj][3][n]; } }
        asm volatile("s_waitcnt lgkmcnt(0)" ::: "memory"); __builtin_amdgcn_s_barrier(); asm volatile("" ::: "memory");
        const int j0 = u.pn * 128 + wc * 32 + fq * 8;
        const f32x4 z4 = (f32x4){0.f, 0.f, 0.f, 0.f};
#pragma unroll
        for (int n = 0; n < 2; ++n) { const int jn = j0 + 4 * n; const bool valid = jn < FF;
            f32x4 wg0 = z4, wg1 = z4, wg2 = z4, wv0 = z4, wv1 = z4, wv2 = z4, bg = z4, bv = z4;
            if (valid) { wg0 = *(const f32x4*)(cw + jn); wg1 = *(const f32x4*)(cw + NSRC + jn); wg2 = *(const f32x4*)(cw + 2 * NSRC + jn);
                         wv0 = *(const f32x4*)(cw + FF + jn); wv1 = *(const f32x4*)(cw + NSRC + FF + jn); wv2 = *(const f32x4*)(cw + 2 * NSRC + FF + jn);
                         bg = *(const f32x4*)(cb + jn); bv = *(const f32x4*)(cb + FF + jn); }
#pragma unroll
            for (int ai = 0; ai < 2; ++ai) { const int slab = 2 * ai + wr;
                f32x4 topg = z4, topv = z4, botg = z4, botv = z4;
                if (slab > 0) { topg = *(const PG8_LAS f32x4*)(xe + (((slab - 1) * 2 + 1) * 4 + wc) * 64 + fq * 8 + n * 4); topv = *(const PG8_LAS f32x4*)(xe + (((slab - 1) * 2 + 1) * 4 + wc) * 64 + 32 + fq * 8 + n * 4); }
                if (slab < 3) { botg = *(const PG8_LAS f32x4*)(xe + (((slab + 1) * 2 + 0) * 4 + wc) * 64 + fq * 8 + n * 4); botv = *(const PG8_LAS f32x4*)(xe + (((slab + 1) * 2 + 0) * 4 + wc) * 64 + 32 + fq * 8 + n * 4); }
#pragma unroll
                for (int m = 0; m < 4; ++m) { const f32x4 eg = acc[ai][0][m][n], ev = acc[ai][1][m][n];
                    f32x4 upg = dpp_shr1(eg), upv = dpp_shr1(ev), dng = dpp_shl1(eg), dnv = dpp_shl1(ev);
                    const f32x4 ag = (m > 0) ? dpp_mirror(acc[ai][0][m > 0 ? m - 1 : 0][n]) : topg, av = (m > 0) ? dpp_mirror(acc[ai][1][m > 0 ? m - 1 : 0][n]) : topv;
                    const f32x4 cg2 = (m < 3) ? dpp_mirror(acc[ai][0][m < 3 ? m + 1 : 3][n]) : botg, cv2 = (m < 3) ? dpp_mirror(acc[ai][1][m < 3 ? m + 1 : 3][n]) : botv;
                    if (fr == 0) { upg = ag; upv = av; }
                    if (fr == 15) { dng = cg2; dnv = cv2; }
                    const f32x4 g = wg0 * upg + wg1 * eg + wg2 * dng + bg, v = wv0 * upv + wv1 * ev + wv2 * dnv + bv;
                    f32x4 o;
#pragma unroll
                    for (int i = 0; i < 4; ++i) o[i] = valid ? g[i] * sigm(g[i]) * v[i] : 0.f;
                    const int rt = ai * HALF + wr * 64 + m * 16 + fr;
                    if (rt != 0 && rt != 255) { u32x2 w; w.x = cvt_pk_bf16(o[0], o[1]); w.y = cvt_pk_bf16(o[2], o[3]); *(u32x2*)(ACT + (size_t)(u.pm * BM + rt) * FFP + jn) = w; } } }
        }
    }
};
}

constexpr int NB = 32, T = 2048, D = 1024, M = NB * T, MH = M / 2;
constexpr int NMIX = 3360, NMIXP = 3584, NGATE = 2048;
constexpr int DFF = 2752, DFFP = 2816, NUP = 5632, NUPSRC = 5504, NPROJ = 5408;
constexpr int C_GQ = 0, C_GK = 256, C_GV = 512, C_GOG = 1024, C_GAF = 1536, C_GAB = 1552, C_R0 = 1568;
constexpr size_t MiB = 1u << 20;
constexpr size_t WS_WMIX = 1 * MiB, WS_WGATE = 8 * MiB, WS_WGP = 12 * MiB, WS_WRP = 13 * MiB, WS_WOUT = 14 * MiB, WS_WUP = 16 * MiB, WS_WDN = 27 * MiB;
constexpr size_t WS_LW2F = 33 * MiB, WS_LW2B = WS_LW2F + 65536, WS_LA2 = WS_LW2B + 65536, WS_LG2 = WS_LA2 + 65536;
constexpr size_t WS_HB = 36 * MiB, WS_PM = 164 * MiB, WS_GO = 584 * MiB, WS_O = 712 * MiB, WS_E = 840 * MiB, WS_BON = 968 * MiB, WS_END = 970 * MiB;
constexpr size_t WS_H2 = 256 * MiB;
constexpr size_t WS_U = WS_PM, WS_SB = WS_PM, WS_ACT = 516 * MiB, WS_X2 = 36 * MiB;
static_assert(WS_WDN + (size_t)D * DFFP * 2 <= WS_LW2F && WS_LG2 + 131072 <= WS_HB, "weights map");
static_assert(WS_PM + (size_t)M * NMIX * 2 <= WS_GO && WS_U + (size_t)MH * NUP * 2 <= WS_ACT && WS_ACT + (size_t)M * DFFP * 2 <= 1024 * MiB, "ws map");
constexpr int LDS_BYTES = 147456;

#define LAS __attribute__((address_space(3)))
#define DI __device__ __forceinline__
typedef unsigned short bf16;
typedef float f32x4 __attribute__((ext_vector_type(4)));
typedef float f32x2 __attribute__((ext_vector_type(2)));
typedef short bf16x8 __attribute__((ext_vector_type(8)));
typedef unsigned u32x4 __attribute__((ext_vector_type(4)));
typedef unsigned u32x2 __attribute__((ext_vector_type(2)));
typedef _Float16 h16x2 __attribute__((ext_vector_type(2)));
#define LDS_WAIT() asm volatile("s_waitcnt lgkmcnt(0)" ::: "memory")
#define LDS_BARRIER() do { asm volatile("s_waitcnt lgkmcnt(0)" ::: "memory"); __builtin_amdgcn_s_barrier(); asm volatile("" ::: "memory"); } while (0)
#define MFMA16(a, b, c) __builtin_amdgcn_mfma_f32_16x16x32_bf16((a), (b), (c), 0, 0, 0)
#define MFMA_GUARD(v) asm volatile("s_nop 7\n\ts_nop 7" : "+v"(v))

struct Params {
    const float* in[31]; float* out; unsigned char* ws;
};
enum { I_X = 0, I_N1G, I_WIN, I_GWA2F, I_GBAF, I_GWA2B, I_GBAB, I_GNG, I_GPROJ, I_MUP, I_MUN, I_W0F, I_W2F, I_W0B, I_W2B, I_A0, I_A2, I_G2, I_KK, I_KA, I_RK, I_LNW, I_LNB, I_RPROJ,
       I_WOUT, I_N2G, I_FUP, I_FCW, I_FCB, I_FDN, I_NFG };

DI float bfl(unsigned w) { return __uint_as_float(w << 16); }
DI float bfh(unsigned w) { return __uint_as_float(w & 0xffff0000u); }
DI unsigned f2bf(float f) { unsigned u = __float_as_uint(f); return (u + 0x7fffu + ((u >> 16) & 1u)) >> 16; }
typedef __bf16 bf16x2_t __attribute__((ext_vector_type(2)));
DI unsigned pk2(float lo, float hi) { const f32x2 v = {lo, hi}; const bf16x2_t b = __builtin_convertvector(v, bf16x2_t); return __builtin_bit_cast(unsigned, b); }
DI float sigm(float x) { return __builtin_amdgcn_rcpf(1.0f + __expf(-x)); }
DI unsigned pkh2(float lo, float hi) { h16x2 v; v.x = (_Float16)lo; v.y = (_Float16)hi; return __builtin_bit_cast(unsigned, v); }
DI float hlo(unsigned w) { h16x2 v = __builtin_bit_cast(h16x2, w); return (float)v.x; }
DI float hhi(unsigned w) { h16x2 v = __builtin_bit_cast(h16x2, w); return (float)v.y; }
DI float wave_sum(float v) {
#pragma unroll
    for (int o = 1; o < 64; o <<= 1) v += __shfl_xor(v, o);
    return v;
}
DI float quad_sum(float x) {
    x += __builtin_bit_cast(float, __builtin_amdgcn_update_dpp(0, __builtin_bit_cast(int, x), 0xB1, 0xF, 0xF, true));
    x += __builtin_bit_cast(float, __builtin_amdgcn_update_dpp(0, __builtin_bit_cast(int, x), 0x4E, 0xF, 0xF, true));
    return x;
}
DI float oct_sum(float x) {
    x = quad_sum(x);
    x += __builtin_bit_cast(float, __builtin_amdgcn_update_dpp(0, __builtin_bit_cast(int, x), 0x141, 0xF, 0xF, true));
    return x;
}
struct F8 { f32x4 a, b; };
DI F8 unpack8(u32x4 w) { F8 r; r.a = (f32x4){bfl(w.x), bfh(w.x), bfl(w.y), bfh(w.y)}; r.b = (f32x4){bfl(w.z), bfh(w.z), bfl(w.w), bfh(w.w)}; return r; }
DI u32x4 pack8(f32x4 a, f32x4 b) { u32x4 w; w.x = pk2(a[0], a[1]); w.y = pk2(a[2], a[3]); w.z = pk2(b[0], b[1]); w.w = pk2(b[2], b[3]); return w; }
DI f32x4 unpack4(u32x2 w) { return (f32x4){bfl(w.x), bfh(w.x), bfl(w.y), bfh(w.y)}; }
DI u32x2 pack4(f32x4 a) { u32x2 w; w.x = pk2(a[0], a[1]); w.y = pk2(a[2], a[3]); return w; }

DI void tr_item(const float* W, int ldw, int k0, int c0, bf16* WT, int ldt, int n0, LAS float* scr, int lane) {
    const int c = lane & 7;
    if (c0 < 0) {
#pragma unroll
        for (int j = 0; j < 4; ++j) { const int n = (lane >> 3) + 8 * j; *(u32x4*)(WT + (size_t)(n0 + n) * ldt + k0 + 8 * c) = (u32x4){0u, 0u, 0u, 0u}; }
        return;
    }
#pragma unroll 8
    for (int i = 0; i < 32; ++i) { const int kk = 2 * i + (lane >> 5); scr[kk * 33 + (lane & 31)] = W[(size_t)(k0 + kk) * ldw + c0 + (lane & 31)]; }
    LDS_WAIT();
#pragma unroll
    for (int j = 0; j < 4; ++j) { const int n = (lane >> 3) + 8 * j; const LAS float* s = scr + (8 * c) * 33 + n;
        u32x4 o; o.x = pk2(s[0 * 33], s[1 * 33]); o.y = pk2(s[2 * 33], s[3 * 33]); o.z = pk2(s[4 * 33], s[5 * 33]); o.w = pk2(s[6 * 33], s[7 * 33]);
        *(u32x4*)(WT + (size_t)(n0 + n) * ldt + k0 + 8 * c) = o; }
    LDS_WAIT();
}
DI void rms_row_bf16(const float* xrow, const float* g, bf16* orow, int lane) {
    const f32x4* xr = (const f32x4*)xrow + lane;
    f32x4 v[4]; float s = 0.f;
#pragma unroll
    for (int j = 0; j < 4; ++j) { v[j] = xr[64 * j]; s += (v[j].x * v[j].x + v[j].y * v[j].y) + (v[j].z * v[j].z + v[j].w * v[j].w); }
    const float rstd = 1.0f / sqrtf(wave_sum(s) * (1.f / D) + 1e-6f);
    u32x2* o8 = (u32x2*)orow + lane;
#pragma unroll
    for (int j = 0; j < 4; ++j) { const f32x4 gg = ((const f32x4*)g)[lane + 64 * j]; o8[64 * j] = pack4(v[j] * rstd * gg); }
}
DI void rms_rows2_f32(const unsigned char* src, float* dst, int m0, int m1, const float* g, int lane) {
    const f32x4* xa = (const f32x4*)(src + (size_t)m0 * D * 4) + lane; const f32x4* xb = (const f32x4*)(src + (size_t)m1 * D * 4) + lane;
    f32x4 va[4], vb[4]; float sa = 0.f, sb = 0.f;
#pragma unroll
    for (int j = 0; j < 4; ++j) { va[j] = xa[64 * j]; vb[j] = xb[64 * j]; }
#pragma unroll
    for (int j = 0; j < 4; ++j) { sa += (va[j].x * va[j].x + va[j].y * va[j].y) + (va[j].z * va[j].z + va[j].w * va[j].w); sb += (vb[j].x * vb[j].x + vb[j].y * vb[j].y) + (vb[j].z * vb[j].z + vb[j].w * vb[j].w); }
#pragma unroll
    for (int o = 1; o < 64; o <<= 1) { sa += __shfl_xor(sa, o); sb += __shfl_xor(sb, o); }
    const float ra = 1.0f / sqrtf(sa * (1.f / D) + 1e-6f), rb = 1.0f / sqrtf(sb * (1.f / D) + 1e-6f);
    f32x4* oa = (f32x4*)(dst + (size_t)m0 * D) + lane; f32x4* ob = (f32x4*)(dst + (size_t)m1 * D) + lane;
#pragma unroll
    for (int j = 0; j < 4; ++j) { const f32x4 gg = ((const f32x4*)g)[lane + 64 * j]; oa[64 * j] = va[j] * ra * gg; ob[64 * j] = vb[j] * rb * gg; }
}
DI void rms_rows2_bf16(const float* src, const float* g, bf16* dst, int m0, int m1, int lane) {
    const f32x4* xa = (const f32x4*)(src + (size_t)m0 * D) + lane; const f32x4* xb = (const f32x4*)(src + (size_t)m1 * D) + lane;
    f32x4 va[4], vb[4]; float sa = 0.f, sb = 0.f;
#pragma unroll
    for (int j = 0; j < 4; ++j) { va[j] = xa[64 * j]; vb[j] = xb[64 * j]; }
#pragma unroll
    for (int j = 0; j < 4; ++j) { sa += (va[j].x * va[j].x + va[j].y * va[j].y) + (va[j].z * va[j].z + va[j].w * va[j].w); sb += (vb[j].x * vb[j].x + vb[j].y * vb[j].y) + (vb[j].z * vb[j].z + vb[j].w * vb[j].w); }
#pragma unroll
    for (int o = 1; o < 64; o <<= 1) { sa += __shfl_xor(sa, o); sb += __shfl_xor(sb, o); }
    const float ra = 1.0f / sqrtf(sa * (1.f / D) + 1e-6f), rb = 1.0f / sqrtf(sb * (1.f / D) + 1e-6f);
    u32x2* oa = (u32x2*)(dst + (size_t)m0 * D) + lane; u32x2* ob = (u32x2*)(dst + (size_t)m1 * D) + lane;
#pragma unroll
    for (int j = 0; j < 4; ++j) { const f32x4 gg = ((const f32x4*)g)[lane + 64 * j]; oa[64 * j] = pack4(va[j] * ra * gg); ob[64 * j] = pack4(vb[j] * rb * gg); }
}

DI void p0_prologue(const Params& P, LAS unsigned char* lds) {
    const int tid = threadIdx.x, lane = tid & 63, wv = tid >> 6;
    LAS float* scr = (LAS float*)(lds + wv * 16384);
    const int gw = blockIdx.x * 8 + wv, NGW = gridDim.x * 8;
    unsigned char* ws = P.ws;
    constexpr int I0 = 16 * (NMIXP / 32), I1 = 16 * (NGATE / 32), I2 = 8 * 32, I3 = 8 * 32, I4 = 16 * 32, I5 = 16 * (NUP / 32), I6 = 44 * 32, I7 = 16, I8 = 16, I9 = 16, I10 = 32;
    constexpr int NIT = I0 + I1 + I2 + I3 + I4 + I5 + I6 + I7 + I8 + I9 + I10;
    for (int it = gw; it < NIT; it += NGW) {
        int r = it;
        if (r < I0) { const int nb = r % (NMIXP / 32), kb = r / (NMIXP / 32); tr_item(P.in[I_WIN], NPROJ, 64 * kb, 32 * nb < NMIX ? 32 * nb : -1, (bf16*)(ws + WS_WMIX), D, 32 * nb, scr, lane); continue; } r -= I0;
        if (r < I1) { const int nb = r % (NGATE / 32), kb = r / (NGATE / 32); tr_item(P.in[I_WIN], NPROJ, 64 * kb, NMIX + 32 * nb, (bf16*)(ws + WS_WGATE), D, 32 * nb, scr, lane); continue; } r -= I1;
        if (r < I2) { const int nb = r % 32, kb = r / 32; tr_item(P.in[I_GPROJ], D, 64 * kb, 32 * nb, (bf16*)(ws + WS_WGP), 512, 32 * nb, scr, lane); continue; } r -= I2;
        if (r < I3) { const int nb = r % 32, kb = r / 32; tr_item(P.in[I_RPROJ], D, 64 * kb, 32 * nb, (bf16*)(ws + WS_WRP), 512, 32 * nb, scr, lane); continue; } r -= I3;
        if (r < I4) { const int nb = r % 32, kb = r / 32; tr_item(P.in[I_WOUT], D, 64 * kb, 32 * nb, (bf16*)(ws + WS_WOUT), D, 32 * nb, scr, lane); continue; } r -= I4;
        if (r < I5) { const int nb = r % (NUP / 32), kb = r / (NUP / 32); const int n = 32 * nb, j = n >> 8, i = n & 255, ff = 128 * j + (i & 127);
            tr_item(P.in[I_FUP], NUPSRC, 64 * kb, ff < DFF ? (i < 128 ? ff : DFF + ff) : -1, (bf16*)(ws + WS_WUP), D, n, scr, lane); continue; } r -= I5;
        if (r < I6) { const int nb = r % 32, kb = r / 32; tr_item(P.in[I_FDN], D, 64 * kb, kb < 43 ? 32 * nb : -1, (bf16*)(ws + WS_WDN), DFFP, 32 * nb, scr, lane); continue; } r -= I6;
        if (r < I7) { tr_item(P.in[I_W2F], 512, 0, 32 * r, (bf16*)(ws + WS_LW2F), 64, 32 * r, scr, lane); continue; } r -= I7;
        if (r < I8) { tr_item(P.in[I_W2B], 512, 0, 32 * r, (bf16*)(ws + WS_LW2B), 64, 32 * r, scr, lane); continue; } r -= I8;
        if (r < I9) { tr_item(P.in[I_A2], 512, 0, 32 * r, (bf16*)(ws + WS_LA2), 64, 32 * r, scr, lane); continue; } r -= I9;
        { const int nb = r % 16, kb = r / 16; tr_item(P.in[I_G2], 512, 64 * kb, 32 * nb, (bf16*)(ws + WS_LG2), 128, 32 * nb, scr, lane); }
    }
    bf16* HB = (bf16*)(ws + WS_HB);
    for (int m = gw; m < M; m += 2 * NGW) rms_rows2_bf16(P.in[I_X], P.in[I_N1G], HB, m, m + NGW, lane);
}
#define XB_TMO      128
#define XB_XCNT(j)  (256  + 64 * (j))
#define XB_XSUB(j)  (1280 + 64 * (j))
#define XB_XGEN(j)  (2304 + 64 * (j))
#define XB_TOP      3328
#define XB_TOPGEN   3392
#define XCD_BAR_WORDS 3456
#define XB_SPIN_CAP (1u << 18)

__device__ __forceinline__ unsigned xb_ld(unsigned* p)              { return __hip_atomic_load(p, __ATOMIC_RELAXED, __HIP_MEMORY_SCOPE_AGENT); }
__device__ __forceinline__ unsigned xb_add(unsigned* p, unsigned v) { return __hip_atomic_fetch_add(p, v, __ATOMIC_RELAXED, __HIP_MEMORY_SCOPE_AGENT); }
__device__ __forceinline__ unsigned xb_xcc_id() { return (unsigned)__builtin_amdgcn_s_getreg((3 << 11) | 20) & 0xFu; }
#define XB_SPIN(cond, bar) do { unsigned _sp = 0; while (cond) { __builtin_amdgcn_s_sleep(1); \
    if ((++_sp & 255u) == 0u) { if (xb_ld(&(bar)[XB_TMO])) break; if (_sp > XB_SPIN_CAP) { atomicAdd(&(bar)[XB_TMO], 1u); break; } } } } while (0)

struct XcdBarrier {
    unsigned* bar; unsigned x;
    volatile LAS unsigned* st;
};

__device__ __forceinline__ XcdBarrier xcd_barrier_post(unsigned* bar, volatile LAS unsigned* st) {
    XcdBarrier b; b.bar = bar; b.x = xb_xcc_id(); b.st = st;
    if (threadIdx.x == 0) (void)xb_add(&bar[XB_XCNT(b.x)], 1u);
    return b;
}
__device__ __forceinline__ void xcd_barrier_complete(unsigned* bar, unsigned x, unsigned& nloc, unsigned& nx) {
    const unsigned G = gridDim.x * gridDim.y * gridDim.z;
    unsigned sum, cnt, mine, sp = 0u;
    for (;;) {
        sum = 0u; cnt = 0u; mine = 0u;
#pragma unroll
        for (unsigned j = 0; j < 16; ++j) { const unsigned c = xb_ld(&bar[XB_XCNT(j)]); sum += c; cnt += (c > 0u) ? 1u : 0u; mine = (j == x) ? c : mine; }
        if (sum == G) break;
        __builtin_amdgcn_s_sleep(1);
        if ((++sp & 255u) == 0u) { if (xb_ld(&bar[XB_TMO])) break; if (sp > XB_SPIN_CAP) { atomicAdd(&bar[XB_TMO], 1u); break; } }
    }
    nloc = mine > 0u ? mine : 1u; nx = cnt > 0u ? cnt : 1u;
}

__device__ __forceinline__ void xcd_barrier(const XcdBarrier& b) {
    asm volatile("s_waitcnt vmcnt(0)" ::: "memory");
    __syncthreads();
    if (threadIdx.x == 0) {
        unsigned* bar = b.bar;
        __builtin_amdgcn_s_waitcnt(0);
        unsigned nloc = b.st[0], nx = b.st[1];
        if (nloc == 0u) { xcd_barrier_complete(bar, b.x, nloc, nx); b.st[0] = nloc; b.st[1] = nx; }
        const unsigned old = xb_add(&bar[XB_XSUB(b.x)], 1u);
        const unsigned gen = old / nloc;
        if (old + 1u == (gen + 1u) * nloc) {
            __builtin_amdgcn_fence(__ATOMIC_RELEASE, "agent");
            asm volatile("s_waitcnt vmcnt(0)" ::: "memory");
            const unsigned og = xb_add(&bar[XB_TOP], 1u);
            const unsigned tg = og / nx;
            if (og + 1u == (tg + 1u) * nx) xb_add(&bar[XB_TOPGEN], 1u);
            else XB_SPIN(xb_ld(&bar[XB_TOPGEN]) == tg, bar);
            __builtin_amdgcn_fence(__ATOMIC_ACQUIRE, "agent");
            xb_add(&bar[XB_XGEN(b.x)], 1u);
            asm volatile("s_waitcnt vmcnt(0)" ::: "memory");
        } else {
            XB_SPIN(xb_ld(&bar[XB_XGEN(b.x)]) == gen, bar);
            __builtin_amdgcn_fence(__ATOMIC_ACQUIRE, "agent");
            asm volatile("s_waitcnt vmcnt(0)" ::: "memory");
        }
    }
    __syncthreads();
}


DI void gla_unit(const Params& P, LAS unsigned char* lds, int unit) {
    const int tid = threadIdx.x, lane = tid & 63, wv = __builtin_amdgcn_readfirstlane(tid >> 6), fr = lane & 15, q4 = lane >> 4;
    const int dir = unit & 1, h = (unit >> 1) & 3, b = unit >> 3;
    LAS bf16* QI = (LAS bf16*)lds; LAS bf16* KI = QI + 64 * 72; LAS bf16* QE = KI + 64 * 72; LAS bf16* KDT = QE + 64 * 72; LAS bf16* AS = KDT + 64 * 72;
    LAS bf16* VT = AS + 64 * 72; LAS bf16* ST = VT + 128 * 72;
    LAS float* BL = (LAS float*)(ST + 128 * 72); LAS float* AF = BL + 64 * 64; LAS float* GT = AF + 64 * 16;
    const bf16* PM = (const bf16*)(P.ws + WS_PM);
    bf16* GO = (bf16*)(P.ws + WS_GO) + (size_t)dir * M * 512;
    const float* wa2 = dir ? P.in[I_GWA2B] : P.in[I_GWA2F];
    const float* ba = dir ? P.in[I_GBAB] : P.in[I_GBAF];
    const int kq = tid & 63, cgp = tid >> 6;
    float wcol[16];
#pragma unroll
    for (int r = 0; r < 16; ++r) wcol[r] = wa2[r * 256 + 64 * h + kq];
    const float bak = ba[64 * h + kq];
    f32x4 Sacc[4];
#pragma unroll
    for (int i = 0; i < 4; ++i) Sacc[i] = (f32x4){0.f, 0.f, 0.f, 0.f};
    for (int i = tid; i < 128 * 72 / 2; i += 512) ((LAS unsigned*)ST)[i] = 0u;
    const size_t rowbase = (size_t)b * T;
    const int afcol = dir ? C_GAB : C_GAF;
    u32x4 paf = (u32x4){0u, 0u, 0u, 0u}, pq, pk, pva, pvb;
#define GLA_PREFETCH(nn) do { const int chunk_ = dir ? 31 - (nn) : (nn); const size_t tk0_ = rowbase + chunk_ * 64; \
        if (tid < 128) paf = *(const u32x4*)(PM + (tk0_ + (dir ? 63 - (tid >> 1) : (tid >> 1))) * NMIX + afcol + 8 * (tid & 1)); \
        const bf16* rp_ = PM + (tk0_ + (dir ? 63 - (tid >> 3) : (tid >> 3))) * NMIX; \
        pq = *(const u32x4*)(rp_ + C_GQ + 64 * h + 8 * (tid & 7)); pk = *(const u32x4*)(rp_ + C_GK + 64 * h + 8 * (tid & 7)); \
        pva = *(const u32x4*)(rp_ + C_GV + 128 * h + 16 * (tid & 7)); pvb = *(const u32x4*)(rp_ + C_GV + 128 * h + 16 * (tid & 7) + 8); } while (0)
    GLA_PREFETCH(0);
    for (int n = 0; n < 32; ++n) {
        const int chunk = dir ? 31 - n : n;
        const size_t tok0 = rowbase + chunk * 64;
#define GTOK(c) (tok0 + (dir ? 63 - (c) : (c)))
        if (tid < 128) { const int c = tid >> 1, hf = tid & 1; const F8 f = unpack8(paf);
            *(LAS f32x4*)(AF + c * 16 + 8 * hf) = f.a; *(LAS f32x4*)(AF + c * 16 + 8 * hf + 4) = f.b; }
        LDS_BARRIER();
        float pre[8]; float run = 0.f;
#pragma unroll
        for (int j = 0; j < 8; ++j) { const int c = 8 * cgp + j; float z = bak;
#pragma unroll
            for (int r4 = 0; r4 < 4; ++r4) { const f32x4 a = *(LAS f32x4*)(AF + c * 16 + 4 * r4); z += a[0] * wcol[4 * r4] + a[1] * wcol[4 * r4 + 1] + a[2] * wcol[4 * r4 + 2] + a[3] * wcol[4 * r4 + 3]; }
            const float la = -(fmaxf(-z, 0.f) + __logf(1.f + __expf(-fabsf(z)))) * (1.f / 16.f); run += la; pre[j] = run; }
        GT[cgp * 64 + kq] = run;
        LDS_BARRIER();
        float off = 0.f;
#pragma unroll
        for (int g = 0; g < 8; ++g) off += (g < cgp) ? GT[g * 64 + kq] : 0.f;
#pragma unroll
        for (int j = 0; j < 8; ++j) BL[(8 * cgp + j) * 64 + kq] = off + pre[j];
        LDS_BARRIER();
        {   const int c = tid >> 3, k0 = 8 * (tid & 7);
            const F8 q = unpack8(pq), k = unpack8(pk);
            const u32x4 va = pva, vb = pvb;
            f32x4 qi[2], ki[2], qe[2], kd[2];
#pragma unroll
            for (int hh = 0; hh < 2; ++hh) { const f32x4 bl = *(LAS f32x4*)(BL + c * 64 + k0 + 4 * hh), br = *(LAS f32x4*)(BL + 32 * 64 + k0 + 4 * hh), bt = *(LAS f32x4*)(BL + 63 * 64 + k0 + 4 * hh);
                const f32x4 qq = (hh ? q.b : q.a) * 0.125f, kk = hh ? k.b : k.a;
#pragma unroll
                for (int j = 0; j < 4; ++j) { qi[hh][j] = qq[j] * __expf(bl[j] - br[j]); ki[hh][j] = kk[j] * __expf(br[j] - bl[j]); qe[hh][j] = qq[j] * __expf(bl[j]); kd[hh][j] = kk[j] * __expf(bt[j] - bl[j]); } }
            *(LAS u32x4*)(QI + c * 72 + k0) = pack8(qi[0], qi[1]); *(LAS u32x4*)(KI + c * 72 + k0) = pack8(ki[0], ki[1]); *(LAS u32x4*)(QE + c * 72 + k0) = pack8(qe[0], qe[1]);
#pragma unroll
            for (int j = 0; j < 4; ++j) { KDT[(k0 + j) * 72 + c] = (bf16)f2bf(kd[0][j]); KDT[(k0 + 4 + j) * 72 + c] = (bf16)f2bf(kd[1][j]); }
            const int v0 = 16 * (tid & 7);
            VT[(v0 + 0) * 72 + c] = (bf16)(va.x & 0xffffu); VT[(v0 + 1) * 72 + c] = (bf16)(va.x >> 16); VT[(v0 + 2) * 72 + c] = (bf16)(va.y & 0xffffu); VT[(v0 + 3) * 72 + c] = (bf16)(va.y >> 16);
            VT[(v0 + 4) * 72 + c] = (bf16)(va.z & 0xffffu); VT[(v0 + 5) * 72 + c] = (bf16)(va.z >> 16); VT[(v0 + 6) * 72 + c] = (bf16)(va.w & 0xffffu); VT[(v0 + 7) * 72 + c] = (bf16)(va.w >> 16);
            VT[(v0 + 8) * 72 + c] = (bf16)(vb.x & 0xffffu); VT[(v0 + 9) * 72 + c] = (bf16)(vb.x >> 16); VT[(v0 + 10) * 72 + c] = (bf16)(vb.y & 0xffffu); VT[(v0 + 11) * 72 + c] = (bf16)(vb.y >> 16);
            VT[(v0 + 12) * 72 + c] = (bf16)(vb.z & 0xffffu); VT[(v0 + 13) * 72 + c] = (bf16)(vb.z >> 16); VT[(v0 + 14) * 72 + c] = (bf16)(vb.w & 0xffffu); VT[(v0 + 15) * 72 + c] = (bf16)(vb.w >> 16);
        }
        if (n + 1 < 32) GLA_PREFETCH(n + 1);
        LDS_BARRIER();
        {   const int ct = wv >> 1;
#pragma unroll
            for (int tt = 0; tt < 2; ++tt) { const int st = 2 * (wv & 1) + tt;
                f32x4 acc = (f32x4){0.f, 0.f, 0.f, 0.f};
#pragma unroll
                for (int ks = 0; ks < 2; ++ks) { const bf16x8 a = *(LAS bf16x8*)(KI + (16 * st + fr) * 72 + 32 * ks + 8 * q4), bb = *(LAS bf16x8*)(QI + (16 * ct + fr) * 72 + 32 * ks + 8 * q4); acc = MFMA16(a, bb, acc); }
                MFMA_GUARD(acc);
                const int cg0 = 16 * ct + fr, sg0 = 16 * st + 4 * q4;
#pragma unroll
                for (int j = 0; j < 4; ++j) acc[j] = (cg0 >= sg0 + j) ? acc[j] : 0.f;
                *(LAS u32x2*)(AS + (16 * ct + fr) * 72 + 16 * st + 4 * q4) = pack4(acc); }
        }
        LDS_BARRIER();
        {   bf16x8 av[2], as_[2];
#pragma unroll
            for (int ks = 0; ks < 2; ++ks) { av[ks] = *(LAS bf16x8*)(VT + (16 * wv + fr) * 72 + 32 * ks + 8 * q4); as_[ks] = *(LAS bf16x8*)(ST + (16 * wv + fr) * 72 + 32 * ks + 8 * q4); }
#pragma unroll
            for (int ct = 0; ct < 4; ++ct) { f32x4 o = (f32x4){0.f, 0.f, 0.f, 0.f};
#pragma unroll
                for (int ks = 0; ks < 2; ++ks) { const bf16x8 bb = *(LAS bf16x8*)(AS + (16 * ct + fr) * 72 + 32 * ks + 8 * q4); o = MFMA16(av[ks], bb, o); }
#pragma unroll
                for (int ks = 0; ks < 2; ++ks) { const bf16x8 bb = *(LAS bf16x8*)(QE + (16 * ct + fr) * 72 + 32 * ks + 8 * q4); o = MFMA16(as_[ks], bb, o); }
                MFMA_GUARD(o);
                *(u32x2*)(GO + GTOK(16 * ct + fr) * 512 + 128 * h + 16 * wv + 4 * q4) = pack4(o); }
#pragma unroll
            for (int kt = 0; kt < 4; ++kt) { const f32x4 bt = *(LAS f32x4*)(BL + 63 * 64 + 16 * kt + 4 * q4);
                f32x4 s = Sacc[kt]; s[0] *= __expf(bt[0]); s[1] *= __expf(bt[1]); s[2] *= __expf(bt[2]); s[3] *= __expf(bt[3]);
#pragma unroll
                for (int ks = 0; ks < 2; ++ks) { const bf16x8 a = *(LAS bf16x8*)(KDT + (16 * kt + fr) * 72 + 32 * ks + 8 * q4); s = MFMA16(a, av[ks], s); }
                MFMA_GUARD(s); Sacc[kt] = s; }
        }
        LDS_BARRIER();
#pragma unroll
        for (int kt = 0; kt < 4; ++kt) *(LAS u32x2*)(ST + (16 * wv + fr) * 72 + 16 * kt + 4 * q4) = pack4(Sacc[kt]);
#undef GTOK
    }
#undef GLA_PREFETCH
    LDS_BARRIER();
}
DI void gla_post(const Params& P) {
    const int tid = threadIdx.x, lane = tid & 63, wv = tid >> 6;
    const bf16* PM = (const bf16*)(P.ws + WS_PM); const bf16* GO = (const bf16*)(P.ws + WS_GO); bf16* O = (bf16*)(P.ws + WS_O);
    const F8 ng = {*(const f32x4*)(P.in[I_GNG] + 8 * lane), *(const f32x4*)(P.in[I_GNG] + 8 * lane + 4)};
    for (int m = blockIdx.x * 8 + wv; m < M; m += gridDim.x * 8) {
        const F8 a = unpack8(*(const u32x4*)(GO + (size_t)m * 512 + 8 * lane)), bq = unpack8(*(const u32x4*)(GO + (size_t)(M + m) * 512 + 8 * lane));
        const F8 og = unpack8(*(const u32x4*)(PM + (size_t)m * NMIX + C_GOG + 8 * lane));
        const f32x4 o0 = a.a + bq.a, o1 = a.b + bq.b;
        float ss = (o0[0] * o0[0] + o0[1] * o0[1]) + (o0[2] * o0[2] + o0[3] * o0[3]) + (o1[0] * o1[0] + o1[1] * o1[1]) + (o1[2] * o1[2] + o1[3] * o1[3]);
        ss += __shfl_xor(ss, 1); ss += __shfl_xor(ss, 2); ss += __shfl_xor(ss, 4); ss += __shfl_xor(ss, 8);
        const float rs = 1.0f / sqrtf(ss * (1.f / 128.f) + 1e-5f);
        f32x4 r0, r1;
#pragma unroll
        for (int j = 0; j < 4; ++j) { r0[j] = o0[j] * rs * ng.a[j] * (og.a[j] * sigm(og.a[j])); r1[j] = o1[j] * rs * ng.b[j] * (og.b[j] * sigm(og.b[j])); }
        *(u32x4*)(O + (size_t)m * 512 + 8 * lane) = pack8(r0, r1);
    }
}

template <int K> DI void lora_mma(f32x4 (&acc)[4][4], const bf16* Wt, LAS bf16* X, int ldx, int fr, int q4) {
#pragma unroll
    for (int a = 0; a < 4; ++a)
#pragma unroll
        for (int c = 0; c < 4; ++c) acc[a][c] = (f32x4){0.f, 0.f, 0.f, 0.f};
#pragma unroll
    for (int ks = 0; ks < K / 32; ++ks) { bf16x8 af[4];
#pragma unroll
        for (int nt = 0; nt < 4; ++nt) af[nt] = *(const bf16x8*)(Wt + (size_t)(32 * (nt >> 1) + 8 * (fr >> 2) + 4 * (nt & 1) + (fr & 3)) * K + 32 * ks + 8 * q4);
#pragma unroll
        for (int mt = 0; mt < 4; ++mt) { const bf16x8 bb = *(LAS bf16x8*)(X + (16 * mt + fr) * ldx + 32 * ks + 8 * q4);
#pragma unroll
            for (int nt = 0; nt < 4; ++nt) acc[nt][mt] = MFMA16(af[nt], bb, acc[nt][mt]); } }
    __builtin_amdgcn_sched_barrier(0); asm volatile("s_nop 7\n\ts_nop 7" ::: "memory"); __builtin_amdgcn_sched_barrier(0);
}
DI f32x4 shift4(const bf16* rp, bool hp, bool hn, const float* mup, const float* mun) {
    const f32x4 c = unpack4(*(const u32x2*)rp);
    const f32x4 pp = hp ? unpack4(*(const u32x2*)(rp - NMIX)) : (f32x4){0.f, 0.f, 0.f, 0.f};
    const f32x4 pn = hn ? unpack4(*(const u32x2*)(rp + NMIX)) : (f32x4){0.f, 0.f, 0.f, 0.f};
    return c + *(const f32x4*)mup * (pp - c) + *(const f32x4*)mun * (pn - c);
}
DI F8 shift8(const bf16* rp, bool hp, bool hn, const float* mup, const float* mun) {
    const F8 c = unpack8(*(const u32x4*)rp);
    F8 pp, pn; const f32x4 z = (f32x4){0.f, 0.f, 0.f, 0.f};
    if (hp) pp = unpack8(*(const u32x4*)(rp - NMIX)); else { pp.a = z; pp.b = z; }
    if (hn) pn = unpack8(*(const u32x4*)(rp + NMIX)); else { pn.a = z; pn.b = z; }
    F8 r; r.a = c.a + *(const f32x4*)mup * (pp.a - c.a) + *(const f32x4*)mun * (pn.a - c.a);
    r.b = c.b + *(const f32x4*)(mup + 4) * (pp.b - c.b) + *(const f32x4*)(mun + 4) * (pn.b - c.b); return r;
}
DI void r1_tile(const Params& P, LAS unsigned char* lds, int tile) {
    const int tid = threadIdx.x, lane = tid & 63, hd = __builtin_amdgcn_readfirstlane(tid >> 6), fr = lane & 15, q4 = lane >> 4;
    LAS bf16* XW = (LAS bf16*)lds; LAS bf16* XA = XW + 64 * 72; LAS bf16* XG = XA + 64 * 72;
    const bf16* PM = (const bf16*)(P.ws + WS_PM);
    const float* mup = P.in[I_MUP]; const float* mun = P.in[I_MUN];
    const int t0 = tile * 64;
    {   const int row = tid >> 3, g8 = tid & 7; const int tok = t0 + row, tpos = tok & (T - 1);
        const bool hp = tpos > 0, hn = tpos < T - 1;
        const bf16* rp = PM + (size_t)tok * NMIX + C_R0 + 1536 + 32 * g8;
#pragma unroll
        for (int v4 = 0; v4 < 4; ++v4) { F8 s = shift8(rp + 8 * v4, hp, hn, mup + 1536 + 32 * g8 + 8 * v4, mun + 1536 + 32 * g8 + 8 * v4);
            if (g8 < 2) {
#pragma unroll
                for (int j = 0; j < 4; ++j) { s.a[j] = 1.f - 2.f * __builtin_amdgcn_rcpf(__expf(2.f * s.a[j]) + 1.f); s.b[j] = 1.f - 2.f * __builtin_amdgcn_rcpf(__expf(2.f * s.b[j]) + 1.f); }
                *(LAS u32x4*)(XW + row * 72 + 32 * g8 + 8 * v4) = pack8(s.a, s.b);
            } else if (g8 < 4) { *(LAS u32x4*)(XA + row * 72 + 32 * (g8 - 2) + 8 * v4) = pack8(s.a, s.b);
            } else {
#pragma unroll
                for (int j = 0; j < 4; ++j) { s.a[j] = sigm(s.a[j]); s.b[j] = sigm(s.b[j]); }
                *(LAS u32x4*)(XG + row * 136 + 32 * (g8 - 4) + 8 * v4) = pack8(s.a, s.b); } }
    }
    __syncthreads();
    unsigned char* dout = (unsigned char*)P.out;
    bf16* KP = (bf16*)dout; bf16* KKn = KP + (size_t)M * 512; bf16* BB = KKn + (size_t)M * 512; bf16* GG = BB + (size_t)M * 512;
    unsigned short* EF = (unsigned short*)(P.ws + WS_E); unsigned short* EB = EF + (size_t)M * 512;
    float* BON = (float*)(P.ws + WS_BON);
    const int ch8 = 64 * hd + 8 * q4;
    f32x4 acc[4][4];
    lora_mma<64>(acc, (const bf16*)(P.ws + WS_LA2) + (size_t)(64 * hd) * 64, XA, 72, fr, q4);
#pragma unroll
    for (int np = 0; np < 2; ++np) { const f32x4 a0a = *(const f32x4*)(P.in[I_A0] + ch8 + 32 * np), a0b = *(const f32x4*)(P.in[I_A0] + ch8 + 32 * np + 4);
#pragma unroll
        for (int mt = 0; mt < 4; ++mt)
#pragma unroll
            for (int j = 0; j < 4; ++j) { acc[2 * np][mt][j] = sigm(acc[2 * np][mt][j] + a0a[j]); acc[2 * np + 1][mt][j] = sigm(acc[2 * np + 1][mt][j] + a0b[j]); } }
#pragma unroll
    for (int mt = 0; mt < 4; ++mt) { const int tok = t0 + 16 * mt + fr, tpos = tok & (T - 1); const bool hp = tpos > 0, hn = tpos < T - 1;
        const bf16* rp = PM + (size_t)tok * NMIX + C_R0 + ch8;
        F8 ks[2]; float ss = 0.f;
#pragma unroll
        for (int np = 0; np < 2; ++np) { ks[np] = shift8(rp + 512 + 32 * np, hp, hn, mup + 512 + ch8 + 32 * np, mun + 512 + ch8 + 32 * np);
            const f32x4 k0 = ks[np].a * *(const f32x4*)(P.in[I_KK] + ch8 + 32 * np), k1 = ks[np].b * *(const f32x4*)(P.in[I_KK] + ch8 + 32 * np + 4);
            ss += ((k0[0] * k0[0] + k0[1] * k0[1]) + (k0[2] * k0[2] + k0[3] * k0[3])) + ((k1[0] * k1[0] + k1[1] * k1[1]) + (k1[2] * k1[2] + k1[3] * k1[3])); }
        ss += __shfl_xor(ss, 16); ss += __shfl_xor(ss, 32);
        const float inv = 1.0f / fmaxf(sqrtf(ss), 1e-12f);
        float bon = 0.f;
#pragma unroll
        for (int np = 0; np < 2; ++np) { const f32x4 aa = acc[2 * np][mt], ab = acc[2 * np + 1][mt];
            const f32x4 kka = *(const f32x4*)(P.in[I_KK] + ch8 + 32 * np), kkb = *(const f32x4*)(P.in[I_KK] + ch8 + 32 * np + 4);
            const f32x4 kaa = *(const f32x4*)(P.in[I_KA] + ch8 + 32 * np), kab = *(const f32x4*)(P.in[I_KA] + ch8 + 32 * np + 4);
            const f32x4 kn0 = ks[np].a * kka * inv, kn1 = ks[np].b * kkb * inv;
            const f32x4 kp0 = ks[np].a * (1.0f + (aa - 1.0f) * kaa), kp1 = ks[np].b * (1.0f + (ab - 1.0f) * kab);
            const f32x4 bb0 = kn0 * aa, bb1 = kn1 * ab;
            const F8 rs = shift8(rp + 32 * np, hp, hn, mup + ch8 + 32 * np, mun + ch8 + 32 * np);
            const f32x4 rk0 = *(const f32x4*)(P.in[I_RK] + ch8 + 32 * np), rk1 = *(const f32x4*)(P.in[I_RK] + ch8 + 32 * np + 4);
            bon += ((rs.a[0] * kp0[0] * rk0[0] + rs.a[1] * kp0[1] * rk0[1]) + (rs.a[2] * kp0[2] * rk0[2] + rs.a[3] * kp0[3] * rk0[3]))
                 + ((rs.b[0] * kp1[0] * rk1[0] + rs.b[1] * kp1[1] * rk1[1]) + (rs.b[2] * kp1[2] * rk1[2] + rs.b[3] * kp1[3] * rk1[3]));
            const size_t o = (size_t)tok * 512 + ch8 + 32 * np;
            *(u32x4*)(KP + o) = pack8(kp0, kp1); *(u32x4*)(KKn + o) = pack8(kn0, kn1); *(u32x4*)(BB + o) = pack8(bb0, bb1); }
        bon += __shfl_xor(bon, 16); bon += __shfl_xor(bon, 32);
        if (q4 == 0) BON[(size_t)tok * 8 + hd] = bon; }
#pragma unroll
    for (int d = 0; d < 2; ++d) {
        lora_mma<64>(acc, (const bf16*)(P.ws + (d ? WS_LW2B : WS_LW2F)) + (size_t)(64 * hd) * 64, XW, 72, fr, q4);
        unsigned short* E = d ? EB : EF; const float* w0 = d ? P.in[I_W0B] : P.in[I_W0F];
#pragma unroll
        for (int np = 0; np < 2; ++np) { const f32x4 w0a = *(const f32x4*)(w0 + ch8 + 32 * np), w0b = *(const f32x4*)(w0 + ch8 + 32 * np + 4);
#pragma unroll
            for (int mt = 0; mt < 4; ++mt) { const f32x4 a = acc[2 * np][mt], c = acc[2 * np + 1][mt]; u32x4 w;
                w.x = pkh2(0.60653066f * sigm(a[0] + w0a[0]), 0.60653066f * sigm(a[1] + w0a[1])); w.y = pkh2(0.60653066f * sigm(a[2] + w0a[2]), 0.60653066f * sigm(a[3] + w0a[3]));
                w.z = pkh2(0.60653066f * sigm(c[0] + w0b[0]), 0.60653066f * sigm(c[1] + w0b[1])); w.w = pkh2(0.60653066f * sigm(c[2] + w0b[2]), 0.60653066f * sigm(c[3] + w0b[3]));
                *(u32x4*)(E + (size_t)(t0 + 16 * mt + fr) * 512 + ch8 + 32 * np) = w; } }
    }
    lora_mma<128>(acc, (const bf16*)(P.ws + WS_LG2) + (size_t)(64 * hd) * 128, XG, 136, fr, q4);
#pragma unroll
    for (int np = 0; np < 2; ++np)
#pragma unroll
        for (int mt = 0; mt < 4; ++mt) *(u32x4*)(GG + (size_t)(t0 + 16 * mt + fr) * 512 + ch8 + 32 * np) = pack8(acc[2 * np][mt], acc[2 * np + 1][mt]);
    __syncthreads();
}

constexpr int TC = 16;
#define OPI(buf, d, arr) (OP + ((((buf) * 2 + (d)) * 6 + (arr)) * (TC * 64)))
DI void scan_load(const Params& P, LAS float* OP, int buf, int ci, int b, int hd, int ltid) {
    const int d = ltid >> 7, i = (ltid >> 3) & 15, c8 = ltid & 7;
    const int step = TC * ci + i, tpos = d ? T - 1 - step : step; const size_t tok = (size_t)b * T + tpos;
    const int ch0 = 64 * hd + 8 * c8;
    const bf16* PM = (const bf16*)(P.ws + WS_PM);
    const bf16* KP = (const bf16*)P.out; const bf16* KKn = KP + (size_t)M * 512; const bf16* BB = KKn + (size_t)M * 512;
    const unsigned short* E = (const unsigned short*)(P.ws + WS_E) + (size_t)d * M * 512;
    const F8 kp = unpack8(*(const u32x4*)(KP + tok * 512 + ch0)), kk = unpack8(*(const u32x4*)(KKn + tok * 512 + ch0)), bb = unpack8(*(const u32x4*)(BB + tok * 512 + ch0));
    const u32x4 ew = *(const u32x4*)(E + tok * 512 + ch0);
    const bool hp = tpos > 0, hn = tpos < T - 1;
    const bf16* rp = PM + tok * NMIX + C_R0 + ch0;
    const F8 r = shift8(rp, hp, hn, P.in[I_MUP] + ch0, P.in[I_MUN] + ch0), v = shift8(rp + 1024, hp, hn, P.in[I_MUP] + 1024 + ch0, P.in[I_MUN] + 1024 + ch0);
    const int o = i * 64 + 8 * c8;
    *(LAS f32x4*)(OPI(buf, d, 0) + o) = -kk.a; *(LAS f32x4*)(OPI(buf, d, 0) + o + 4) = -kk.b;
    f32x4 w0, w1; w0[0] = __expf(-hlo(ew.x)); w0[1] = __expf(-hhi(ew.x)); w0[2] = __expf(-hlo(ew.y)); w0[3] = __expf(-hhi(ew.y));
    w1[0] = __expf(-hlo(ew.z)); w1[1] = __expf(-hhi(ew.z)); w1[2] = __expf(-hlo(ew.w)); w1[3] = __expf(-hhi(ew.w));
    *(LAS f32x4*)(OPI(buf, d, 1) + o) = w0; *(LAS f32x4*)(OPI(buf, d, 1) + o + 4) = w1;
    *(LAS f32x4*)(OPI(buf, d, 2) + o) = bb.a; *(LAS f32x4*)(OPI(buf, d, 2) + o + 4) = bb.b;
    *(LAS f32x4*)(OPI(buf, d, 3) + o) = kp.a; *(LAS f32x4*)(OPI(buf, d, 3) + o + 4) = kp.b;
    *(LAS f32x4*)(OPI(buf, d, 4) + o) = r.a; *(LAS f32x4*)(OPI(buf, d, 4) + o + 4) = r.b;
    *(LAS f32x4*)(OPI(buf, d, 5) + o) = v.a; *(LAS f32x4*)(OPI(buf, d, 5) + o + 4) = v.b;
}
DI void scan_flush(const Params& P, LAS float* YB, int buf, int ci, int b, int hd, int ltid) {
    const int d = ltid >> 7, i = (ltid >> 3) & 15, c8 = ltid & 7;
    const int step = TC * ci + i, tpos = d ? T - 1 - step : step; const size_t tok = (size_t)b * T + tpos;
    bf16* Y = (bf16*)(P.ws + WS_GO) + (size_t)d * M * 512;
    const LAS float* y = YB + (buf * 2 + d) * (TC * 64) + i * 64 + 8 * c8;
    *(u32x4*)(Y + tok * 512 + 64 * hd + 8 * c8) = pack8(*(const LAS f32x4*)y, *(const LAS f32x4*)(y + 4));
}
struct ScanOps { f32x2 nk[4], w[4], bb[4], kx[4], rx[4]; f32x4 vv; };
DI void scan_ops_load(ScanOps& o, const LAS float* base, const LAS float* vb, int i) {
#pragma unroll
    for (int hh = 0; hh < 2; ++hh) { const f32x4 t0 = *(const LAS f32x4*)(base + 0 * TC * 64 + i * 64 + 4 * hh), t1 = *(const LAS f32x4*)(base + 1 * TC * 64 + i * 64 + 4 * hh), t2 = *(const LAS f32x4*)(base + 2 * TC * 64 + i * 64 + 4 * hh),
                                                   t3 = *(const LAS f32x4*)(base + 3 * TC * 64 + i * 64 + 4 * hh), t4 = *(const LAS f32x4*)(base + 4 * TC * 64 + i * 64 + 4 * hh);
        o.nk[2 * hh] = (f32x2){t0[0], t0[1]}; o.nk[2 * hh + 1] = (f32x2){t0[2], t0[3]}; o.w[2 * hh] = (f32x2){t1[0], t1[1]}; o.w[2 * hh + 1] = (f32x2){t1[2], t1[3]};
        o.bb[2 * hh] = (f32x2){t2[0], t2[1]}; o.bb[2 * hh + 1] = (f32x2){t2[2], t2[3]}; o.kx[2 * hh] = (f32x2){t3[0], t3[1]}; o.kx[2 * hh + 1] = (f32x2){t3[2], t3[3]};
        o.rx[2 * hh] = (f32x2){t4[0], t4[1]}; o.rx[2 * hh + 1] = (f32x2){t4[2], t4[3]}; }
    o.vv = *(const LAS f32x4*)(vb + i * 64);
}
DI void scan_step(f32x2 (&S)[4][4], const ScanOps& o, LAS float* yb, int i, int c8) {
    float sa[4];
#pragma unroll
    for (int j = 0; j < 4; ++j) { f32x2 a = S[j][0] * o.nk[0]; a = S[j][1] * o.nk[1] + a; a = S[j][2] * o.nk[2] + a; a = S[j][3] * o.nk[3] + a; sa[j] = oct_sum(a.x + a.y); }
    f32x4 yo;
#pragma unroll
    for (int j = 0; j < 4; ++j) { const f32x2 sav = (f32x2){sa[j], sa[j]}, vjv = (f32x2){o.vv[j], o.vv[j]};
#pragma unroll
        for (int p = 0; p < 4; ++p) S[j][p] = S[j][p] * o.w[p] + (sav * o.bb[p] + vjv * o.kx[p]);
        f32x2 y = S[j][0] * o.rx[0]; y = S[j][1] * o.rx[1] + y; y = S[j][2] * o.rx[2] + y; y = S[j][3] * o.rx[3] + y; yo[j] = oct_sum(y.x + y.y); }
    if (c8 == 0) *(LAS f32x4*)(yb + i * 64) = yo;
}
DI void scan_unit(const Params& P, LAS unsigned char* lds, int bh) {
    const int tid = threadIdx.x, lane = tid & 63, wv = __builtin_amdgcn_readfirstlane(tid >> 6);
    const int b = bh >> 3, hd = bh & 7;
    LAS float* OP = (LAS float*)lds; LAS float* YB = OP + 2 * 2 * 6 * TC * 64;
    constexpr int NCH = T / TC;
    const bool loader = wv >= 4; const int ltid = tid - 256;
    const int d = wv >> 1, c8 = lane & 7, rbase = 32 * (wv & 1) + 4 * (lane >> 3);
    f32x2 S[4][4];
#pragma unroll
    for (int j = 0; j < 4; ++j)
#pragma unroll
        for (int p = 0; p < 4; ++p) S[j][p] = (f32x2){0.f, 0.f};
    if (loader) scan_load(P, OP, 0, 0, b, hd, ltid);
    __syncthreads();
    for (int ci = 0; ci < NCH; ++ci) {
        const int buf = ci & 1;
        if (loader) {
            if (ci + 1 < NCH) scan_load(P, OP, buf ^ 1, ci + 1, b, hd, ltid);
            if (ci > 0) scan_flush(P, YB, buf ^ 1, ci - 1, b, hd, ltid);
        } else {
            const LAS float* base = OPI(buf, d, 0) + 8 * c8;
            const LAS float* vb = OPI(buf, d, 5) + rbase;
            LAS float* yb = YB + (buf * 2 + d) * (TC * 64) + rbase;
            ScanOps cur, nxt; scan_ops_load(cur, base, vb, 0);
#pragma unroll 1
            for (int i = 0; i < TC; i += 2) {
                scan_ops_load(nxt, base, vb, i + 1);
                scan_step(S, cur, yb, i, c8);
                if (i + 2 < TC) scan_ops_load(cur, base, vb, i + 2);
                scan_step(S, nxt, yb, i + 1, c8);
            }
        }
        __syncthreads();
    }
    if (loader) scan_flush(P, YB, (NCH - 1) & 1, NCH - 1, b, hd, ltid);
    __syncthreads();
}
DI void r3_post(const Params& P) {
    const int tid = threadIdx.x, lane = tid & 63, wv = tid >> 6;
    const bf16* PM = (const bf16*)(P.ws + WS_PM); const bf16* Y = (const bf16*)(P.ws + WS_GO); bf16* O = (bf16*)(P.ws + WS_O);
    const bf16* GG = (const bf16*)P.out + (size_t)3 * M * 512; const float* BON = (const float*)(P.ws + WS_BON);
    const F8 lw = {*(const f32x4*)(P.in[I_LNW] + 8 * lane), *(const f32x4*)(P.in[I_LNW] + 8 * lane + 4)}, lb = {*(const f32x4*)(P.in[I_LNB] + 8 * lane), *(const f32x4*)(P.in[I_LNB] + 8 * lane + 4)};
    for (int m = blockIdx.x * 8 + wv; m < M; m += gridDim.x * 8) {
        const int tpos = m & (T - 1);
        const F8 a = unpack8(*(const u32x4*)(Y + (size_t)m * 512 + 8 * lane)), bq = unpack8(*(const u32x4*)(Y + (size_t)(M + m) * 512 + 8 * lane));
        const F8 g = unpack8(*(const u32x4*)(GG + (size_t)m * 512 + 8 * lane));
        const F8 v = shift8(PM + (size_t)m * NMIX + C_R0 + 1024 + 8 * lane, tpos > 0, tpos < T - 1, P.in[I_MUP] + 1024 + 8 * lane, P.in[I_MUN] + 1024 + 8 * lane);
        const float bon = BON[(size_t)m * 8 + (lane >> 3)];
        const f32x4 y0 = a.a + bq.a, y1 = a.b + bq.b;
        float s = (y0[0] + y0[1]) + (y0[2] + y0[3]) + (y1[0] + y1[1]) + (y1[2] + y1[3]);
        s += __shfl_xor(s, 1); s += __shfl_xor(s, 2); s += __shfl_xor(s, 4);
        const float mu = s * (1.f / 64.f);
        const f32x4 d0 = y0 - mu, d1 = y1 - mu;
        float q = (d0[0] * d0[0] + d0[1] * d0[1]) + (d0[2] * d0[2] + d0[3] * d0[3]) + (d1[0] * d1[0] + d1[1] * d1[1]) + (d1[2] * d1[2] + d1[3] * d1[3]);
        q += __shfl_xor(q, 1); q += __shfl_xor(q, 2); q += __shfl_xor(q, 4);
        const float rs = 1.0f / sqrtf(q * (1.f / 64.f) + 64.f * 1e-5f);
        const f32x4 o0 = (d0 * rs * lw.a + lb.a + bon * v.a) * g.a, o1 = (d1 * rs * lw.b + lb.b + bon * v.b) * g.b;
        *(u32x4*)(O + (size_t)(M + m) * 512 + 8 * lane) = pack8(o0, o1);
    }
}

DI void conv_phase(const Params& P, int half, int sel = 0) {
    const bf16* U = (const bf16*)(P.ws + WS_U); bf16* ACT = (bf16*)(P.ws + WS_ACT);
    const float* cw = P.in[I_FCW]; const float* cb = P.in[I_FCB];
    constexpr int NCG = DFFP / 8;
    const int nitems = (MH / 8) * NCG;
    for (int it = blockIdx.x * 512 + threadIdx.x; it < nitems; it += gridDim.x * 512) {
        const int run = it / NCG, cgp = it - run * NCG, j0 = 8 * cgp;
        const int tl0 = run * 8, tg0 = half * MH + tl0, tpos0 = tg0 & (T - 1);
        bf16* ap = ACT + (size_t)tg0 * DFFP + j0;
        if (j0 >= DFF) {
#pragma unroll
            for (int rr = 0; rr < 8; ++rr) *(u32x4*)(ap + (size_t)rr * DFFP) = (u32x4){0u, 0u, 0u, 0u};
            continue; }
        const int ucol = 256 * (j0 >> 7) + (j0 & 127);
        F8 wg[3], wvv[3];
#pragma unroll
        for (int t = 0; t < 3; ++t) { wg[t].a = *(const f32x4*)(cw + t * NUPSRC + j0); wg[t].b = *(const f32x4*)(cw + t * NUPSRC + j0 + 4); wvv[t].a = *(const f32x4*)(cw + t * NUPSRC + DFF + j0); wvv[t].b = *(const f32x4*)(cw + t * NUPSRC + DFF + j0 + 4); }
        const F8 bg = {*(const f32x4*)(cb + j0), *(const f32x4*)(cb + j0 + 4)}, bv = {*(const f32x4*)(cb + DFF + j0), *(const f32x4*)(cb + DFF + j0 + 4)};
        const bf16* up = U + (size_t)tl0 * NUP + ucol;
        const f32x4 z = (f32x4){0.f, 0.f, 0.f, 0.f};
        F8 pg, pv, cg_, cv, ng, nv;
        if (tpos0 > 0) { pg = unpack8(*(const u32x4*)(up - NUP)); pv = unpack8(*(const u32x4*)(up - NUP + 128)); } else { pg.a = z; pg.b = z; pv.a = z; pv.b = z; }
        cg_ = unpack8(*(const u32x4*)up); cv = unpack8(*(const u32x4*)(up + 128));
#pragma unroll
        for (int rr = 0; rr < 8; ++rr) {
            if (tpos0 + rr + 1 < T) { ng = unpack8(*(const u32x4*)(up + (size_t)(rr + 1) * NUP)); nv = unpack8(*(const u32x4*)(up + (size_t)(rr + 1) * NUP + 128)); } else { ng.a = z; ng.b = z; nv.a = z; nv.b = z; }
            const f32x4 g0 = wg[0].a * pg.a + wg[1].a * cg_.a + wg[2].a * ng.a + bg.a, g1 = wg[0].b * pg.b + wg[1].b * cg_.b + wg[2].b * ng.b + bg.b;
            const f32x4 x0 = wvv[0].a * pv.a + wvv[1].a * cv.a + wvv[2].a * nv.a + bv.a, x1 = wvv[0].b * pv.b + wvv[1].b * cv.b + wvv[2].b * nv.b + bv.b;
            f32x4 o0, o1;
#pragma unroll
            for (int j = 0; j < 4; ++j) { o0[j] = g0[j] * sigm(g0[j]) * x0[j]; o1[j] = g1[j] * sigm(g1[j]) * x1[j]; }
            { const int rt_ = (tl0 + rr) & 255; const bool edge = (rt_ == 0 || rt_ == 255);
              if (sel == 0 || (sel == 1 && edge) || (sel == 2 && !edge)) *(u32x4*)(ap + (size_t)rr * DFFP) = pack8(o0, o1); }
            pg = cg_; pv = cv; cg_ = ng; cv = nv;
        }
    }
}
#ifndef DBG_UDUMP
#define DBG_UDUMP 0
#endif
DI void conv_fix(const Params& P) {
    const float* SB = (const float*)(P.ws + (DBG_UDUMP ? 868 * MiB : WS_SB)); bf16* ACT = (bf16*)(P.ws + WS_ACT);
    const float* cw = P.in[I_FCW]; const float* cb = P.in[I_FCB];
    constexpr int NG = DFFP / 4;
    const int nitems = 256 * 2 * NG;
    for (int it = blockIdx.x * 512 + threadIdx.x; it < nitems; it += gridDim.x * 512) {
        const int jg = it % NG, rw = it / NG, which = rw & 1, pm = rw >> 1, j = 4 * jg;
        bf16* ap = ACT + (size_t)(pm * 256 + (which ? 255 : 0)) * DFFP + j;
        if (j >= DFF) { *(u32x2*)ap = (u32x2){0u, 0u}; continue; }
        const int col = 256 * (j >> 7) + (j & 127);
        const f32x4 z = (f32x4){0.f, 0.f, 0.f, 0.f};
        const float* cur = SB + (size_t)(pm * 4 + (which ? 3 : 0)) * NUP + col;
        const float* prv = which ? SB + (size_t)(pm * 4 + 2) * NUP + col : ((pm & 7) ? SB + (size_t)((pm - 1) * 4 + 3) * NUP + col : nullptr);
        const float* nxt = which ? (((pm & 7) != 7) ? SB + (size_t)((pm + 1) * 4 + 0) * NUP + col : nullptr) : SB + (size_t)(pm * 4 + 1) * NUP + col;
        const f32x4 cgv = *(const f32x4*)cur, cvv = *(const f32x4*)(cur + 128);
        const f32x4 pg = prv ? *(const f32x4*)prv : z, pv = prv ? *(const f32x4*)(prv + 128) : z;
        const f32x4 ng = nxt ? *(const f32x4*)nxt : z, nv = nxt ? *(const f32x4*)(nxt + 128) : z;
        const f32x4 g = *(const f32x4*)(cw + j) * pg + *(const f32x4*)(cw + NUPSRC + j) * cgv + *(const f32x4*)(cw + 2 * NUPSRC + j) * ng + *(const f32x4*)(cb + j);
        const f32x4 v = *(const f32x4*)(cw + DFF + j) * pv + *(const f32x4*)(cw + NUPSRC + DFF + j) * cvv + *(const f32x4*)(cw + 2 * NUPSRC + DFF + j) * nv + *(const f32x4*)(cb + DFF + j);
        f32x4 o;
#pragma unroll
        for (int i = 0; i < 4; ++i) o[i] = g[i] * sigm(g[i]) * v[i];
        *(u32x2*)ap = pack4(o);
    }
}
#ifndef DBG_SKIPMASK
#define DBG_SKIPMASK 0
#endif
#ifndef FUSE_NORM2
#define FUSE_NORM2 1
#endif
#ifndef FUSE_CONV
#define FUSE_CONV 1
#endif
#ifndef SEAM_ACQ
#define SEAM_ACQ 0
#endif
#ifndef USE_CG_SYNC
#define USE_CG_SYNC 0
#endif
#ifndef N_PHASE_LAUNCH
#define N_PHASE_LAUNCH 0
#endif
constexpr int NPHASES = 16;
__global__ void __launch_bounds__(512, 2) fwd_kernel(Params P, int ph_lo, int ph_hi) {
    extern __shared__ __attribute__((aligned(16))) unsigned char lds_raw[];
    LAS unsigned char* lds = (LAS unsigned char*)lds_raw;
    const int tid = threadIdx.x, wv = tid >> 6, lane = tid & 63;
    unsigned char* ws = P.ws;
    bf16* HB = (bf16*)(ws + WS_HB);
    const int G = gridDim.x, bx = blockIdx.x;
#if N_PHASE_LAUNCH
#define SEAM() do {} while (0)
#define SEAM0() do {} while (0)
#else
    cg::grid_group grid = cg::this_grid();
    volatile LAS unsigned* xst = (volatile LAS unsigned*)(lds + 131072 + 64);
    if (tid < 2) xst[tid] = 0u;
    __syncthreads();
    const XcdBarrier xbar = xcd_barrier_post((unsigned*)ws, xst);
#define SEAM0() grid.sync()
#if USE_CG_SYNC
#define SEAM() grid.sync()
#else
#if SEAM_ACQ
#define SEAM() do { xcd_barrier(xbar); __builtin_amdgcn_fence(__ATOMIC_ACQUIRE, "agent"); } while (0)
#else
#define SEAM() xcd_barrier(xbar)
#endif
#endif
#endif
#define IN(k) (ph_lo <= (k) && (k) < ph_hi)
#define GEMM_CALL(EPI, A_, B_, M_, N_, K_, E_) do { pg8::Gemm g{(const pg8::bf16_t*)(A_), (const pg8::bf16_t*)(B_), (M_), (N_), (K_)}; pg8::StaticOrder S; S.init((M_), (N_), G, bx); \
        pg8::gemm_phase<EPI, pg8::StaticOrder, PG8_ALIGN, PG8_SP2>(lds, g, S, (E_)); } while (0)
    if (IN(0)) { p0_prologue(P, lds); SEAM0(); }
    if (IN(1)) { pg8::EpiStore E{(pg8::bf16_t*)(ws + WS_PM), NMIX, NMIX, 0, nullptr}; GEMM_CALL(pg8::EpiStore, HB, ws + WS_WMIX, M, NMIXP, D, E);
#ifdef PROBE_G1A2
                 __syncthreads(); GEMM_CALL(pg8::EpiStore, HB, ws + WS_WMIX, M, NMIXP, D, E);
#endif
                 SEAM(); }
    if (IN(2)) { for (int u = bx; u < 256; u += G) gla_unit(P, lds, (G == 256) ? ((u & ~15) + 2 * (u & 7) + ((u >> 3) & 1)) : u);
#ifdef PROBE_GLA2
                 for (int u = bx; u < 256; u += G) gla_unit(P, lds, u);
#endif
                 SEAM(); }
    if (IN(3)) { gla_post(P); for (int t = bx; t < M / 64; t += G) r1_tile(P, lds, t);
#ifdef PROBE_R12
                 for (int t = bx; t < M / 64; t += G) r1_tile(P, lds, t);
#endif
                 SEAM(); }
    if (IN(5)) { for (int u = bx; u < 256; u += G) scan_unit(P, lds, u);
#ifdef PROBE_SCAN2
                 for (int u = bx; u < 256; u += G) scan_unit(P, lds, u);
#endif
                 SEAM(); }
    if (IN(6)) { r3_post(P); __syncthreads();
                 pg8::EpiStore E{(pg8::bf16_t*)(ws + WS_E), D, D, D, (pg8::bf16_t*)P.out}; GEMM_CALL(pg8::EpiStore, HB, ws + WS_WGATE, M, NGATE, D, E); SEAM(); }
    if (IN(7)) { { pg8::EpiGate<0> E{(const pg8::bf16_t*)(ws + WS_E), (pg8::bf16_t*)HB, D}; GEMM_CALL(pg8::EpiGate<0>, ws + WS_O, ws + WS_WGP, M, D, 512, E); }
                 __syncthreads();
                 { pg8::EpiGate<1> E{(const pg8::bf16_t*)P.out, (pg8::bf16_t*)HB, D}; GEMM_CALL(pg8::EpiGate<1>, ws + WS_O + (size_t)M * 512 * 2, ws + WS_WRP, M, D, 512, E); }
                 SEAM(); }
#if FUSE_NORM2
    if (IN(8)) { pg8::EpiResNorm E{P.in[I_X], P.out, (pg8::bf16_t*)(ws + WS_H2), P.in[I_N2G], (float*)(ws + 65536), D}; GEMM_CALL(pg8::EpiResNorm, HB, ws + WS_WOUT, M, D, D, E); SEAM(); }
#else
    if (IN(8)) { pg8::EpiRes E{P.in[I_X], P.out, D}; GEMM_CALL(pg8::EpiRes, HB, ws + WS_WOUT, M, D, D, E); SEAM(); }
#endif
#if !FUSE_NORM2
    if (IN(9)) { for (int m = bx * 8 + wv; m < M; m += G * 16) rms_rows2_bf16(P.out, P.in[I_N2G], HB, m, m + G * 8, lane); SEAM(); }
#endif
#if FUSE_CONV
    if (IN(10)) { pg8::EpiConv E{(pg8::bf16_t*)(ws + WS_ACT), (float*)(ws + (DBG_UDUMP ? 868 * MiB : WS_SB)), P.in[I_FCW], P.in[I_FCB], (PG8_LAS float*)(lds + 131072 + 256), DBG_UDUMP ? (pg8::bf16_t*)(ws + WS_U) : nullptr, FUSE_NORM2 ? (const float*)(ws + 65536) : nullptr};
                  GEMM_CALL(pg8::EpiConv, FUSE_NORM2 ? (bf16*)(ws + WS_H2) : HB, ws + WS_WUP, M, NUP, D, E); SEAM(); }
    if (IN(11)) { conv_fix(P); SEAM(); }
#if DBG_UDUMP
    if (IN(12)) { conv_phase(P, 0, 2); SEAM(); }
#endif
#ifdef DBG_SEL
#pragma unroll 1
    for (int half = 0; half < 2; ++half) {
        if (IN(12)) { pg8::EpiStore E{(pg8::bf16_t*)(ws + WS_U), NUP, NUP, 0, nullptr}; GEMM_CALL(pg8::EpiStore, HB + (size_t)half * MH * D, ws + WS_WUP, MH, NUP, D, E); SEAM(); }
        if (IN(12)) { conv_phase(P, half, DBG_SEL); SEAM(); }
    }
#endif
#else
#pragma unroll 1
    for (int half = 0; half < 2; ++half) {
        if (IN(10 + 2 * half)) { pg8::EpiStore E{(pg8::bf16_t*)(ws + WS_U), NUP, NUP, 0, nullptr}; GEMM_CALL(pg8::EpiStore, HB + (size_t)half * MH * D, ws + WS_WUP, MH, NUP, D, E); SEAM(); }
        if (IN(11 + 2 * half)) { conv_phase(P, half); SEAM(); }
    }
#endif
    if (IN(14)) { pg8::EpiRes E{P.out, (float*)(ws + WS_X2), D}; GEMM_CALL(pg8::EpiRes, ws + WS_ACT, ws + WS_WDN, M, D, DFFP, E); SEAM(); }
    if (IN(15)) { for (int m = bx * 8 + wv; m < M; m += G * 16) rms_rows2_f32(ws + WS_X2, P.out, m, m + G * 8, P.in[I_NFG], lane); }
#ifdef DBG_DUMP
    if (IN(20)) { const bf16* src = (const bf16*)(ws + DBG_SRC); for (size_t i = (size_t)bx * 512 + tid; i < (size_t)M * D; i += (size_t)G * 512) P.out[i] = bfl(src[i]); }
#endif
}

extern "C" void kernel_launch(void* const* d_in, const int* in_sizes, int n_in, void* d_out, int out_size, void* d_ws, size_t ws_size, hipStream_t stream) {
    static int grid = 0;
    if (grid == 0) {
        if (n_in != 31 || in_sizes[0] != M * D || out_size != M * D || ws_size < 1024 * MiB) { fprintf(stderr, "kernel_launch: unexpected shapes (n_in %d, in0 %d, out %d, ws %zu)\n", n_in, n_in > 0 ? in_sizes[0] : -1, out_size, ws_size); grid = -1; return; }
        int dev = 0, cus = 0, per_cu = 0;
        if (hipGetDevice(&dev) != hipSuccess || hipDeviceGetAttribute(&cus, hipDeviceAttributeMultiprocessorCount, dev) != hipSuccess) { grid = -1; return; }
        if (hipFuncSetAttribute((const void*)fwd_kernel, hipFuncAttributeMaxDynamicSharedMemorySize, LDS_BYTES) != hipSuccess) { fprintf(stderr, "kernel_launch: hipFuncSetAttribute failed\n"); grid = -1; return; }
        if (hipOccupancyMaxActiveBlocksPerMultiprocessor(&per_cu, (const void*)fwd_kernel, 512, LDS_BYTES) != hipSuccess || per_cu < 1) { fprintf(stderr, "kernel_launch: occupancy query says %d\n", per_cu); per_cu = 1; }
        (void)hipGetLastError();
        grid = cus * 1;
    }
    if (grid < 0) return;
    Params p{};
    for (int i = 0; i < 31; ++i) p.in[i] = (const float*)d_in[i];
    p.out = (float*)d_out; p.ws = (unsigned char*)d_ws;
#if N_PHASE_LAUNCH
#ifdef DBG_DUMP
    for (int ph = 0; ph <= DBG_DUMP; ++ph) { if (DBG_SKIPMASK & (1 << ph)) continue; hipLaunchKernelGGL(fwd_kernel, dim3(grid), dim3(512), LDS_BYTES, stream, p, ph, ph + 1); }
    if (DBG_DUMP < 14) hipLaunchKernelGGL(fwd_kernel, dim3(grid), dim3(512), LDS_BYTES, stream, p, 20, 21);
#else
    for (int ph = 0; ph < NPHASES; ++ph) { hipLaunchKernelGGL(fwd_kernel, dim3(grid), dim3(512), LDS_BYTES, stream, p, ph, ph + 1); }
#endif
#else
    if (hipMemsetAsync(d_ws, 0, 65536 + 262144, stream) != hipSuccess) { fprintf(stderr, "kernel_launch: memset failed\n"); return; }
    int lo = 0, hi = NPHASES;
    void* args[] = {&p, &lo, &hi};
    hipError_t e = hipLaunchCooperativeKernel((const void*)fwd_kernel, dim3(grid), dim3(512), args, LDS_BYTES, stream);
    if (e != hipSuccess) fprintf(stderr, "kernel_launch: cooperative launch failed: %s (grid %d)\n", hipGetErrorString(e), grid);
#endif
}
```

```cpp
#include <hip/hip_runtime.h>
#include <hip/hip_cooperative_groups.h>
#include <cstdio>
#include <cstdint>
namespace cg = cooperative_groups;
#define N_PHASE_LAUNCH 0
#define FUSE_NORM2 0
namespace pg8 {
#define PG8_LAS __attribute__((address_space(3)))
typedef unsigned short bf16_t;
typedef short bf16x8 __attribute__((ext_vector_type(8)));
typedef float f32x4 __attribute__((ext_vector_type(4)));
typedef unsigned u32x4 __attribute__((ext_vector_type(4)));
constexpr int BM = 256, BK = 64, HALF = 128, HTB = HALF * BK * 2  , STAGE_BYTES = 8 * HTB, NXCD = 8, WGM = 8;

__host__ __device__ __forceinline__ int lds_byte(int r, int c) { const int st = (r >> 4) * 2 + (c >> 5), rr = r & 15, cc = c & 31, ob = rr * 64 + cc * 2; return st * 1024 + (ob ^ (((ob >> 9) & 1) << 5)); }
__host__ __device__ __forceinline__ void stage_rc(int b, int& R, int& C) { const int st = b / 1024, sb = b % 1024, swz = sb ^ (((sb >> 9) & 1) << 5); R = (st >> 1) * 16 + swz / 64; C = (st & 1) * 32 + (swz % 64) / 2; }
__host__ __device__ __forceinline__ int perm32(int rho) { const int n = rho >> 4, i = rho & 15; return 8 * (i >> 2) + 4 * n + (i & 3); }

struct Unit { int pm, pn; };
struct Gemm { const bf16_t* A; const bf16_t* Bt; int M, N, K; };

struct StaticOrder {
    int nM, nN, nwg, G, c;
    __host__ __device__ void init(int M, int N, int G_, int c_) { nM = M / BM; nN = N / BM; nwg = nM * nN; G = G_; c = c_; }
    __host__ __device__ bool next(int i, Unit& u) const {
        const long L = (long)i * G + c; if (L >= nwg) return false;
        int wgid = (int)L; { const int q = nwg / NXCD, r = nwg % NXCD, xcd = wgid % NXCD, off = wgid / NXCD; wgid = (xcd < r ? xcd * (q + 1) : r * (q + 1) + (xcd - r) * q) + off; }
        const int nig = WGM * nN, gid = wgid / nig, fm = gid * WGM, gsz = (nM - fm) < WGM ? (nM - fm) : WGM;
        u.pm = fm + ((wgid % nig) % gsz); u.pn = (wgid % nig) / gsz; return true;
    }
    __device__ __forceinline__ void a_ready(const Unit&) const {}
    __device__ __forceinline__ void done(const Unit&) const {}
};

__device__ __forceinline__ unsigned cvt_pk_bf16(float lo, float hi) { unsigned r; asm volatile("v_cvt_pk_bf16_f32 %0, %1, %2" : "=v"(r) : "v"(lo), "v"(hi)); return r; }

template <class Epi, class Sched, bool ALIGN_EPI = false, bool SP2 = false>
__device__ __forceinline__ void gemm_phase(PG8_LAS unsigned char* lds, const Gemm g, const Sched& S, const Epi& E) {
    const int tid = threadIdx.x, wid = __builtin_amdgcn_readfirstlane(tid >> 6), lane = tid & 63, wr = wid >> 2, wc = wid & 3, fr = lane & 15, fq = lane >> 4;
    const int K = g.K, nt = K / BK;
    unsigned voffA[2], voffB[2];
#pragma unroll
    for (int i = 0; i < 2; ++i) { int R, C; stage_rc(tid * 16 + i * 8192, R, C); const int Rb = Epi::PERM ? ((R & ~31) + perm32(R & 31)) : R;
        voffA[i] = (unsigned)(R * K + C) * 2u; voffB[i] = (unsigned)(Rb * K + C) * 2u; }
    const size_t kstep = (size_t)(BK * 2);
    const size_t hstep = (size_t)HALF * K * 2;
    const size_t tstep = 2 * hstep;
    const unsigned ldsw = (unsigned)wid * 1024u;
    const int aoff = lds_byte(wr * 64 + fr, fq * 8), boff = lds_byte(wc * 32 + fr, fq * 8);
#define PG8_SA(b, h) (((b) * 2 + (h)) * HTB)
#define PG8_SB(b, h) ((4 + (b) * 2 + (h)) * HTB)
#define PG8_STAGE(bufoff, gbase, voff) do { _Pragma("unroll") for (int _i = 0; _i < 2; ++_i) \
        __builtin_amdgcn_global_load_lds((const unsigned*)((const char*)(gbase) + (voff)[_i]), (PG8_LAS unsigned*)(lds + (bufoff) + ldsw + _i * 8192), 16, 0, 0); } while (0)
#define PG8_LDA(dst, b, h) do { _Pragma("unroll") for (int m = 0; m < 4; ++m) _Pragma("unroll") for (int k = 0; k < 2; ++k) dst[m][k] = *(const PG8_LAS bf16x8*)(lds + PG8_SA(b, h) + aoff + m * 2048 + k * 1024); } while (0)
#define PG8_LDB(dst, b, h) do { _Pragma("unroll") for (int n = 0; n < 2; ++n) _Pragma("unroll") for (int k = 0; k < 2; ++k) dst[n][k] = *(const PG8_LAS bf16x8*)(lds + PG8_SB(b, h) + boff + n * 2048 + k * 1024); } while (0)
#define PG8_MMA(ai, bj, At, Bt) do { __builtin_amdgcn_s_setprio(1); _Pragma("unroll") for (int m = 0; m < 4; ++m) _Pragma("unroll") for (int n = 0; n < 2; ++n) _Pragma("unroll") for (int k = 0; k < 2; ++k) \
        acc[ai][bj][m][n] = __builtin_amdgcn_mfma_f32_16x16x32_bf16(Bt[n][k], At[m][k], acc[ai][bj][m][n], 0, 0, 0); __builtin_amdgcn_s_setprio(0); } while (0)
#define PG8_WAIT_V(n) asm volatile("s_waitcnt vmcnt(" #n ")" ::: "memory")
#define PG8_WAIT_L(n) asm volatile("s_waitcnt lgkmcnt(" #n ")" ::: "memory")
#define PG8_BAR __builtin_amdgcn_s_barrier()
#define PG8_SCHED __builtin_amdgcn_sched_barrier(0)
    Unit cur, nxt; int ui = 0;
    if (!S.next(0, cur)) return;
    f32x4 acc[2][2][4][2];
#pragma unroll
    for (int a = 0; a < 2; ++a)
#pragma unroll
        for (int b = 0; b < 2; ++b)
#pragma unroll
            for (int m = 0; m < 4; ++m)
#pragma unroll
                for (int n = 0; n < 2; ++n) acc[a][b][m][n] = (f32x4){0.f, 0.f, 0.f, 0.f};
    bf16x8 At[4][2], B0[2][2], B1[2][2];
    const char* cA = (const char*)g.A + (size_t)cur.pm * tstep; const char* cB = (const char*)g.Bt + (size_t)cur.pn * tstep;
    S.a_ready(cur);
    if constexpr (SP2) {
        PG8_STAGE(PG8_SB(0, 0), cB, voffB); PG8_STAGE(PG8_SB(0, 1), cB + hstep, voffB); PG8_STAGE(PG8_SA(0, 0), cA, voffA); PG8_STAGE(PG8_SA(0, 1), cA + hstep, voffA);
        if (wr == 1) PG8_BAR;
        PG8_WAIT_V(2); PG8_BAR;
        PG8_STAGE(PG8_SB(1, 0), cB + kstep, voffB); PG8_STAGE(PG8_SA(1, 0), cA + kstep, voffA); PG8_STAGE(PG8_SB(1, 1), cB + hstep + kstep, voffB);
        PG8_WAIT_V(6); PG8_BAR;
    } else {
        PG8_STAGE(PG8_SB(0, 0), cB, voffB); PG8_STAGE(PG8_SA(0, 0), cA, voffA); PG8_STAGE(PG8_SB(0, 1), cB + hstep, voffB); PG8_STAGE(PG8_SA(0, 1), cA + hstep, voffA);
        if (wr == 1) PG8_BAR;
        PG8_WAIT_V(4); PG8_BAR;
        PG8_STAGE(PG8_SB(1, 0), cB + kstep, voffB); PG8_STAGE(PG8_SA(1, 0), cA + kstep, voffA); PG8_STAGE(PG8_SB(1, 1), cB + hstep + kstep, voffB);
        PG8_WAIT_V(6); PG8_BAR;
    }
    for (;;) {
        const bool has_next = S.next(ui + 1, nxt);
        const char* nA = has_next ? (const char*)g.A + (size_t)nxt.pm * tstep : cA; const char* nB = has_next ? (const char*)g.Bt + (size_t)nxt.pn * tstep : cB;
        for (int t = 0; t < nt; t += 2) {
            if constexpr (Epi::MID) { if (t == (nt >> 1)) {
                __builtin_amdgcn_sched_barrier(0); asm volatile("s_nop 7\n\ts_nop 7" ::: "memory"); __builtin_amdgcn_sched_barrier(0);
                E.mid(acc, cur, wr, wc, fr, fq);
                __builtin_amdgcn_sched_barrier(0); asm volatile("s_nop 7" ::: "memory"); __builtin_amdgcn_sched_barrier(0); } }
            const bool last = (t == nt - 2);
            const char* a1 = cA + (size_t)(t + 1) * kstep;
            const char* a2 = last ? nA : cA + (size_t)(t + 2) * kstep; const char* b2 = last ? nB : cB + (size_t)(t + 2) * kstep;
            const char* a3 = a2 + kstep; const char* b3 = b2 + kstep;
            if (last && has_next) S.a_ready(nxt);
            if constexpr (SP2) {
            PG8_LDB(B0, 0, 0); PG8_LDB(B1, 0, 1); PG8_SCHED; PG8_LDA(At, 0, 0); PG8_STAGE(PG8_SA(1, 1), a1 + hstep, voffA);
            PG8_WAIT_V(8); PG8_WAIT_L(0); PG8_BAR; PG8_MMA(0, 0, At, B0); PG8_MMA(0, 1, At, B1); PG8_BAR; PG8_SCHED;
            PG8_LDA(At, 0, 1); PG8_STAGE(PG8_SB(0, 0), b2, voffB); PG8_STAGE(PG8_SB(0, 1), b2 + hstep, voffB); PG8_STAGE(PG8_SA(0, 0), a2, voffA);
            PG8_WAIT_V(8); PG8_WAIT_L(0); PG8_BAR; PG8_MMA(1, 0, At, B0); PG8_MMA(1, 1, At, B1); PG8_BAR; PG8_SCHED;
            PG8_LDB(B0, 1, 0); PG8_LDB(B1, 1, 1); PG8_SCHED; PG8_LDA(At, 1, 0); PG8_STAGE(PG8_SA(0, 1), a2 + hstep, voffA);
            PG8_WAIT_V(8); PG8_WAIT_L(0); PG8_BAR; PG8_MMA(0, 0, At, B0); PG8_MMA(0, 1, At, B1); PG8_BAR; PG8_SCHED;
            PG8_LDA(At, 1, 1); PG8_STAGE(PG8_SB(1, 0), b3, voffB); PG8_STAGE(PG8_SB(1, 1), b3 + hstep, voffB); PG8_STAGE(PG8_SA(1, 0), a3, voffA);
            PG8_WAIT_V(8); PG8_WAIT_L(0); PG8_BAR; PG8_MMA(1, 0, At, B0); PG8_MMA(1, 1, At, B1); PG8_BAR; PG8_SCHED;
            } else {
            PG8_LDB(B0, 0, 0); PG8_SCHED; PG8_LDA(At, 0, 0); PG8_STAGE(PG8_SA(1, 1), a1 + hstep, voffA);
            PG8_WAIT_L(8); PG8_BAR; PG8_WAIT_L(0); PG8_MMA(0, 0, At, B0); PG8_BAR; PG8_SCHED;
            PG8_LDB(B1, 0, 1); PG8_STAGE(PG8_SB(0, 0), b2, voffB);
            PG8_BAR; PG8_WAIT_L(0); PG8_MMA(0, 1, At, B1); PG8_BAR;
            PG8_LDA(At, 0, 1); PG8_STAGE(PG8_SA(0, 0), a2, voffA);
            PG8_BAR; PG8_WAIT_L(0); PG8_MMA(1, 0, At, B0); PG8_BAR; PG8_SCHED;
            PG8_STAGE(PG8_SB(0, 1), b2 + hstep, voffB);
            PG8_WAIT_V(6); PG8_BAR; PG8_MMA(1, 1, At, B1); PG8_BAR;
            PG8_LDB(B0, 1, 0); PG8_SCHED; PG8_LDA(At, 1, 0); PG8_STAGE(PG8_SA(0, 1), a2 + hstep, voffA);
            PG8_WAIT_L(8); PG8_BAR; PG8_WAIT_L(0); PG8_MMA(0, 0, At, B0); PG8_BAR; PG8_SCHED;
            PG8_LDB(B1, 1, 1); PG8_STAGE(PG8_SB(1, 0), b3, voffB);
            PG8_BAR; PG8_WAIT_L(0); PG8_MMA(0, 1, At, B1); PG8_BAR;
            PG8_LDA(At, 1, 1); PG8_STAGE(PG8_SA(1, 0), a3, voffA);
            PG8_BAR; PG8_WAIT_L(0); PG8_MMA(1, 0, At, B0); PG8_BAR; PG8_SCHED;
            PG8_STAGE(PG8_SB(1, 1), b3 + hstep, voffB);
            PG8_WAIT_V(6); PG8_BAR; PG8_MMA(1, 1, At, B1); PG8_BAR;
            }
        }
        if constexpr (ALIGN_EPI) { if (wr == 0) PG8_BAR; }
        __builtin_amdgcn_sched_barrier(0); asm volatile("s_nop 7\n\ts_nop 7" ::: "memory"); __builtin_amdgcn_sched_barrier(0);
        if constexpr (!Epi::AFTER_DRAIN) { E(acc, cur, wr, wc, fr, fq); S.done(cur); }
        if (!has_next) break;
#pragma unroll
        for (int a = 0; a < 2; ++a)
#pragma unroll
            for (int b = 0; b < 2; ++b)
#pragma unroll
                for (int m = 0; m < 4; ++m)
#pragma unroll
                    for (int n = 0; n < 2; ++n) acc[a][b][m][n] = (f32x4){0.f, 0.f, 0.f, 0.f};
        cur = nxt; cA = nA; cB = nB; ++ui;
        if constexpr (ALIGN_EPI) { if (wr == 1) PG8_BAR; }
    }
    PG8_WAIT_V(0);
    if constexpr (!ALIGN_EPI) { if (wr == 0) PG8_BAR; }
    PG8_BAR;
    if constexpr (Epi::AFTER_DRAIN) { E.fused(acc, cur, wr, wc, fr, fq, lds, wid, lane); S.done(cur); }
#undef PG8_SA
#undef PG8_SB
#undef PG8_STAGE
#undef PG8_LDA
#undef PG8_LDB
#undef PG8_MMA
#undef PG8_WAIT_V
#undef PG8_WAIT_L
#undef PG8_BAR
#undef PG8_SCHED
}
}

#ifndef PG8_SP2
#define PG8_SP2 true
#endif
#ifndef PG8_ALIGN
#define PG8_ALIGN true
#endif
namespace pg8 {
typedef unsigned u32x2 __attribute__((ext_vector_type(2)));
__device__ __forceinline__ float bfl(unsigned w) { return __uint_as_float(w << 16); }
__device__ __forceinline__ float bfh(unsigned w) { return __uint_as_float(w & 0xffff0000u); }
__device__ __forceinline__ float sigm(float x) { return __builtin_amdgcn_rcpf(1.0f + __expf(-x)); }
struct EpiStore {
    static constexpr bool PERM = true, AFTER_DRAIN = false, MID = false;
    bf16_t* O; int ldc; int nvalid; int split_cols; bf16_t* O2;
    __device__ __forceinline__ void operator()(const f32x4 (&acc)[2][2][4][2], const Unit& u, int wr, int wc, int fr, int fq) const {
        const int row0 = u.pm * BM + wr * 64 + fr; int colt = u.pn * BM; bf16_t* base = O;
        if (split_cols && colt >= split_cols) { base = O2; colt -= split_cols; }
        const int col0 = colt + wc * 32 + 8 * fq;
#pragma unroll
        for (int ai = 0; ai < 2; ++ai)
#pragma unroll
            for (int m = 0; m < 4; ++m) { bf16_t* rowp = base + (size_t)(row0 + ai * HALF + m * 16) * ldc + col0;
#pragma unroll
                for (int bj = 0; bj < 2; ++bj) { const f32x4 v0 = acc[ai][bj][m][0], v1 = acc[ai][bj][m][1];
                    u32x4 w; w.x = cvt_pk_bf16(v0[0], v0[1]); w.y = cvt_pk_bf16(v0[2], v0[3]); w.z = cvt_pk_bf16(v1[0], v1[1]); w.w = cvt_pk_bf16(v1[2], v1[3]);
                    if (col0 + bj * HALF + 8 <= nvalid) *(u32x4*)(rowp + bj * HALF) = w; } }
    }
};
template <int MODE> struct EpiGate {
    static constexpr bool PERM = true, AFTER_DRAIN = false, MID = false;
    const bf16_t* G; bf16_t* O; int ldc;
    __device__ __forceinline__ void operator()(const f32x4 (&acc)[2][2][4][2], const Unit& u, int wr, int wc, int fr, int fq) const {
        const int row0 = u.pm * BM + wr * 64 + fr; const int col0 = u.pn * BM + wc * 32 + 8 * fq;
#pragma unroll
        for (int ai = 0; ai < 2; ++ai)
#pragma unroll
            for (int m = 0; m < 4; ++m) { const size_t off = (size_t)(row0 + ai * HALF + m * 16) * ldc + col0;
#pragma unroll
                for (int bj = 0; bj < 2; ++bj) { const f32x4 v0 = acc[ai][bj][m][0], v1 = acc[ai][bj][m][1];
                    const u32x4 g = *(const u32x4*)(G + off + bj * HALF);
                    float r0 = sigm(bfl(g.x)) * v0[0], r1 = sigm(bfh(g.x)) * v0[1], r2 = sigm(bfl(g.y)) * v0[2], r3 = sigm(bfh(g.y)) * v0[3];
                    float r4 = sigm(bfl(g.z)) * v1[0], r5 = sigm(bfh(g.z)) * v1[1], r6 = sigm(bfl(g.w)) * v1[2], r7 = sigm(bfh(g.w)) * v1[3];
                    if (MODE == 1) { const u32x4 p = *(const u32x4*)(O + off + bj * HALF);
                        r0 += bfl(p.x); r1 += bfh(p.x); r2 += bfl(p.y); r3 += bfh(p.y); r4 += bfl(p.z); r5 += bfh(p.z); r6 += bfl(p.w); r7 += bfh(p.w); }
                    u32x4 w; w.x = cvt_pk_bf16(r0, r1); w.y = cvt_pk_bf16(r2, r3); w.z = cvt_pk_bf16(r4, r5); w.w = cvt_pk_bf16(r6, r7);
                    *(u32x4*)(O + off + bj * HALF) = w; } }
    }
};
struct EpiMerge {
    static constexpr bool PERM = true, AFTER_DRAIN = false, MID = true;
    const bf16_t* GA; const bf16_t* GB; bf16_t* O; int ldc;
    template <bool DIV> __device__ __forceinline__ void scale_pass(f32x4 (&acc)[2][2][4][2], const bf16_t* G, const Unit& u, int wr, int wc, int fr, int fq) const {
        const int row0 = u.pm * BM + wr * 64 + fr; const int col0 = u.pn * BM + wc * 32 + 8 * fq;
#pragma unroll
        for (int ai = 0; ai < 2; ++ai)
#pragma unroll
            for (int m = 0; m < 4; ++m) { const size_t off = (size_t)(row0 + ai * HALF + m * 16) * ldc + col0;
#pragma unroll
                for (int bj = 0; bj < 2; ++bj) { const u32x4 g = *(const u32x4*)(G + off + bj * HALF);
                    f32x4 r0, r1;
                    r0[0] = 1.f + __expf(-bfl(g.x)); r0[1] = 1.f + __expf(-bfh(g.x)); r0[2] = 1.f + __expf(-bfl(g.y)); r0[3] = 1.f + __expf(-bfh(g.y));
                    r1[0] = 1.f + __expf(-bfl(g.z)); r1[1] = 1.f + __expf(-bfh(g.z)); r1[2] = 1.f + __expf(-bfl(g.w)); r1[3] = 1.f + __expf(-bfh(g.w));
                    if (DIV) {
#pragma unroll
                        for (int i = 0; i < 4; ++i) { r0[i] = __builtin_amdgcn_rcpf(r0[i]); r1[i] = __builtin_amdgcn_rcpf(r1[i]); } }
                    acc[ai][bj][m][0] = acc[ai][bj][m][0] * r0; acc[ai][bj][m][1] = acc[ai][bj][m][1] * r1;
                    asm volatile("" ::: "memory"); } }
    }
    __device__ __forceinline__ void mid(f32x4 (&acc)[2][2][4][2], const Unit& u, int wr, int wc, int fr, int fq) const {
        scale_pass<false>(acc, GB, u, wr, wc, fr, fq); scale_pass<true>(acc, GA, u, wr, wc, fr, fq);
    }
    __device__ __forceinline__ void operator()(const f32x4 (&acc)[2][2][4][2], const Unit& u, int wr, int wc, int fr, int fq) const {
        const int row0 = u.pm * BM + wr * 64 + fr; const int col0 = u.pn * BM + wc * 32 + 8 * fq;
#pragma unroll
        for (int ai = 0; ai < 2; ++ai)
#pragma unroll
            for (int m = 0; m < 4; ++m) { const size_t off = (size_t)(row0 + ai * HALF + m * 16) * ldc + col0;
#pragma unroll
                for (int bj = 0; bj < 2; ++bj) { const f32x4 v0 = acc[ai][bj][m][0], v1 = acc[ai][bj][m][1];
                    const u32x4 g = *(const u32x4*)(GB + off + bj * HALF);
                    u32x4 w; w.x = cvt_pk_bf16(sigm(bfl(g.x)) * v0[0], sigm(bfh(g.x)) * v0[1]); w.y = cvt_pk_bf16(sigm(bfl(g.y)) * v0[2], sigm(bfh(g.y)) * v0[3]);
                    w.z = cvt_pk_bf16(sigm(bfl(g.z)) * v1[0], sigm(bfh(g.z)) * v1[1]); w.w = cvt_pk_bf16(sigm(bfl(g.w)) * v1[2], sigm(bfh(g.w)) * v1[3]);
                    *(u32x4*)(O + off + bj * HALF) = w; } }
    }
};
struct EpiRes {
    static constexpr bool PERM = false, AFTER_DRAIN = false, MID = false;
    const float* base; float* out; int ldc;
    __device__ __forceinline__ void operator()(const f32x4 (&acc)[2][2][4][2], const Unit& u, int wr, int wc, int fr, int fq) const {
        const int row0 = u.pm * BM + wr * 64 + fr; const int col0 = u.pn * BM + wc * 32 + 4 * fq;
#pragma unroll
        for (int ai = 0; ai < 2; ++ai)
#pragma unroll
            for (int m = 0; m < 4; ++m) { const size_t off = (size_t)(row0 + ai * HALF + m * 16) * ldc + col0;
#pragma unroll
                for (int bj = 0; bj < 2; ++bj)
#pragma unroll
                    for (int n = 0; n < 2; ++n) { const f32x4 b = *(const f32x4*)(base + off + bj * HALF + n * 16); *(f32x4*)(out + off + bj * HALF + n * 16) = b + acc[ai][bj][m][n]; } }
    }
};

struct EpiResBf16 {
    static constexpr bool PERM = false, AFTER_DRAIN = false, MID = false;
    const float* base; bf16_t* out; int ldc;
    __device__ __forceinline__ void operator()(const f32x4 (&acc)[2][2][4][2], const Unit& u, int wr, int wc, int fr, int fq) const {
        const int row0 = u.pm * BM + wr * 64 + fr; const int col0 = u.pn * BM + wc * 32 + 4 * fq;
#pragma unroll
        for (int ai = 0; ai < 2; ++ai)
#pragma unroll
            for (int m = 0; m < 4; ++m) { const size_t off = (size_t)(row0 + ai * HALF + m * 16) * ldc + col0;
#pragma unroll
                for (int bj = 0; bj < 2; ++bj)
#pragma unroll
                    for (int n = 0; n < 2; ++n) { const f32x4 x = *(const f32x4*)(base + off + bj * HALF + n * 16) + acc[ai][bj][m][n];
                        u32x2 w; w.x = cvt_pk_bf16(x[0], x[1]); w.y = cvt_pk_bf16(x[2], x[3]); *(u32x2*)(out + off + bj * HALF + n * 16) = w; } }
    }
};
struct EpiResNorm {
    static constexpr bool PERM = false, AFTER_DRAIN = false, MID = false;
    const float* base; float* out; bf16_t* H; const float* g; float* SS; int ldc;
    __device__ __forceinline__ void operator()(const f32x4 (&acc)[2][2][4][2], const Unit& u, int wr, int wc, int fr, int fq) const {
        const int row0 = u.pm * BM + wr * 64 + fr; const int col0 = u.pn * BM + wc * 32 + 4 * fq;
#pragma unroll
        for (int ai = 0; ai < 2; ++ai)
#pragma unroll
            for (int m = 0; m < 4; ++m) { const int row = row0 + ai * HALF + m * 16; const size_t off = (size_t)row * ldc + col0; float ss = 0.f;
#pragma unroll
                for (int bj = 0; bj < 2; ++bj)
#pragma unroll
                    for (int n = 0; n < 2; ++n) { const f32x4 x1 = *(const f32x4*)(base + off + bj * HALF + n * 16) + acc[ai][bj][m][n]; *(f32x4*)(out + off + bj * HALF + n * 16) = x1;
                        ss += (x1[0] * x1[0] + x1[1] * x1[1]) + (x1[2] * x1[2] + x1[3] * x1[3]);
                        const f32x4 hh = x1 * *(const f32x4*)(g + col0 + bj * HALF + n * 16);
                        u32x2 w; w.x = cvt_pk_bf16(hh[0], hh[1]); w.y = cvt_pk_bf16(hh[2], hh[3]); *(u32x2*)(H + off + bj * HALF + n * 16) = w; }
                ss += __shfl_xor(ss, 16); ss += __shfl_xor(ss, 32);
                if (fq == 0) (void)__hip_atomic_fetch_add(SS + row, ss, __ATOMIC_RELAXED, __HIP_MEMORY_SCOPE_AGENT); }
    }
};
__device__ __forceinline__ f32x4 dpp_shr1(f32x4 v) { f32x4 r;
#pragma unroll
    for (int i = 0; i < 4; ++i) { const float t = v[i]; r[i] = __int_as_float(__builtin_amdgcn_update_dpp(0, __float_as_int(t), 0x111, 0xF, 0xF, true)); }
    return r; }
__device__ __forceinline__ f32x4 dpp_shl1(f32x4 v) { f32x4 r;
#pragma unroll
    for (int i = 0; i < 4; ++i) { const float t = v[i]; r[i] = __int_as_float(__builtin_amdgcn_update_dpp(0, __float_as_int(t), 0x101, 0xF, 0xF, true)); }
    return r; }
__device__ __forceinline__ f32x4 dpp_mirror(f32x4 v) { f32x4 r;
#pragma unroll
    for (int i = 0; i < 4; ++i) { const float t = v[i]; r[i] = __int_as_float(__builtin_amdgcn_update_dpp(0, __float_as_int(t), 0x140, 0xF, 0xF, true)); }
    return r; }
struct EpiConv {
    static constexpr bool PERM = true, AFTER_DRAIN = false, MID = false;
    bf16_t* ACT; float* SB; const float* cw; const float* cb; PG8_LAS float* xe; bf16_t* Udbg; const float* SS;
    __device__ __forceinline__ void operator()(const f32x4 (&acc)[2][2][4][2], const Unit& u, int wr, int wc, int fr, int fq) const {
        constexpr int FF = 2752, FFP = 2816, NSRC = 5504, NU = 5632;
        if (SS) {
            f32x4 (&sa)[2][2][4][2] = const_cast<f32x4 (&)[2][2][4][2]>(acc);
#pragma unroll
            for (int ai = 0; ai < 2; ++ai)
#pragma unroll
                for (int m = 0; m < 4; ++m) { const float q = __hip_atomic_load(SS + u.pm * BM + ai * HALF + wr * 64 + m * 16 + fr, __ATOMIC_RELAXED, __HIP_MEMORY_SCOPE_AGENT);
                    const float rs = 1.0f / sqrtf(q * (1.0f / 1024.0f) + 1e-6f);
#pragma unroll
                    for (int bj = 0; bj < 2; ++bj)
#pragma unroll
                        for (int n = 0; n < 2; ++n) sa[ai][bj][m][n] = sa[ai][bj][m][n] * rs; } }
#pragma unroll
        for (int ai = 0; ai < 2; ++ai) { const int slab = 2 * ai + wr;
#pragma unroll
            for (int bj = 0; bj < 2; ++bj)
#pragma unroll
                for (int n = 0; n < 2; ++n) {
                    if (fr == 0) *(PG8_LAS f32x4*)(xe + ((slab * 2 + 0) * 4 + wc) * 64 + bj * 32 + fq * 8 + n * 4) = acc[ai][bj][0][n];
                    if (fr == 15) *(PG8_LAS f32x4*)(xe + ((slab * 2 + 1) * 4 + wc) * 64 + bj * 32 + fq * 8 + n * 4) = acc[ai][bj][3][n]; } }
        if (Udbg && u.pm < 128) { const int row0 = u.pm * BM + wr * 64 + fr, col0 = u.pn * BM + wc * 32 + 8 * fq;
#pragma unroll
            for (int ai = 0; ai < 2; ++ai)
#pragma unroll
                for (int m = 0; m < 4; ++m)
#pragma unroll
                    for (int bj = 0; bj < 2; ++bj) { const f32x4 v0 = acc[ai][bj][m][0], v1 = acc[ai][bj][m][1]; u32x4 w; w.x = cvt_pk_bf16(v0[0], v0[1]); w.y = cvt_pk_bf16(v0[2], v0[3]); w.z = cvt_pk_bf16(v1[0], v1[1]); w.w = cvt_pk_bf16(v1[2], v1[3]);
                        *(u32x4*)(Udbg + (size_t)(row0 + ai * HALF + m * 16) * NU + col0 + bj * HALF) = w; } }
        { const int colb = u.pn * BM + wc * 32 + 8 * fq;
          if (wr == 0 && fr < 2) {
#pragma unroll
              for (int bj = 0; bj < 2; ++bj)
#pragma unroll
                  for (int n = 0; n < 2; ++n) *(f32x4*)(SB + (size_t)(u.pm * 4 + fr) * NU + colb + bj * HALF + 4 * n) = acc[0][bj][0][n]; }
          if (wr == 1 && fr >= 14) {
#pragma unroll
              for (int bj = 0; bj < 2; ++bj)
#pragma unroll
                  for (int n = 0; n < 2; ++n) *(f32x4*)(SB + (size_t)(u.pm * 4 + 2 + (fr - 14)) * NU + colb + bj * HALF + 4 * n) = acc[1][bj][3][n]; } }
        asm volatile("s_waitcnt lgkmcnt(0)" ::: "memory"); __builtin_amdgcn_s_barrier(); asm volatile("" ::: "memory");
        const int j0 = u.pn * 128 + wc * 32 + fq * 8;
        const f32x4 z4 = (f32x4){0.f, 0.f, 0.f, 0.f};
#pragma unroll
        for (int n = 0; n < 2; ++n) { const int jn = j0 + 4 * n; const bool valid = jn < FF;
            f32x4 wg0 = z4, wg1 = z4, wg2 = z4, wv0 = z4, wv1 = z4, wv2 = z4, bg = z4, bv = z4;
            if (valid) { wg0 = *(const f32x4*)(cw + jn); wg1 = *(const f32x4*)(cw + NSRC + jn); wg2 = *(const f32x4*)(cw + 2 * NSRC + jn);
                         wv0 = *(const f32x4*)(cw + FF + jn); wv1 = *(const f32x4*)(cw + NSRC + FF + jn); wv2 = *(const f32x4*)(cw + 2 * NSRC + FF + jn);
                         bg = *(const f32x4*)(cb + jn); bv = *(const f32x4*)(cb + FF + jn); }
#pragma unroll
            for (int ai = 0; ai < 2; ++ai) { const int slab = 2 * ai + wr;
                f32x4 topg = z4, topv = z4, botg = z4, botv = z4;
                if (slab > 0) { topg = *(const PG8_LAS f32x4*)(xe + (((slab - 1) * 2 + 1) * 4 + wc) * 64 + fq * 8 + n * 4); topv = *(const PG8_LAS f32x4*)(xe + (((slab - 1) * 2 + 1) * 4 + wc) * 64 + 32 + fq * 8 + n * 4); }
                if (slab < 3) { botg = *(const PG8_LAS f32x4*)(xe + (((slab + 1) * 2 + 0) * 4 + wc) * 64 + fq * 8 + n * 4); botv = *(const PG8_LAS f32x4*)(xe + (((slab + 1) * 2 + 0) * 4 + wc) * 64 + 32 + fq * 8 + n * 4); }
#pragma unroll
                for (int m = 0; m < 4; ++m) { const f32x4 eg = acc[ai][0][m][n], ev = acc[ai][1][m][n];
                    f32x4 upg = dpp_shr1(eg), upv = dpp_shr1(ev), dng = dpp_shl1(eg), dnv = dpp_shl1(ev);
                    const f32x4 ag = (m > 0) ? dpp_mirror(acc[ai][0][m > 0 ? m - 1 : 0][n]) : topg, av = (m > 0) ? dpp_mirror(acc[ai][1][m > 0 ? m - 1 : 0][n]) : topv;
                    const f32x4 cg2 = (m < 3) ? dpp_mirror(acc[ai][0][m < 3 ? m + 1 : 3][n]) : botg, cv2 = (m < 3) ? dpp_mirror(acc[ai][1][m < 3 ? m + 1 : 3][n]) : botv;
                    if (fr == 0) { upg = ag; upv = av; }
                    if (fr == 15) { dng = cg2; dnv = cv2; }
                    const f32x4 g = wg0 * upg + wg1 * eg + wg2 * dng + bg, v = wv0 * upv + wv1 * ev + wv2 * dnv + bv;
                    f32x4 o;
#pragma unroll
                    for (int i = 0; i < 4; ++i) o[i] = valid ? g[i] * sigm(g[i]) * v[i] : 0.f;
                    const int rt = ai * HALF + wr * 64 + m * 16 + fr;
                    if (rt != 0 && rt != 255) { u32x2 w; w.x = cvt_pk_bf16(o[0], o[1]); w.y = cvt_pk_bf16(o[2], o[3]); *(u32x2*)(ACT + (size_t)(u.pm * BM + rt) * FFP + jn) = w; } } }
        }
    }
};
}

constexpr int NB = 32, T = 2048, D = 1024, M = NB * T, MH = M / 2;
constexpr int NMIX = 3360, NMIXP = 3584, NGATE = 2048;
constexpr int DFF = 2752, DFFP = 2816, NUP = 5632, NUPSRC = 5504, NPROJ = 5408;
constexpr int C_GQ = 0, C_GK = 256, C_GV = 512, C_GOG = 1024, C_GAF = 1536, C_GAB = 1552, C_R0 = 1568;
constexpr size_t MiB = 1u << 20;
constexpr size_t WS_WMIX = 1 * MiB, WS_WGATE = 8 * MiB, WS_WGP = 12 * MiB, WS_WRP = 13 * MiB, WS_WOUT = 14 * MiB, WS_WUP = 16 * MiB, WS_WDN = 27 * MiB;
constexpr size_t WS_LW2F = 33 * MiB, WS_LW2B = WS_LW2F + 65536, WS_LA2 = WS_LW2B + 65536, WS_LG2 = WS_LA2 + 65536;
constexpr size_t WS_HB = 36 * MiB, WS_PM = 164 * MiB, WS_GO = 584 * MiB, WS_O = 712 * MiB, WS_E = 840 * MiB, WS_BON = 968 * MiB, WS_END = 970 * MiB;
constexpr size_t WS_H2 = 256 * MiB;
constexpr size_t WS_U = WS_PM, WS_SB = WS_PM, WS_ACT = 516 * MiB, WS_X2 = 36 * MiB;
static_assert(WS_WDN + (size_t)D * DFFP * 2 <= WS_LW2F && WS_LG2 + 131072 <= WS_HB, "weights map");
static_assert(WS_PM + (size_t)M * NMIX * 2 <= WS_GO && WS_U + (size_t)MH * NUP * 2 <= WS_ACT && WS_ACT + (size_t)M * DFFP * 2 <= 1024 * MiB, "ws map");
constexpr int LDS_BYTES = 147456;

#define LAS __attribute__((address_space(3)))
#define DI __device__ __forceinline__
typedef unsigned short bf16;
typedef float f32x4 __attribute__((ext_vector_type(4)));
typedef float f32x2 __attribute__((ext_vector_type(2)));
typedef short bf16x8 __attribute__((ext_vector_type(8)));
typedef unsigned u32x4 __attribute__((ext_vector_type(4)));
typedef unsigned u32x2 __attribute__((ext_vector_type(2)));
typedef _Float16 h16x2 __attribute__((ext_vector_type(2)));
#define LDS_WAIT() asm volatile("s_waitcnt lgkmcnt(0)" ::: "memory")
#define LDS_BARRIER() do { asm volatile("s_waitcnt lgkmcnt(0)" ::: "memory"); __builtin_amdgcn_s_barrier(); asm volatile("" ::: "memory"); } while (0)
#define MFMA16(a, b, c) __builtin_amdgcn_mfma_f32_16x16x32_bf16((a), (b), (c), 0, 0, 0)
#define MFMA_GUARD(v) asm volatile("s_nop 7\n\ts_nop 7" : "+v"(v))

struct Params {
    const float* in[31]; float* out; unsigned char* ws;
};
enum { I_X = 0, I_N1G, I_WIN, I_GWA2F, I_GBAF, I_GWA2B, I_GBAB, I_GNG, I_GPROJ, I_MUP, I_MUN, I_W0F, I_W2F, I_W0B, I_W2B, I_A0, I_A2, I_G2, I_KK, I_KA, I_RK, I_LNW, I_LNB, I_RPROJ,
       I_WOUT, I_N2G, I_FUP, I_FCW, I_FCB, I_FDN, I_NFG };

DI float bfl(unsigned w) { return __uint_as_float(w << 16); }
DI float bfh(unsigned w) { return __uint_as_float(w & 0xffff0000u); }
DI unsigned f2bf(float f) { unsigned u = __float_as_uint(f); return (u + 0x7fffu + ((u >> 16) & 1u)) >> 16; }
typedef __bf16 bf16x2_t __attribute__((ext_vector_type(2)));
DI unsigned pk2(float lo, float hi) { const f32x2 v = {lo, hi}; const bf16x2_t b = __builtin_convertvector(v, bf16x2_t); return __builtin_bit_cast(unsigned, b); }
DI float sigm(float x) { return __builtin_amdgcn_rcpf(1.0f + __expf(-x)); }
DI unsigned pkh2(float lo, float hi) { h16x2 v; v.x = (_Float16)lo; v.y = (_Float16)hi; return __builtin_bit_cast(unsigned, v); }
DI float hlo(unsigned w) { h16x2 v = __builtin_bit_cast(h16x2, w); return (float)v.x; }
DI float hhi(unsigned w) { h16x2 v = __builtin_bit_cast(h16x2, w); return (float)v.y; }
DI float wave_sum(float v) {
#pragma unroll
    for (int o = 1; o < 64; o <<= 1) v += __shfl_xor(v, o);
    return v;
}
DI float quad_sum(float x) {
    x += __builtin_bit_cast(float, __builtin_amdgcn_update_dpp(0, __builtin_bit_cast(int, x), 0xB1, 0xF, 0xF, true));
    x += __builtin_bit_cast(float, __builtin_amdgcn_update_dpp(0, __builtin_bit_cast(int, x), 0x4E, 0xF, 0xF, true));
    return x;
}
DI float oct_sum(float x) {
    x = quad_sum(x);
    x += __builtin_bit_cast(float, __builtin_amdgcn_update_dpp(0, __builtin_bit_cast(int, x), 0x141, 0xF, 0xF, true));
    return x;
}
struct F8 { f32x4 a, b; };
DI F8 unpack8(u32x4 w) { F8 r; r.a = (f32x4){bfl(w.x), bfh(w.x), bfl(w.y), bfh(w.y)}; r.b = (f32x4){bfl(w.z), bfh(w.z), bfl(w.w), bfh(w.w)}; return r; }
DI u32x4 pack8(f32x4 a, f32x4 b) { u32x4 w; w.x = pk2(a[0], a[1]); w.y = pk2(a[2], a[3]); w.z = pk2(b[0], b[1]); w.w = pk2(b[2], b[3]); return w; }
DI f32x4 unpack4(u32x2 w) { return (f32x4){bfl(w.x), bfh(w.x), bfl(w.y), bfh(w.y)}; }
DI u32x2 pack4(f32x4 a) { u32x2 w; w.x = pk2(a[0], a[1]); w.y = pk2(a[2], a[3]); return w; }

DI void tr_item(const float* W, int ldw, int k0, int c0, bf16* WT, int ldt, int n0, LAS float* scr, int lane) {
    const int c = lane & 7;
    if (c0 < 0) {
#pragma unroll
        for (int j = 0; j < 4; ++j) { const int n = (lane >> 3) + 8 * j; *(u32x4*)(WT + (size_t)(n0 + n) * ldt + k0 + 8 * c) = (u32x4){0u, 0u, 0u, 0u}; }
        return;
    }
#pragma unroll 8
    for (int i = 0; i < 32; ++i) { const int kk = 2 * i + (lane >> 5); scr[kk * 33 + (lane & 31)] = W[(size_t)(k0 + kk) * ldw + c0 + (lane & 31)]; }
    LDS_WAIT();
#pragma unroll
    for (int j = 0; j < 4; ++j) { const int n = (lane >> 3) + 8 * j; const LAS float* s = scr + (8 * c) * 33 + n;
        u32x4 o; o.x = pk2(s[0 * 33], s[1 * 33]); o.y = pk2(s[2 * 33], s[3 * 33]); o.z = pk2(s[4 * 33], s[5 * 33]); o.w = pk2(s[6 * 33], s[7 * 33]);
        *(u32x4*)(WT + (size_t)(n0 + n) * ldt + k0 + 8 * c) = o; }
    LDS_WAIT();
}
DI void rms_row_bf16(const float* xrow, const float* g, bf16* orow, int lane) {
    const f32x4* xr = (const f32x4*)xrow + lane;
    f32x4 v[4]; float s = 0.f;
#pragma unroll
    for (int j = 0; j < 4; ++j) { v[j] = xr[64 * j]; s += (v[j].x * v[j].x + v[j].y * v[j].y) + (v[j].z * v[j].z + v[j].w * v[j].w); }
    const float rstd = 1.0f / sqrtf(wave_sum(s) * (1.f / D) + 1e-6f);
    u32x2* o8 = (u32x2*)orow + lane;
#pragma unroll
    for (int j = 0; j < 4; ++j) { const f32x4 gg = ((const f32x4*)g)[lane + 64 * j]; o8[64 * j] = pack4(v[j] * rstd * gg); }
}
DI void rms_rows2_f32(const unsigned char* src, float* dst, int m0, int m1, const float* g, int lane) {
    const f32x4* xa = (const f32x4*)(src + (size_t)m0 * D * 4) + lane; const f32x4* xb = (const f32x4*)(src + (size_t)m1 * D * 4) + lane;
    f32x4 va[4], vb[4]; float sa = 0.f, sb = 0.f;
#pragma unroll
    for (int j = 0; j < 4; ++j) { va[j] = xa[64 * j]; vb[j] = xb[64 * j]; }
#pragma unroll
    for (int j = 0; j < 4; ++j) { sa += (va[j].x * va[j].x + va[j].y * va[j].y) + (va[j].z * va[j].z + va[j].w * va[j].w); sb += (vb[j].x * vb[j].x + vb[j].y * vb[j].y) + (vb[j].z * vb[j].z + vb[j].w * vb[j].w); }
#pragma unroll
    for (int o = 1; o < 64; o <<= 1) { sa += __shfl_xor(sa, o); sb += __shfl_xor(sb, o); }
    const float ra = 1.0f / sqrtf(sa * (1.f / D) + 1e-6f), rb = 1.0f / sqrtf(sb * (1.f / D) + 1e-6f);
    f32x4* oa = (f32x4*)(dst + (size_t)m0 * D) + lane; f32x4* ob = (f32x4*)(dst + (size_t)m1 * D) + lane;
#pragma unroll
    for (int j = 0; j < 4; ++j) { const f32x4 gg = ((const f32x4*)g)[lane + 64 * j]; oa[64 * j] = va[j] * ra * gg; ob[64 * j] = vb[j] * rb * gg; }
}
DI void rms_rows2_bf16(const float* src, const float* g, bf16* dst, int m0, int m1, int lane) {
    const f32x4* xa = (const f32x4*)(src + (size_t)m0 * D) + lane; const f32x4* xb = (const f32x4*)(src + (size_t)m1 * D) + lane;
    f32x4 va[4], vb[4]; float sa = 0.f, sb = 0.f;
#pragma unroll
    for (int j = 0; j < 4; ++j) { va[j] = xa[64 * j]; vb[j] = xb[64 * j]; }
#pragma unroll
    for (int j = 0; j < 4; ++j) { sa += (va[j].x * va[j].x + va[j].y * va[j].y) + (va[j].z * va[j].z + va[j].w * va[j].w); sb += (vb[j].x * vb[j].x + vb[j].y * vb[j].y) + (vb[j].z * vb[j].z + vb[j].w * vb[j].w); }
#pragma unroll
    for (int o = 1; o < 64; o <<= 1) { sa += __shfl_xor(sa, o); sb += __shfl_xor(sb, o); }
    const float ra = 1.0f / sqrtf(sa * (1.f / D) + 1e-6f), rb = 1.0f / sqrtf(sb * (1.f / D) + 1e-6f);
    u32x2* oa = (u32x2*)(dst + (size_t)m0 * D) + lane; u32x2* ob = (u32x2*)(dst + (size_t)m1 * D) + lane;
#pragma unroll
    for (int j = 0; j < 4; ++j) { const f32x4 gg = ((const f32x4*)g)[lane + 64 * j]; oa[64 * j] = pack4(va[j] * ra * gg); ob[64 * j] = pack4(vb[j] * rb * gg); }
}

DI void p0_prologue(const Params& P, LAS unsigned char* lds) {
    const int tid = threadIdx.x, lane = tid & 63, wv = tid >> 6;
    LAS float* scr = (LAS float*)(lds + wv * 16384);
    const int gw = blockIdx.x * 8 + wv, NGW = gridDim.x * 8;
    unsigned char* ws = P.ws;
    constexpr int I0 = 16 * (NMIXP / 32), I1 = 16 * (NGATE / 32), I2 = 8 * 32, I3 = 8 * 32, I4 = 16 * 32, I5 = 16 * (NUP / 32), I6 = 44 * 32, I7 = 16, I8 = 16, I9 = 16, I10 = 32;
    constexpr int NIT = I0 + I1 + I2 + I3 + I4 + I5 + I6 + I7 + I8 + I9 + I10;
    for (int it = gw; it < NIT; it += NGW) {
        int r = it;
        if (r < I0) { const int nb = r % (NMIXP / 32), kb = r / (NMIXP / 32); tr_item(P.in[I_WIN], NPROJ, 64 * kb, 32 * nb < NMIX ? 32 * nb : -1, (bf16*)(ws + WS_WMIX), D, 32 * nb, scr, lane); continue; } r -= I0;
        if (r < I1) { const int nb = r % (NGATE / 32), kb = r / (NGATE / 32); tr_item(P.in[I_WIN], NPROJ, 64 * kb, NMIX + 32 * nb, (bf16*)(ws + WS_WGATE), D, 32 * nb, scr, lane); continue; } r -= I1;
        if (r < I2) { const int nb = r % 32, kb = r / 32; tr_item(P.in[I_GPROJ], D, 64 * kb, 32 * nb, (bf16*)(ws + WS_WGP), 512, 32 * nb, scr, lane); continue; } r -= I2;
        if (r < I3) { const int nb = r % 32, kb = r / 32; tr_item(P.in[I_RPROJ], D, 64 * kb, 32 * nb, (bf16*)(ws + WS_WRP), 512, 32 * nb, scr, lane); continue; } r -= I3;
        if (r < I4) { const int nb = r % 32, kb = r / 32; tr_item(P.in[I_WOUT], D, 64 * kb, 32 * nb, (bf16*)(ws + WS_WOUT), D, 32 * nb, scr, lane); continue; } r -= I4;
        if (r < I5) { const int nb = r % (NUP / 32), kb = r / (NUP / 32); const int n = 32 * nb, j = n >> 8, i = n & 255, ff = 128 * j + (i & 127);
            tr_item(P.in[I_FUP], NUPSRC, 64 * kb, ff < DFF ? (i < 128 ? ff : DFF + ff) : -1, (bf16*)(ws + WS_WUP), D, n, scr, lane); continue; } r -= I5;
        if (r < I6) { const int nb = r % 32, kb = r / 32; tr_item(P.in[I_FDN], D, 64 * kb, kb < 43 ? 32 * nb : -1, (bf16*)(ws + WS_WDN), DFFP, 32 * nb, scr, lane); continue; } r -= I6;
        if (r < I7) { tr_item(P.in[I_W2F], 512, 0, 32 * r, (bf16*)(ws + WS_LW2F), 64, 32 * r, scr, lane); continue; } r -= I7;
        if (r < I8) { tr_item(P.in[I_W2B], 512, 0, 32 * r, (bf16*)(ws + WS_LW2B), 64, 32 * r, scr, lane); continue; } r -= I8;
        if (r < I9) { tr_item(P.in[I_A2], 512, 0, 32 * r, (bf16*)(ws + WS_LA2), 64, 32 * r, scr, lane); continue; } r -= I9;
        { const int nb = r % 16, kb = r / 16; tr_item(P.in[I_G2], 512, 64 * kb, 32 * nb, (bf16*)(ws + WS_LG2), 128, 32 * nb, scr, lane); }
    }
    bf16* HB = (bf16*)(ws + WS_HB);
    for (int m = gw; m < M; m += 2 * NGW) rms_rows2_bf16(P.in[I_X], P.in[I_N1G], HB, m, m + NGW, lane);
}
#define XB_TMO      128
#define XB_XCNT(j)  (256  + 64 * (j))
#define XB_XSUB(j)  (1280 + 64 * (j))
#define XB_XGEN(j)  (2304 + 64 * (j))
#define XB_TOP      3328
#define XB_TOPGEN   3392
#define XCD_BAR_WORDS 3456
#define XB_SPIN_CAP (1u << 18)

__device__ __forceinline__ unsigned xb_ld(unsigned* p)              { return __hip_atomic_load(p, __ATOMIC_RELAXED, __HIP_MEMORY_SCOPE_AGENT); }
__device__ __forceinline__ unsigned xb_add(unsigned* p, unsigned v) { return __hip_atomic_fetch_add(p, v, __ATOMIC_RELAXED, __HIP_MEMORY_SCOPE_AGENT); }
__device__ __forceinline__ unsigned xb_xcc_id() { return (unsigned)__builtin_amdgcn_s_getreg((3 << 11) | 20) & 0xFu; }
#define XB_SPIN(cond, bar) do { unsigned _sp = 0; while (cond) { __builtin_amdgcn_s_sleep(1); \
    if ((++_sp & 255u) == 0u) { if (xb_ld(&(bar)[XB_TMO])) break; if (_sp > XB_SPIN_CAP) { atomicAdd(&(bar)[XB_TMO], 1u); break; } } } } while (0)

struct XcdBarrier {
    unsigned* bar; unsigned x;
    volatile LAS unsigned* st;
};

__device__ __forceinline__ XcdBarrier xcd_barrier_post(unsigned* bar, volatile LAS unsigned* st) {
    XcdBarrier b; b.bar = bar; b.x = xb_xcc_id(); b.st = st;
    if (threadIdx.x == 0) (void)xb_add(&bar[XB_XCNT(b.x)], 1u);
    return b;
}
__device__ __forceinline__ void xcd_barrier_complete(unsigned* bar, unsigned x, unsigned& nloc, unsigned& nx) {
    const unsigned G = gridDim.x * gridDim.y * gridDim.z;
    unsigned sum, cnt, mine, sp = 0u;
    for (;;) {
        sum = 0u; cnt = 0u; mine = 0u;
#pragma unroll
        for (unsigned j = 0; j < 16; ++j) { const unsigned c = xb_ld(&bar[XB_XCNT(j)]); sum += c; cnt += (c > 0u) ? 1u : 0u; mine = (j == x) ? c : mine; }
        if (sum == G) break;
        __builtin_amdgcn_s_sleep(1);
        if ((++sp & 255u) == 0u) { if (xb_ld(&bar[XB_TMO])) break; if (sp > XB_SPIN_CAP) { atomicAdd(&bar[XB_TMO], 1u); break; } }
    }
    nloc = mine > 0u ? mine : 1u; nx = cnt > 0u ? cnt : 1u;
}

__device__ __forceinline__ void xcd_barrier(const XcdBarrier& b) {
    asm volatile("s_waitcnt vmcnt(0)" ::: "memory");
    __syncthreads();
    if (threadIdx.x == 0) {
        unsigned* bar = b.bar;
        __builtin_amdgcn_s_waitcnt(0);
        unsigned nloc = b.st[0], nx = b.st[1];
        if (nloc == 0u) { xcd_barrier_complete(bar, b.x, nloc, nx); b.st[0] = nloc; b.st[1] = nx; }
        const unsigned old = xb_add(&bar[XB_XSUB(b.x)], 1u);
        const unsigned gen = old / nloc;
        if (old + 1u == (gen + 1u) * nloc) {
            __builtin_amdgcn_fence(__ATOMIC_RELEASE, "agent");
            asm volatile("s_waitcnt vmcnt(0)" ::: "memory");
            const unsigned og = xb_add(&bar[XB_TOP], 1u);
            const unsigned tg = og / nx;
            if (og + 1u == (tg + 1u) * nx) xb_add(&bar[XB_TOPGEN], 1u);
            else XB_SPIN(xb_ld(&bar[XB_TOPGEN]) == tg, bar);
            __builtin_amdgcn_fence(__ATOMIC_ACQUIRE, "agent");
            xb_add(&bar[XB_XGEN(b.x)], 1u);
            asm volatile("s_waitcnt vmcnt(0)" ::: "memory");
        } else {
            XB_SPIN(xb_ld(&bar[XB_XGEN(b.x)]) == gen, bar);
            __builtin_amdgcn_fence(__ATOMIC_ACQUIRE, "agent");
            asm volatile("s_waitcnt vmcnt(0)" ::: "memory");
        }
    }
    __syncthreads();
}


DI void gla_unit(const Params& P, LAS unsigned char* lds, int unit) {
    const int tid = threadIdx.x, lane = tid & 63, wv = __builtin_amdgcn_readfirstlane(tid >> 6), fr = lane & 15, q4 = lane >> 4;
    const int dir = unit & 1, h = (unit >> 1) & 3, b = unit >> 3;
    LAS bf16* QI = (LAS bf16*)lds; LAS bf16* KI = QI + 64 * 72; LAS bf16* QE = KI + 64 * 72; LAS bf16* KDT = QE + 64 * 72; LAS bf16* AS = KDT + 64 * 72;
    LAS bf16* VT = AS + 64 * 72; LAS bf16* ST = VT + 128 * 72;
    LAS float* BL = (LAS float*)(ST + 128 * 72); LAS float* AF = BL + 64 * 64; LAS float* GT = AF + 64 * 16;
    const bf16* PM = (const bf16*)(P.ws + WS_PM);
    bf16* GO = (bf16*)(P.ws + WS_GO) + (size_t)dir * M * 512;
    const float* wa2 = dir ? P.in[I_GWA2B] : P.in[I_GWA2F];
    const float* ba = dir ? P.in[I_GBAB] : P.in[I_GBAF];
    const int kq = tid & 63, cgp = tid >> 6;
    float wcol[16];
#pragma unroll
    for (int r = 0; r < 16; ++r) wcol[r] = wa2[r * 256 + 64 * h + kq];
    const float bak = ba[64 * h + kq];
    f32x4 Sacc[4];
#pragma unroll
    for (int i = 0; i < 4; ++i) Sacc[i] = (f32x4){0.f, 0.f, 0.f, 0.f};
    for (int i = tid; i < 128 * 72 / 2; i += 512) ((LAS unsigned*)ST)[i] = 0u;
    const size_t rowbase = (size_t)b * T;
    const int afcol = dir ? C_GAB : C_GAF;
    u32x4 paf = (u32x4){0u, 0u, 0u, 0u}, pq, pk, pva, pvb;
#define GLA_PREFETCH(nn) do { const int chunk_ = dir ? 31 - (nn) : (nn); const size_t tk0_ = rowbase + chunk_ * 64; \
        if (tid < 128) paf = *(const u32x4*)(PM + (tk0_ + (dir ? 63 - (tid >> 1) : (tid >> 1))) * NMIX + afcol + 8 * (tid & 1)); \
        const bf16* rp_ = PM + (tk0_ + (dir ? 63 - (tid >> 3) : (tid >> 3))) * NMIX; \
        pq = *(const u32x4*)(rp_ + C_GQ + 64 * h + 8 * (tid & 7)); pk = *(const u32x4*)(rp_ + C_GK + 64 * h + 8 * (tid & 7)); \
        pva = *(const u32x4*)(rp_ + C_GV + 128 * h + 16 * (tid & 7)); pvb = *(const u32x4*)(rp_ + C_GV + 128 * h + 16 * (tid & 7) + 8); } while (0)
    GLA_PREFETCH(0);
    for (int n = 0; n < 32; ++n) {
        const int chunk = dir ? 31 - n : n;
        const size_t tok0 = rowbase + chunk * 64;
#define GTOK(c) (tok0 + (dir ? 63 - (c) : (c)))
        if (tid < 128) { const int c = tid >> 1, hf = tid & 1; const F8 f = unpack8(paf);
            *(LAS f32x4*)(AF + c * 16 + 8 * hf) = f.a; *(LAS f32x4*)(AF + c * 16 + 8 * hf + 4) = f.b; }
        LDS_BARRIER();
        float pre[8]; float run = 0.f;
#pragma unroll
        for (int j = 0; j < 8; ++j) { const int c = 8 * cgp + j; float z = bak;
#pragma unroll
            for (int r4 = 0; r4 < 4; ++r4) { const f32x4 a = *(LAS f32x4*)(AF + c * 16 + 4 * r4); z += a[0] * wcol[4 * r4] + a[1] * wcol[4 * r4 + 1] + a[2] * wcol[4 * r4 + 2] + a[3] * wcol[4 * r4 + 3]; }
            const float la = -(fmaxf(-z, 0.f) + __logf(1.f + __expf(-fabsf(z)))) * (1.f / 16.f); run += la; pre[j] = run; }
        GT[cgp * 64 + kq] = run;
        LDS_BARRIER();
        float off = 0.f;
#pragma unroll
        for (int g = 0; g < 8; ++g) off += (g < cgp) ? GT[g * 64 + kq] : 0.f;
#pragma unroll
        for (int j = 0; j < 8; ++j) BL[(8 * cgp + j) * 64 + kq] = off + pre[j];
        LDS_BARRIER();
        {   const int c = tid >> 3, k0 = 8 * (tid & 7);
            const F8 q = unpack8(pq), k = unpack8(pk);
            const u32x4 va = pva, vb = pvb;
            f32x4 qi[2], ki[2], qe[2], kd[2];
#pragma unroll
            for (int hh = 0; hh < 2; ++hh) { const f32x4 bl = *(LAS f32x4*)(BL + c * 64 + k0 + 4 * hh), br = *(LAS f32x4*)(BL + 32 * 64 + k0 + 4 * hh), bt = *(LAS f32x4*)(BL + 63 * 64 + k0 + 4 * hh);
                const f32x4 qq = (hh ? q.b : q.a) * 0.125f, kk = hh ? k.b : k.a;
#pragma unroll
                for (int j = 0; j < 4; ++j) { qi[hh][j] = qq[j] * __expf(bl[j] - br[j]); ki[hh][j] = kk[j] * __expf(br[j] - bl[j]); qe[hh][j] = qq[j] * __expf(bl[j]); kd[hh][j] = kk[j] * __expf(bt[j] - bl[j]); } }
            *(LAS u32x4*)(QI + c * 72 + k0) = pack8(qi[0], qi[1]); *(LAS u32x4*)(KI + c * 72 + k0) = pack8(ki[0], ki[1]); *(LAS u32x4*)(QE + c * 72 + k0) = pack8(qe[0], qe[1]);
#pragma unroll
            for (int j = 0; j < 4; ++j) { KDT[(k0 + j) * 72 + c] = (bf16)f2bf(kd[0][j]); KDT[(k0 + 4 + j) * 72 + c] = (bf16)f2bf(kd[1][j]); }
            const int v0 = 16 * (tid & 7);
            VT[(v0 + 0) * 72 + c] = (bf16)(va.x & 0xffffu); VT[(v0 + 1) * 72 + c] = (bf16)(va.x >> 16); VT[(v0 + 2) * 72 + c] = (bf16)(va.y & 0xffffu); VT[(v0 + 3) * 72 + c] = (bf16)(va.y >> 16);
            VT[(v0 + 4) * 72 + c] = (bf16)(va.z & 0xffffu); VT[(v0 + 5) * 72 + c] = (bf16)(va.z >> 16); VT[(v0 + 6) * 72 + c] = (bf16)(va.w & 0xffffu); VT[(v0 + 7) * 72 + c] = (bf16)(va.w >> 16);
            VT[(v0 + 8) * 72 + c] = (bf16)(vb.x & 0xffffu); VT[(v0 + 9) * 72 + c] = (bf16)(vb.x >> 16); VT[(v0 + 10) * 72 + c] = (bf16)(vb.y & 0xffffu); VT[(v0 + 11) * 72 + c] = (bf16)(vb.y >> 16);
            VT[(v0 + 12) * 72 + c] = (bf16)(vb.z & 0xffffu); VT[(v0 + 13) * 72 + c] = (bf16)(vb.z >> 16); VT[(v0 + 14) * 72 + c] = (bf16)(vb.w & 0xffffu); VT[(v0 + 15) * 72 + c] = (bf16)(vb.w >> 16);
        }
        if (n + 1 < 32) GLA_PREFETCH(n + 1);
        LDS_BARRIER();
        {   const int ct = wv >> 1;
#pragma unroll
            for (int tt = 0; tt < 2; ++tt) { const int st = 2 * (wv & 1) + tt;
                f32x4 acc = (f32x4){0.f, 0.f, 0.f, 0.f};
#pragma unroll
                for (int ks = 0; ks < 2; ++ks) { const bf16x8 a = *(LAS bf16x8*)(KI + (16 * st + fr) * 72 + 32 * ks + 8 * q4), bb = *(LAS bf16x8*)(QI + (16 * ct + fr) * 72 + 32 * ks + 8 * q4); acc = MFMA16(a, bb, acc); }
                MFMA_GUARD(acc);
                const int cg0 = 16 * ct + fr, sg0 = 16 * st + 4 * q4;
#pragma unroll
                for (int j = 0; j < 4; ++j) acc[j] = (cg0 >= sg0 + j) ? acc[j] : 0.f;
                *(LAS u32x2*)(AS + (16 * ct + fr) * 72 + 16 * st + 4 * q4) = pack4(acc); }
        }
        LDS_BARRIER();
        {   bf16x8 av[2], as_[2];
#pragma unroll
            for (int ks = 0; ks < 2; ++ks) { av[ks] = *(LAS bf16x8*)(VT + (16 * wv + fr) * 72 + 32 * ks + 8 * q4); as_[ks] = *(LAS bf16x8*)(ST + (16 * wv + fr) * 72 + 32 * ks + 8 * q4); }
#pragma unroll
            for (int ct = 0; ct < 4; ++ct) { f32x4 o = (f32x4){0.f, 0.f, 0.f, 0.f};
#pragma unroll
                for (int ks = 0; ks < 2; ++ks) { const bf16x8 bb = *(LAS bf16x8*)(AS + (16 * ct + fr) * 72 + 32 * ks + 8 * q4); o = MFMA16(av[ks], bb, o); }
#pragma unroll
                for (int ks = 0; ks < 2; ++ks) { const bf16x8 bb = *(LAS bf16x8*)(QE + (16 * ct + fr) * 72 + 32 * ks + 8 * q4); o = MFMA16(as_[ks], bb, o); }
                MFMA_GUARD(o);
                *(u32x2*)(GO + GTOK(16 * ct + fr) * 512 + 128 * h + 16 * wv + 4 * q4) = pack4(o); }
#pragma unroll
            for (int kt = 0; kt < 4; ++kt) { const f32x4 bt = *(LAS f32x4*)(BL + 63 * 64 + 16 * kt + 4 * q4);
                f32x4 s = Sacc[kt]; s[0] *= __expf(bt[0]); s[1] *= __expf(bt[1]); s[2] *= __expf(bt[2]); s[3] *= __expf(bt[3]);
#pragma unroll
                for (int ks = 0; ks < 2; ++ks) { const bf16x8 a = *(LAS bf16x8*)(KDT + (16 * kt + fr) * 72 + 32 * ks + 8 * q4); s = MFMA16(a, av[ks], s); }
                MFMA_GUARD(s); Sacc[kt] = s; }
        }
        LDS_BARRIER();
#pragma unroll
        for (int kt = 0; kt < 4; ++kt) *(LAS u32x2*)(ST + (16 * wv + fr) * 72 + 16 * kt + 4 * q4) = pack4(Sacc[kt]);
#undef GTOK
    }
#undef GLA_PREFETCH
    LDS_BARRIER();
}
DI void gla_post(const Params& P) {
    const int tid = threadIdx.x, lane = tid & 63, wv = tid >> 6;
    const bf16* PM = (const bf16*)(P.ws + WS_PM); const bf16* GO = (const bf16*)(P.ws + WS_GO); bf16* O = (bf16*)(P.ws + WS_O);
    const F8 ng = {*(const f32x4*)(P.in[I_GNG] + 8 * lane), *(const f32x4*)(P.in[I_GNG] + 8 * lane + 4)};
    for (int m = blockIdx.x * 8 + wv; m < M; m += gridDim.x * 8) {
        const F8 a = unpack8(*(const u32x4*)(GO + (size_t)m * 512 + 8 * lane)), bq = unpack8(*(const u32x4*)(GO + (size_t)(M + m) * 512 + 8 * lane));
        const F8 og = unpack8(*(const u32x4*)(PM + (size_t)m * NMIX + C_GOG + 8 * lane));
        const f32x4 o0 = a.a + bq.a, o1 = a.b + bq.b;
        float ss = (o0[0] * o0[0] + o0[1] * o0[1]) + (o0[2] * o0[2] + o0[3] * o0[3]) + (o1[0] * o1[0] + o1[1] * o1[1]) + (o1[2] * o1[2] + o1[3] * o1[3]);
        ss += __shfl_xor(ss, 1); ss += __shfl_xor(ss, 2); ss += __shfl_xor(ss, 4); ss += __shfl_xor(ss, 8);
        const float rs = 1.0f / sqrtf(ss * (1.f / 128.f) + 1e-5f);
        f32x4 r0, r1;
#pragma unroll
        for (int j = 0; j < 4; ++j) { r0[j] = o0[j] * rs * ng.a[j] * (og.a[j] * sigm(og.a[j])); r1[j] = o1[j] * rs * ng.b[j] * (og.b[j] * sigm(og.b[j])); }
        *(u32x4*)(O + (size_t)m * 512 + 8 * lane) = pack8(r0, r1);
    }
}

template <int K> DI void lora_mma(f32x4 (&acc)[4][4], const bf16* Wt, LAS bf16* X, int ldx, int fr, int q4) {
#pragma unroll
    for (int a = 0; a < 4; ++a)
#pragma unroll
        for (int c = 0; c < 4; ++c) acc[a][c] = (f32x4){0.f, 0.f, 0.f, 0.f};
#pragma unroll
    for (int ks = 0; ks < K / 32; ++ks) { bf16x8 af[4];
#pragma unroll
        for (int nt = 0; nt < 4; ++nt) af[nt] = *(const bf16x8*)(Wt + (size_t)(32 * (nt >> 1) + 8 * (fr >> 2) + 4 * (nt & 1) + (fr & 3)) * K + 32 * ks + 8 * q4);
#pragma unroll
        for (int mt = 0; mt < 4; ++mt) { const bf16x8 bb = *(LAS bf16x8*)(X + (16 * mt + fr) * ldx + 32 * ks + 8 * q4);
#pragma unroll
            for (int nt = 0; nt < 4; ++nt) acc[nt][mt] = MFMA16(af[nt], bb, acc[nt][mt]); } }
    __builtin_amdgcn_sched_barrier(0); asm volatile("s_nop 7\n\ts_nop 7" ::: "memory"); __builtin_amdgcn_sched_barrier(0);
}
DI f32x4 shift4(const bf16* rp, bool hp, bool hn, const float* mup, const float* mun) {
    const f32x4 c = unpack4(*(const u32x2*)rp);
    const f32x4 pp = hp ? unpack4(*(const u32x2*)(rp - NMIX)) : (f32x4){0.f, 0.f, 0.f, 0.f};
    const f32x4 pn = hn ? unpack4(*(const u32x2*)(rp + NMIX)) : (f32x4){0.f, 0.f, 0.f, 0.f};
    return c + *(const f32x4*)mup * (pp - c) + *(const f32x4*)mun * (pn - c);
}
DI F8 shift8(const bf16* rp, bool hp, bool hn, const float* mup, const float* mun) {
    const F8 c = unpack8(*(const u32x4*)rp);
    F8 pp, pn; const f32x4 z = (f32x4){0.f, 0.f, 0.f, 0.f};
    if (hp) pp = unpack8(*(const u32x4*)(rp - NMIX)); else { pp.a = z; pp.b = z; }
    if (hn) pn = unpack8(*(const u32x4*)(rp + NMIX)); else { pn.a = z; pn.b = z; }
    F8 r; r.a = c.a + *(const f32x4*)mup * (pp.a - c.a) + *(const f32x4*)mun * (pn.a - c.a);
    r.b = c.b + *(const f32x4*)(mup + 4) * (pp.b - c.b) + *(const f32x4*)(mun + 4) * (pn.b - c.b); return r;
}
DI void r1_tile(const Params& P, LAS unsigned char* lds, int tile) {
    const int tid = threadIdx.x, lane = tid & 63, hd = __builtin_amdgcn_readfirstlane(tid >> 6), fr = lane & 15, q4 = lane >> 4;
    LAS bf16* XW = (LAS bf16*)lds; LAS bf16* XA = XW + 64 * 72; LAS bf16* XG = XA + 64 * 72;
    const bf16* PM = (const bf16*)(P.ws + WS_PM);
    const float* mup = P.in[I_MUP]; const float* mun = P.in[I_MUN];
    const int t0 = tile * 64;
    {   const int row = tid >> 3, g8 = tid & 7; const int tok = t0 + row, tpos = tok & (T - 1);
        const bool hp = tpos > 0, hn = tpos < T - 1;
        const bf16* rp = PM + (size_t)tok * NMIX + C_R0 + 1536 + 32 * g8;
#pragma unroll
        for (int v4 = 0; v4 < 4; ++v4) { F8 s = shift8(rp + 8 * v4, hp, hn, mup + 1536 + 32 * g8 + 8 * v4, mun + 1536 + 32 * g8 + 8 * v4);
            if (g8 < 2) {
#pragma unroll
                for (int j = 0; j < 4; ++j) { s.a[j] = 1.f - 2.f * __builtin_amdgcn_rcpf(__expf(2.f * s.a[j]) + 1.f); s.b[j] = 1.f - 2.f * __builtin_amdgcn_rcpf(__expf(2.f * s.b[j]) + 1.f); }
                *(LAS u32x4*)(XW + row * 72 + 32 * g8 + 8 * v4) = pack8(s.a, s.b);
            } else if (g8 < 4) { *(LAS u32x4*)(XA + row * 72 + 32 * (g8 - 2) + 8 * v4) = pack8(s.a, s.b);
            } else {
#pragma unroll
                for (int j = 0; j < 4; ++j) { s.a[j] = sigm(s.a[j]); s.b[j] = sigm(s.b[j]); }
                *(LAS u32x4*)(XG + row * 136 + 32 * (g8 - 4) + 8 * v4) = pack8(s.a, s.b); } }
    }
    __syncthreads();
    unsigned char* dout = (unsigned char*)P.out;
    bf16* KP = (bf16*)dout; bf16* KKn = KP + (size_t)M * 512; bf16* BB = KKn + (size_t)M * 512; bf16* GG = BB + (size_t)M * 512;
    unsigned short* EF = (unsigned short*)(P.ws + WS_E); unsigned short* EB = EF + (size_t)M * 512;
    float* BON = (float*)(P.ws + WS_BON);
    const int ch8 = 64 * hd + 8 * q4;
    f32x4 acc[4][4];
    lora_mma<64>(acc, (const bf16*)(P.ws + WS_LA2) + (size_t)(64 * hd) * 64, XA, 72, fr, q4);
#pragma unroll
    for (int np = 0; np < 2; ++np) { const f32x4 a0a = *(const f32x4*)(P.in[I_A0] + ch8 + 32 * np), a0b = *(const f32x4*)(P.in[I_A0] + ch8 + 32 * np + 4);
#pragma unroll
        for (int mt = 0; mt < 4; ++mt)
#pragma unroll
            for (int j = 0; j < 4; ++j) { acc[2 * np][mt][j] = sigm(acc[2 * np][mt][j] + a0a[j]); acc[2 * np + 1][mt][j] = sigm(acc[2 * np + 1][mt][j] + a0b[j]); } }
#pragma unroll
    for (int mt = 0; mt < 4; ++mt) { const int tok = t0 + 16 * mt + fr, tpos = tok & (T - 1); const bool hp = tpos > 0, hn = tpos < T - 1;
        const bf16* rp = PM + (size_t)tok * NMIX + C_R0 + ch8;
        F8 ks[2]; float ss = 0.f;
#pragma unroll
        for (int np = 0; np < 2; ++np) { ks[np] = shift8(rp + 512 + 32 * np, hp, hn, mup + 512 + ch8 + 32 * np, mun + 512 + ch8 + 32 * np);
            const f32x4 k0 = ks[np].a * *(const f32x4*)(P.in[I_KK] + ch8 + 32 * np), k1 = ks[np].b * *(const f32x4*)(P.in[I_KK] + ch8 + 32 * np + 4);
            ss += ((k0[0] * k0[0] + k0[1] * k0[1]) + (k0[2] * k0[2] + k0[3] * k0[3])) + ((k1[0] * k1[0] + k1[1] * k1[1]) + (k1[2] * k1[2] + k1[3] * k1[3])); }
        ss += __shfl_xor(ss, 16); ss += __shfl_xor(ss, 32);
        const float inv = 1.0f / fmaxf(sqrtf(ss), 1e-12f);
        float bon = 0.f;
#pragma unroll
        for (int np = 0; np < 2; ++np) { const f32x4 aa = acc[2 * np][mt], ab = acc[2 * np + 1][mt];
            const f32x4 kka = *(const f32x4*)(P.in[I_KK] + ch8 + 32 * np), kkb = *(const f32x4*)(P.in[I_KK] + ch8 + 32 * np + 4);
            const f32x4 kaa = *(const f32x4*)(P.in[I_KA] + ch8 + 32 * np), kab = *(const f32x4*)(P.in[I_KA] + ch8 + 32 * np + 4);
            const f32x4 kn0 = ks[np].a * kka * inv, kn1 = ks[np].b * kkb * inv;
            const f32x4 kp0 = ks[np].a * (1.0f + (aa - 1.0f) * kaa), kp1 = ks[np].b * (1.0f + (ab - 1.0f) * kab);
            const f32x4 bb0 = kn0 * aa, bb1 = kn1 * ab;
            const F8 rs = shift8(rp + 32 * np, hp, hn, mup + ch8 + 32 * np, mun + ch8 + 32 * np);
            const f32x4 rk0 = *(const f32x4*)(P.in[I_RK] + ch8 + 32 * np), rk1 = *(const f32x4*)(P.in[I_RK] + ch8 + 32 * np + 4);
            bon += ((rs.a[0] * kp0[0] * rk0[0] + rs.a[1] * kp0[1] * rk0[1]) + (rs.a[2] * kp0[2] * rk0[2] + rs.a[3] * kp0[3] * rk0[3]))
                 + ((rs.b[0] * kp1[0] * rk1[0] + rs.b[1] * kp1[1] * rk1[1]) + (rs.b[2] * kp1[2] * rk1[2] + rs.b[3] * kp1[3] * rk1[3]));
            const size_t o = (size_t)tok * 512 + ch8 + 32 * np;
            *(u32x4*)(KP + o) = pack8(kp0, kp1); *(u32x4*)(KKn + o) = pack8(kn0, kn1); *(u32x4*)(BB + o) = pack8(bb0, bb1); }
        bon += __shfl_xor(bon, 16); bon += __shfl_xor(bon, 32);
        if (q4 == 0) BON[(size_t)tok * 8 + hd] = bon; }
#pragma unroll
    for (int d = 0; d < 2; ++d) {
        lora_mma<64>(acc, (const bf16*)(P.ws + (d ? WS_LW2B : WS_LW2F)) + (size_t)(64 * hd) * 64, XW, 72, fr, q4);
        unsigned short* E = d ? EB : EF; const float* w0 = d ? P.in[I_W0B] : P.in[I_W0F];
#pragma unroll
        for (int np = 0; np < 2; ++np) { const f32x4 w0a = *(const f32x4*)(w0 + ch8 + 32 * np), w0b = *(const f32x4*)(w0 + ch8 + 32 * np + 4);
#pragma unroll
            for (int mt = 0; mt < 4; ++mt) { const f32x4 a = acc[2 * np][mt], c = acc[2 * np + 1][mt]; u32x4 w;
                w.x = pkh2(0.60653066f * sigm(a[0] + w0a[0]), 0.60653066f * sigm(a[1] + w0a[1])); w.y = pkh2(0.60653066f * sigm(a[2] + w0a[2]), 0.60653066f * sigm(a[3] + w0a[3]));
                w.z = pkh2(0.60653066f * sigm(c[0] + w0b[0]), 0.60653066f * sigm(c[1] + w0b[1])); w.w = pkh2(0.60653066f * sigm(c[2] + w0b[2]), 0.60653066f * sigm(c[3] + w0b[3]));
                *(u32x4*)(E + (size_t)(t0 + 16 * mt + fr) * 512 + ch8 + 32 * np) = w; } }
    }
    lora_mma<128>(acc, (const bf16*)(P.ws + WS_LG2) + (size_t)(64 * hd) * 128, XG, 136, fr, q4);
#pragma unroll
    for (int np = 0; np < 2; ++np)
#pragma unroll
        for (int mt = 0; mt < 4; ++mt) *(u32x4*)(GG + (size_t)(t0 + 16 * mt + fr) * 512 + ch8 + 32 * np) = pack8(acc[2 * np][mt], acc[2 * np + 1][mt]);
    __syncthreads();
}

constexpr int TC = 16;
#define OPI(buf, d, arr) (OP + ((((buf) * 2 + (d)) * 6 + (arr)) * (TC * 64)))
DI void scan_load(const Params& P, LAS float* OP, int buf, int ci, int b, int hd, int ltid) {
    const int d = ltid >> 7, i = (ltid >> 3) & 15, c8 = ltid & 7;
    const int step = TC * ci + i, tpos = d ? T - 1 - step : step; const size_t tok = (size_t)b * T + tpos;
    const int ch0 = 64 * hd + 8 * c8;
    const bf16* PM = (const bf16*)(P.ws + WS_PM);
    const bf16* KP = (const bf16*)P.out; const bf16* KKn = KP + (size_t)M * 512; const bf16* BB = KKn + (size_t)M * 512;
    const unsigned short* E = (const unsigned short*)(P.ws + WS_E) + (size_t)d * M * 512;
    const F8 kp = unpack8(*(const u32x4*)(KP + tok * 512 + ch0)), kk = unpack8(*(const u32x4*)(KKn + tok * 512 + ch0)), bb = unpack8(*(const u32x4*)(BB + tok * 512 + ch0));
    const u32x4 ew = *(const u32x4*)(E + tok * 512 + ch0);
    const bool hp = tpos > 0, hn = tpos < T - 1;
    const bf16* rp = PM + tok * NMIX + C_R0 + ch0;
    const F8 r = shift8(rp, hp, hn, P.in[I_MUP] + ch0, P.in[I_MUN] + ch0), v = shift8(rp + 1024, hp, hn, P.in[I_MUP] + 1024 + ch0, P.in[I_MUN] + 1024 + ch0);
    const int o = i * 64 + 8 * c8;
    *(LAS f32x4*)(OPI(buf, d, 0) + o) = -kk.a; *(LAS f32x4*)(OPI(buf, d, 0) + o + 4) = -kk.b;
    f32x4 w0, w1; w0[0] = __expf(-hlo(ew.x)); w0[1] = __expf(-hhi(ew.x)); w0[2] = __expf(-hlo(ew.y)); w0[3] = __expf(-hhi(ew.y));
    w1[0] = __expf(-hlo(ew.z)); w1[1] = __expf(-hhi(ew.z)); w1[2] = __expf(-hlo(ew.w)); w1[3] = __expf(-hhi(ew.w));
    *(LAS f32x4*)(OPI(buf, d, 1) + o) = w0; *(LAS f32x4*)(OPI(buf, d, 1) + o + 4) = w1;
    *(LAS f32x4*)(OPI(buf, d, 2) + o) = bb.a; *(LAS f32x4*)(OPI(buf, d, 2) + o + 4) = bb.b;
    *(LAS f32x4*)(OPI(buf, d, 3) + o) = kp.a; *(LAS f32x4*)(OPI(buf, d, 3) + o + 4) = kp.b;
    *(LAS f32x4*)(OPI(buf, d, 4) + o) = r.a; *(LAS f32x4*)(OPI(buf, d, 4) + o + 4) = r.b;
    *(LAS f32x4*)(OPI(buf, d, 5) + o) = v.a; *(LAS f32x4*)(OPI(buf, d, 5) + o + 4) = v.b;
}
DI void scan_flush(const Params& P, LAS float* YB, int buf, int ci, int b, int hd, int ltid) {
    const int d = ltid >> 7, i = (ltid >> 3) & 15, c8 = ltid & 7;
    const int step = TC * ci + i, tpos = d ? T - 1 - step : step; const size_t tok = (size_t)b * T + tpos;
    bf16* Y = (bf16*)(P.ws + WS_GO) + (size_t)d * M * 512;
    const LAS float* y = YB + (buf * 2 + d) * (TC * 64) + i * 64 + 8 * c8;
    *(u32x4*)(Y + tok * 512 + 64 * hd + 8 * c8) = pack8(*(const LAS f32x4*)y, *(const LAS f32x4*)(y + 4));
}
struct ScanOps { f32x2 nk[4], w[4], bb[4], kx[4], rx[4]; f32x4 vv; };
DI void scan_ops_load(ScanOps& o, const LAS float* base, const LAS float* vb, int i) {
#pragma unroll
    for (int hh = 0; hh < 2; ++hh) { const f32x4 t0 = *(const LAS f32x4*)(base + 0 * TC * 64 + i * 64 + 4 * hh), t1 = *(const LAS f32x4*)(base + 1 * TC * 64 + i * 64 + 4 * hh), t2 = *(const LAS f32x4*)(base + 2 * TC * 64 + i * 64 + 4 * hh),
                                                   t3 = *(const LAS f32x4*)(base + 3 * TC * 64 + i * 64 + 4 * hh), t4 = *(const LAS f32x4*)(base + 4 * TC * 64 + i * 64 + 4 * hh);
        o.nk[2 * hh] = (f32x2){t0[0], t0[1]}; o.nk[2 * hh + 1] = (f32x2){t0[2], t0[3]}; o.w[2 * hh] = (f32x2){t1[0], t1[1]}; o.w[2 * hh + 1] = (f32x2){t1[2], t1[3]};
        o.bb[2 * hh] = (f32x2){t2[0], t2[1]}; o.bb[2 * hh + 1] = (f32x2){t2[2], t2[3]}; o.kx[2 * hh] = (f32x2){t3[0], t3[1]}; o.kx[2 * hh + 1] = (f32x2){t3[2], t3[3]};
        o.rx[2 * hh] = (f32x2){t4[0], t4[1]}; o.rx[2 * hh + 1] = (f32x2){t4[2], t4[3]}; }
    o.vv = *(const LAS f32x4*)(vb + i * 64);
}
DI void scan_step(f32x2 (&S)[4][4], const ScanOps& o, LAS float* yb, int i, int c8) {
    float sa[4];
#pragma unroll
    for (int j = 0; j < 4; ++j) { f32x2 a = S[j][0] * o.nk[0]; a = S[j][1] * o.nk[1] + a; a = S[j][2] * o.nk[2] + a; a = S[j][3] * o.nk[3] + a; sa[j] = oct_sum(a.x + a.y); }
    f32x4 yo;
#pragma unroll
    for (int j = 0; j < 4; ++j) { const f32x2 sav = (f32x2){sa[j], sa[j]}, vjv = (f32x2){o.vv[j], o.vv[j]};
#pragma unroll
        for (int p = 0; p < 4; ++p) S[j][p] = S[j][p] * o.w[p] + (sav * o.bb[p] + vjv * o.kx[p]);
        f32x2 y = S[j][0] * o.rx[0]; y = S[j][1] * o.rx[1] + y; y = S[j][2] * o.rx[2] + y; y = S[j][3] * o.rx[3] + y; yo[j] = oct_sum(y.x + y.y); }
    if (c8 == 0) *(LAS f32x4*)(yb + i * 64) = yo;
}
DI void scan_unit(const Params& P, LAS unsigned char* lds, int bh) {
    const int tid = threadIdx.x, lane = tid & 63, wv = __builtin_amdgcn_readfirstlane(tid >> 6);
    const int b = bh >> 3, hd = bh & 7;
    LAS float* OP = (LAS float*)lds; LAS float* YB = OP + 2 * 2 * 6 * TC * 64;
    constexpr int NCH = T / TC;
    const bool loader = wv >= 4; const int ltid = tid - 256;
    const int d = wv >> 1, c8 = lane & 7, rbase = 32 * (wv & 1) + 4 * (lane >> 3);
    f32x2 S[4][4];
#pragma unroll
    for (int j = 0; j < 4; ++j)
#pragma unroll
        for (int p = 0; p < 4; ++p) S[j][p] = (f32x2){0.f, 0.f};
    if (loader) scan_load(P, OP, 0, 0, b, hd, ltid);
    __syncthreads();
    for (int ci = 0; ci < NCH; ++ci) {
        const int buf = ci & 1;
        if (loader) {
            if (ci + 1 < NCH) scan_load(P, OP, buf ^ 1, ci + 1, b, hd, ltid);
            if (ci > 0) scan_flush(P, YB, buf ^ 1, ci - 1, b, hd, ltid);
        } else {
            const LAS float* base = OPI(buf, d, 0) + 8 * c8;
            const LAS float* vb = OPI(buf, d, 5) + rbase;
            LAS float* yb = YB + (buf * 2 + d) * (TC * 64) + rbase;
            ScanOps cur, nxt; scan_ops_load(cur, base, vb, 0);
#pragma unroll 1
            for (int i = 0; i < TC; i += 2) {
                scan_ops_load(nxt, base, vb, i + 1);
                scan_step(S, cur, yb, i, c8);
                if (i + 2 < TC) scan_ops_load(cur, base, vb, i + 2);
                scan_step(S, nxt, yb, i + 1, c8);
            }
        }
        __syncthreads();
    }
    if (loader) scan_flush(P, YB, (NCH - 1) & 1, NCH - 1, b, hd, ltid);
    __syncthreads();
}
DI void r3_post(const Params& P) {
    const int tid = threadIdx.x, lane = tid & 63, wv = tid >> 6;
    const bf16* PM = (const bf16*)(P.ws + WS_PM); const bf16* Y = (const bf16*)(P.ws + WS_GO); bf16* O = (bf16*)(P.ws + WS_O);
    const bf16* GG = (const bf16*)P.out + (size_t)3 * M * 512; const float* BON = (const float*)(P.ws + WS_BON);
    const F8 lw = {*(const f32x4*)(P.in[I_LNW] + 8 * lane), *(const f32x4*)(P.in[I_LNW] + 8 * lane + 4)}, lb = {*(const f32x4*)(P.in[I_LNB] + 8 * lane), *(const f32x4*)(P.in[I_LNB] + 8 * lane + 4)};
    for (int m = blockIdx.x * 8 + wv; m < M; m += gridDim.x * 8) {
        const int tpos = m & (T - 1);
        const F8 a = unpack8(*(const u32x4*)(Y + (size_t)m * 512 + 8 * lane)), bq = unpack8(*(const u32x4*)(Y + (size_t)(M + m) * 512 + 8 * lane));
        const F8 g = unpack8(*(const u32x4*)(GG + (size_t)m * 512 + 8 * lane));
        const F8 v = shift8(PM + (size_t)m * NMIX + C_R0 + 1024 + 8 * lane, tpos > 0, tpos < T - 1, P.in[I_MUP] + 1024 + 8 * lane, P.in[I_MUN] + 1024 + 8 * lane);
        const float bon = BON[(size_t)m * 8 + (lane >> 3)];
        const f32x4 y0 = a.a + bq.a, y1 = a.b + bq.b;
        float s = (y0[0] + y0[1]) + (y0[2] + y0[3]) + (y1[0] + y1[1]) + (y1[2] + y1[3]);
        s += __shfl_xor(s, 1); s += __shfl_xor(s, 2); s += __shfl_xor(s, 4);
        const float mu = s * (1.f / 64.f);
        const f32x4 d0 = y0 - mu, d1 = y1 - mu;
        float q = (d0[0] * d0[0] + d0[1] * d0[1]) + (d0[2] * d0[2] + d0[3] * d0[3]) + (d1[0] * d1[0] + d1[1] * d1[1]) + (d1[2] * d1[2] + d1[3] * d1[3]);
        q += __shfl_xor(q, 1); q += __shfl_xor(q, 2); q += __shfl_xor(q, 4);
        const float rs = 1.0f / sqrtf(q * (1.f / 64.f) + 64.f * 1e-5f);
        const f32x4 o0 = (d0 * rs * lw.a + lb.a + bon * v.a) * g.a, o1 = (d1 * rs * lw.b + lb.b + bon * v.b) * g.b;
        *(u32x4*)(O + (size_t)(M + m) * 512 + 8 * lane) = pack8(o0, o1);
    }
}

DI void conv_phase(const Params& P, int half, int sel = 0) {
    const bf16* U = (const bf16*)(P.ws + WS_U); bf16* ACT = (bf16*)(P.ws + WS_ACT);
    const float* cw = P.in[I_FCW]; const float* cb = P.in[I_FCB];
    constexpr int NCG = DFFP / 8;
    const int nitems = (MH / 8) * NCG;
    for (int it = blockIdx.x * 512 + threadIdx.x; it < nitems; it += gridDim.x * 512) {
        const int run = it / NCG, cgp = it - run * NCG, j0 = 8 * cgp;
        const int tl0 = run * 8, tg0 = half * MH + tl0, tpos0 = tg0 & (T - 1);
        bf16* ap = ACT + (size_t)tg0 * DFFP + j0;
        if (j0 >= DFF) {
#pragma unroll
            for (int rr = 0; rr < 8; ++rr) *(u32x4*)(ap + (size_t)rr * DFFP) = (u32x4){0u, 0u, 0u, 0u};
            continue; }
        const int ucol = 256 * (j0 >> 7) + (j0 & 127);
        F8 wg[3], wvv[3];
#pragma unroll
        for (int t = 0; t < 3; ++t) { wg[t].a = *(const f32x4*)(cw + t * NUPSRC + j0); wg[t].b = *(const f32x4*)(cw + t * NUPSRC + j0 + 4); wvv[t].a = *(const f32x4*)(cw + t * NUPSRC + DFF + j0); wvv[t].b = *(const f32x4*)(cw + t * NUPSRC + DFF + j0 + 4); }
        const F8 bg = {*(const f32x4*)(cb + j0), *(const f32x4*)(cb + j0 + 4)}, bv = {*(const f32x4*)(cb + DFF + j0), *(const f32x4*)(cb + DFF + j0 + 4)};
        const bf16* up = U + (size_t)tl0 * NUP + ucol;
        const f32x4 z = (f32x4){0.f, 0.f, 0.f, 0.f};
        F8 pg, pv, cg_, cv, ng, nv;
        if (tpos0 > 0) { pg = unpack8(*(const u32x4*)(up - NUP)); pv = unpack8(*(const u32x4*)(up - NUP + 128)); } else { pg.a = z; pg.b = z; pv.a = z; pv.b = z; }
        cg_ = unpack8(*(const u32x4*)up); cv = unpack8(*(const u32x4*)(up + 128));
#pragma unroll
        for (int rr = 0; rr < 8; ++rr) {
            if (tpos0 + rr + 1 < T) { ng = unpack8(*(const u32x4*)(up + (size_t)(rr + 1) * NUP)); nv = unpack8(*(const u32x4*)(up + (size_t)(rr + 1) * NUP + 128)); } else { ng.a = z; ng.b = z; nv.a = z; nv.b = z; }
            const f32x4 g0 = wg[0].a * pg.a + wg[1].a * cg_.a + wg[2].a * ng.a + bg.a, g1 = wg[0].b * pg.b + wg[1].b * cg_.b + wg[2].b * ng.b + bg.b;
            const f32x4 x0 = wvv[0].a * pv.a + wvv[1].a * cv.a + wvv[2].a * nv.a + bv.a, x1 = wvv[0].b * pv.b + wvv[1].b * cv.b + wvv[2].b * nv.b + bv.b;
            f32x4 o0, o1;
#pragma unroll
            for (int j = 0; j < 4; ++j) { o0[j] = g0[j] * sigm(g0[j]) * x0[j]; o1[j] = g1[j] * sigm(g1[j]) * x1[j]; }
            { const int rt_ = (tl0 + rr) & 255; const bool edge = (rt_ == 0 || rt_ == 255);
              if (sel == 0 || (sel == 1 && edge) || (sel == 2 && !edge)) *(u32x4*)(ap + (size_t)rr * DFFP) = pack8(o0, o1); }
            pg = cg_; pv = cv; cg_ = ng; cv = nv;
        }
    }
}
#ifndef DBG_UDUMP
#define DBG_UDUMP 0
#endif
DI void conv_fix(const Params& P) {
    const float* SB = (const float*)(P.ws + (DBG_UDUMP ? 868 * MiB : WS_SB)); bf16* ACT = (bf16*)(P.ws + WS_ACT);
    const float* cw = P.in[I_FCW]; const float* cb = P.in[I_FCB];
    constexpr int NG = DFFP / 4;
    const int nitems = 256 * 2 * NG;
    for (int it = blockIdx.x * 512 + threadIdx.x; it < nitems; it += gridDim.x * 512) {
        const int jg = it % NG, rw = it / NG, which = rw & 1, pm = rw >> 1, j = 4 * jg;
        bf16* ap = ACT + (size_t)(pm * 256 + (which ? 255 : 0)) * DFFP + j;
        if (j >= DFF) { *(u32x2*)ap = (u32x2){0u, 0u}; continue; }
        const int col = 256 * (j >> 7) + (j & 127);
        const f32x4 z = (f32x4){0.f, 0.f, 0.f, 0.f};
        const float* cur = SB + (size_t)(pm * 4 + (which ? 3 : 0)) * NUP + col;
        const float* prv = which ? SB + (size_t)(pm * 4 + 2) * NUP + col : ((pm & 7) ? SB + (size_t)((pm - 1) * 4 + 3) * NUP + col : nullptr);
        const float* nxt = which ? (((pm & 7) != 7) ? SB + (size_t)((pm + 1) * 4 + 0) * NUP + col : nullptr) : SB + (size_t)(pm * 4 + 1) * NUP + col;
        const f32x4 cgv = *(const f32x4*)cur, cvv = *(const f32x4*)(cur + 128);
        const f32x4 pg = prv ? *(const f32x4*)prv : z, pv = prv ? *(const f32x4*)(prv + 128) : z;
        const f32x4 ng = nxt ? *(const f32x4*)nxt : z, nv = nxt ? *(const f32x4*)(nxt + 128) : z;
        const f32x4 g = *(const f32x4*)(cw + j) * pg + *(const f32x4*)(cw + NUPSRC + j) * cgv + *(const f32x4*)(cw + 2 * NUPSRC + j) * ng + *(const f32x4*)(cb + j);
        const f32x4 v = *(const f32x4*)(cw + DFF + j) * pv + *(const f32x4*)(cw + NUPSRC + DFF + j) * cvv + *(const f32x4*)(cw + 2 * NUPSRC + DFF + j) * nv + *(const f32x4*)(cb + DFF + j);
        f32x4 o;
#pragma unroll
        for (int i = 0; i < 4; ++i) o[i] = g[i] * sigm(g[i]) * v[i];
        *(u32x2*)ap = pack4(o);
    }
}
#ifndef DBG_SKIPMASK
#define DBG_SKIPMASK 0
#endif
#ifndef FUSE_NORM2
#define FUSE_NORM2 1
#endif
#ifndef FUSE_CONV
#define FUSE_CONV 1
#endif
#ifndef SEAM_ACQ
#define SEAM_ACQ 0
#endif
#ifndef USE_CG_SYNC
#define USE_CG_SYNC 0
#endif
#ifndef N_PHASE_LAUNCH
#define N_PHASE_LAUNCH 0
#endif
constexpr int NPHASES = 16;
__global__ void __launch_bounds__(512, 2) fwd_kernel(Params P, int ph_lo, int ph_hi) {
    extern __shared__ __attribute__((aligned(16))) unsigned char lds_raw[];
    LAS unsigned char* lds = (LAS unsigned char*)lds_raw;
    const int tid = threadIdx.x, wv = tid >> 6, lane = tid & 63;
    unsigned char* ws = P.ws;
    bf16* HB = (bf16*)(ws + WS_HB);
    const int G = gridDim.x, bx = blockIdx.x;
#if N_PHASE_LAUNCH
#define SEAM() do {} while (0)
#define SEAM0() do {} while (0)
#else
    cg::grid_group grid = cg::this_grid();
    volatile LAS unsigned* xst = (volatile LAS unsigned*)(lds + 131072 + 64);
    if (tid < 2) xst[tid] = 0u;
    __syncthreads();
    const XcdBarrier xbar = xcd_barrier_post((unsigned*)ws, xst);
#define SEAM0() do { if (ph_lo < 0) grid.sync(); else xcd_barrier(xbar); } while (0)
#if USE_CG_SYNC
#define SEAM() grid.sync()
#else
#if SEAM_ACQ
#define SEAM() do { xcd_barrier(xbar); __builtin_amdgcn_fence(__ATOMIC_ACQUIRE, "agent"); } while (0)
#else
#define SEAM() xcd_barrier(xbar)
#endif
#endif
#endif
#define IN(k) (ph_lo <= (k) && (k) < ph_hi)
#define GEMM_CALL(EPI, A_, B_, M_, N_, K_, E_) do { pg8::Gemm g{(const pg8::bf16_t*)(A_), (const pg8::bf16_t*)(B_), (M_), (N_), (K_)}; pg8::StaticOrder S; S.init((M_), (N_), G, bx); \
        pg8::gemm_phase<EPI, pg8::StaticOrder, PG8_ALIGN, PG8_SP2>(lds, g, S, (E_)); } while (0)
    if (IN(0)) { p0_prologue(P, lds); SEAM0(); }
    if (IN(1)) { pg8::EpiStore E{(pg8::bf16_t*)(ws + WS_PM), NMIX, NMIX, 0, nullptr}; GEMM_CALL(pg8::EpiStore, HB, ws + WS_WMIX, M, NMIXP, D, E);
#ifdef PROBE_G1A2
                 __syncthreads(); GEMM_CALL(pg8::EpiStore, HB, ws + WS_WMIX, M, NMIXP, D, E);
#endif
                 SEAM(); }
    if (IN(2)) { for (int u = bx; u < 256; u += G) gla_unit(P, lds, (G == 256) ? ((u & ~15) + 2 * (u & 7) + ((u >> 3) & 1)) : u);
#ifdef PROBE_GLA2
                 for (int u = bx; u < 256; u += G) gla_unit(P, lds, u);
#endif
                 SEAM(); }
    if (IN(3)) { gla_post(P); for (int t = bx; t < M / 64; t += G) r1_tile(P, lds, t);
#ifdef PROBE_R12
                 for (int t = bx; t < M / 64; t += G) r1_tile(P, lds, t);
#endif
                 SEAM(); }
    if (IN(5)) { for (int u = bx; u < 256; u += G) scan_unit(P, lds, u);
#ifdef PROBE_SCAN2
                 for (int u = bx; u < 256; u += G) scan_unit(P, lds, u);
#endif
                 SEAM(); }
    if (IN(6)) { r3_post(P); __syncthreads();
                 pg8::EpiStore E{(pg8::bf16_t*)(ws + WS_E), D, D, D, (pg8::bf16_t*)P.out}; GEMM_CALL(pg8::EpiStore, HB, ws + WS_WGATE, M, NGATE, D, E); SEAM(); }
    if (IN(7)) { { pg8::EpiGate<0> E{(const pg8::bf16_t*)(ws + WS_E), (pg8::bf16_t*)HB, D}; GEMM_CALL(pg8::EpiGate<0>, ws + WS_O, ws + WS_WGP, M, D, 512, E); }
                 __syncthreads();
                 { pg8::EpiGate<1> E{(const pg8::bf16_t*)P.out, (pg8::bf16_t*)HB, D}; GEMM_CALL(pg8::EpiGate<1>, ws + WS_O + (size_t)M * 512 * 2, ws + WS_WRP, M, D, 512, E); }
                 SEAM(); }
#if FUSE_NORM2
    if (IN(8)) { pg8::EpiResNorm E{P.in[I_X], P.out, (pg8::bf16_t*)(ws + WS_H2), P.in[I_N2G], (float*)(ws + 65536), D}; GEMM_CALL(pg8::EpiResNorm, HB, ws + WS_WOUT, M, D, D, E); SEAM(); }
#else
    if (IN(8)) { pg8::EpiRes E{P.in[I_X], P.out, D}; GEMM_CALL(pg8::EpiRes, HB, ws + WS_WOUT, M, D, D, E); SEAM(); }
#endif
#if !FUSE_NORM2
    if (IN(9)) { for (int m = bx * 8 + wv; m < M; m += G * 16) rms_rows2_bf16(P.out, P.in[I_N2G], HB, m, m + G * 8, lane); SEAM(); }
#endif
#if FUSE_CONV
    if (IN(10)) { pg8::EpiConv E{(pg8::bf16_t*)(ws + WS_ACT), (float*)(ws + (DBG_UDUMP ? 868 * MiB : WS_SB)), P.in[I_FCW], P.in[I_FCB], (PG8_LAS float*)(lds + 131072 + 256), DBG_UDUMP ? (pg8::bf16_t*)(ws + WS_U) : nullptr, FUSE_NORM2 ? (const float*)(ws + 65536) : nullptr};
                  GEMM_CALL(pg8::EpiConv, FUSE_NORM2 ? (bf16*)(ws + WS_H2) : HB, ws + WS_WUP, M, NUP, D, E); SEAM(); }
    if (IN(11)) { conv_fix(P); SEAM(); }
#if DBG_UDUMP
    if (IN(12)) { conv_phase(P, 0, 2); SEAM(); }
#endif
#ifdef DBG_SEL
#pragma unroll 1
    for (int half = 0; half < 2; ++half) {
        if (IN(12)) { pg8::EpiStore E{(pg8::bf16_t*)(ws + WS_U), NUP, NUP, 0, nullptr}; GEMM_CALL(pg8::EpiStore, HB + (size_t)half * MH * D, ws + WS_WUP, MH, NUP, D, E); SEAM(); }
        if (IN(12)) { conv_phase(P, half, DBG_SEL); SEAM(); }
    }
#endif
#else
#pragma unroll 1
    for (int half = 0; half < 2; ++half) {
        if (IN(10 + 2 * half)) { pg8::EpiStore E{(pg8::bf16_t*)(ws + WS_U), NUP, NUP, 0, nullptr}; GEMM_CALL(pg8::EpiStore, HB + (size_t)half * MH * D, ws + WS_WUP, MH, NUP, D, E); SEAM(); }
        if (IN(11 + 2 * half)) { conv_phase(P, half); SEAM(); }
    }
#endif
    if (IN(14)) { pg8::EpiRes E{P.out, (float*)(ws + WS_X2), D}; GEMM_CALL(pg8::EpiRes, ws + WS_ACT, ws + WS_WDN, M, D, DFFP, E); SEAM(); }
    if (IN(15)) { for (int m = bx * 8 + wv; m < M; m += G * 16) rms_rows2_f32(ws + WS_X2, P.out, m, m + G * 8, P.in[I_NFG], lane); }
#ifdef DBG_DUMP
    if (IN(20)) { const bf16* src = (const bf16*)(ws + DBG_SRC); for (size_t i = (size_t)bx * 512 + tid; i < (size_t)M * D; i += (size_t)G * 512) P.out[i] = bfl(src[i]); }
#endif
}

extern "C" void kernel_launch(void* const* d_in, const int* in_sizes, int n_in, void* d_out, int out_size, void* d_ws, size_t ws_size, hipStream_t stream) {
    static int grid = 0;
    if (grid == 0) {
        if (n_in != 31 || in_sizes[0] != M * D || out_size != M * D || ws_size < 1024 * MiB) { fprintf(stderr, "kernel_launch: unexpected shapes (n_in %d, in0 %d, out %d, ws %zu)\n", n_in, n_in > 0 ? in_sizes[0] : -1, out_size, ws_size); grid = -1; return; }
        int dev = 0, cus = 0, per_cu = 0;
        if (hipGetDevice(&dev) != hipSuccess || hipDeviceGetAttribute(&cus, hipDeviceAttributeMultiprocessorCount, dev) != hipSuccess) { grid = -1; return; }
        if (hipFuncSetAttribute((const void*)fwd_kernel, hipFuncAttributeMaxDynamicSharedMemorySize, LDS_BYTES) != hipSuccess) { fprintf(stderr, "kernel_launch: hipFuncSetAttribute failed\n"); grid = -1; return; }
        if (hipOccupancyMaxActiveBlocksPerMultiprocessor(&per_cu, (const void*)fwd_kernel, 512, LDS_BYTES) != hipSuccess || per_cu < 1) { fprintf(stderr, "kernel_launch: occupancy query says %d\n", per_cu); per_cu = 1; }
        (void)hipGetLastError();
        grid = cus * 1;
    }
    if (grid < 0) return;
    Params p{};
    for (int i = 0; i < 31; ++i) p.in[i] = (const float*)d_in[i];
    p.out = (float*)d_out; p.ws = (unsigned char*)d_ws;
#if N_PHASE_LAUNCH
#ifdef DBG_DUMP
    for (int ph = 0; ph <= DBG_DUMP; ++ph) { if (DBG_SKIPMASK & (1 << ph)) continue; hipLaunchKernelGGL(fwd_kernel, dim3(grid), dim3(512), LDS_BYTES, stream, p, ph, ph + 1); }
    if (DBG_DUMP < 14) hipLaunchKernelGGL(fwd_kernel, dim3(grid), dim3(512), LDS_BYTES, stream, p, 20, 21);
#else
    for (int ph = 0; ph < NPHASES; ++ph) { hipLaunchKernelGGL(fwd_kernel, dim3(grid), dim3(512), LDS_BYTES, stream, p, ph, ph + 1); }
#endif
#else
    if (hipMemsetAsync(d_ws, 0, 65536 + 262144, stream) != hipSuccess) { fprintf(stderr, "kernel_launch: memset failed\n"); return; }
    int lo = 0, hi = NPHASES;
    void* args[] = {&p, &lo, &hi};
    hipError_t e = hipLaunchCooperativeKernel((const void*)fwd_kernel, dim3(grid), dim3(512), args, LDS_BYTES, stream);
    if (e != hipSuccess) fprintf(stderr, "kernel_launch: cooperative launch failed: %s (grid %d)\n", hipGetErrorString(e), grid);
#endif
}
```
